# Optimizing an MI355X kernel written in HIP

```python
import jax, jax.numpy as jnp
from jax import lax
import numpy as np

D_MODEL = 1024
BATCH = 8
SEQ = 2048
DEPTH = 1

GRID_W = 64
POOL_WINDOWS = (2, 4, 8, 16)
POOL_WIDTH = D_MODEL // 2
POOL_GROUP = POOL_WIDTH // len(POOL_WINDOWS)
ATTN_HEADS = 8
HEAD_DIM = (D_MODEL // 2) // ATTN_HEADS
ATTN_WIDTH = ATTN_HEADS * HEAD_DIM
MIX_WIDTH = POOL_WIDTH + ATTN_WIDTH
WIN_ROWS_MAX = 8
WIN_COLS = 16
N_EXPERTS = 16
EC_CAPACITY = 2
D_EXPERT = 2 * D_MODEL
PLE_DIM = 256
RMS_EPS = 1e-6

kernel_name = "hybrid_pool_natten_ec_block"


def rms_norm(x, g):
    x32 = x.astype(jnp.float32)
    y = x32 * lax.rsqrt(jnp.mean(x32 * x32, axis=-1, keepdims=True) + RMS_EPS)
    return (y * g.astype(jnp.float32)).astype(x.dtype)


def multiscale_pool(u, w_pool, pool_scale):
    B, S, _ = u.shape
    u32 = u.astype(jnp.float32)
    cs = jnp.concatenate([jnp.zeros((B, 1, POOL_WIDTH), jnp.float32), jnp.cumsum(u32, axis=1)], axis=1)
    t = jnp.arange(S)
    outs = []
    for gi, w in enumerate(POOL_WINDOWS):
        lo = jnp.clip(t - w // 2, 0, S - 1)
        hi = jnp.clip(t + (w - w // 2) - 1, 0, S - 1)
        sl = slice(gi * POOL_GROUP, (gi + 1) * POOL_GROUP)
        csg = cs[:, :, sl]
        cnt = (hi - lo + 1).astype(jnp.float32)[None, :, None]
        outs.append((csg[:, hi + 1] - csg[:, lo]) / cnt - u32[:, :, sl])
    d = jnp.stack(outs, axis=2).astype(u.dtype)
    y = jnp.einsum('bsgc,gcd->bsgd', d, w_pool).reshape(B, S, POOL_WIDTH)
    return y * pool_scale


def neighbourhood_attention(q, k, v, q_norm, k_norm, rpb):
    B, S, H, HD = q.shape
    rows = S // GRID_W
    kh = min(WIN_ROWS_MAX, rows)
    q = rms_norm(q, q_norm) * (HD ** -0.5)
    k = rms_norm(k, k_norm)
    to_grid = lambda a: a.reshape(B, rows, GRID_W, H, HD).transpose(0, 3, 1, 2, 4)
    qg, kg, vg = to_grid(q), to_grid(k), to_grid(v)
    c = jnp.arange(GRID_W)
    col_start = jnp.clip(c - WIN_COLS // 2, 0, GRID_W - WIN_COLS)
    col_idx = col_start[:, None] + jnp.arange(WIN_COLS)[None, :]
    dc = col_idx - c[:, None] + (WIN_COLS - 1)

    def row_block(r):
        row_start = jnp.clip(r - kh // 2, 0, rows - kh)
        q_r = lax.dynamic_index_in_dim(qg, r, axis=2, keepdims=False)
        k_band = lax.dynamic_slice_in_dim(kg, row_start, kh, axis=2)
        v_band = lax.dynamic_slice_in_dim(vg, row_start, kh, axis=2)
        k_nb = k_band[:, :, :, col_idx]
        v_nb = v_band[:, :, :, col_idx]
        s = jnp.einsum('bhcd,bhicjd->bhcij', q_r, k_nb).astype(jnp.float32)
        dr = row_start + jnp.arange(kh) - r + (WIN_ROWS_MAX - 1)
        bias = rpb[:, dr[None, :, None], dc[:, None, :]]
        s = s + bias[None].astype(jnp.float32)
        pr = jax.nn.softmax(s.reshape(B, H, GRID_W, kh * WIN_COLS), axis=-1)
        pr = pr.reshape(B, H, GRID_W, kh, WIN_COLS).astype(v.dtype)
        return jnp.einsum('bhcij,bhicjd->bhcd', pr, v_nb)

    o = lax.map(row_block, jnp.arange(rows))
    return o.transpose(1, 0, 3, 2, 4).reshape(B, S, H * HD)


def expert_choice_ffn(h, w_router, w_gate, w_up, w_down):
    B, S, D = h.shape
    cap = EC_CAPACITY * S // N_EXPERTS
    aff = jax.nn.softmax(jnp.einsum('bsd,de->bse', h, w_router).astype(jnp.float32), axis=-1)
    gates, idx = lax.top_k(aff.transpose(0, 2, 1), cap)
    bidx = jnp.arange(B)[:, None, None]
    xe = h[bidx, idx]
    a = jnp.einsum('becd,edf->becf', xe, w_gate)
    b = jnp.einsum('becd,edf->becf', xe, w_up)
    ye = jnp.einsum('becf,efd->becd', jax.nn.silu(a) * b, w_down)
    return jnp.zeros_like(h).at[bidx, idx].add(ye * gates[..., None].astype(h.dtype))


def setup_inputs(seed: int = 0) -> dict:
    key = jax.random.key(seed)
    ks = jax.random.split(key, 20)
    f32 = jnp.float32
    nrm = lambda k, shape, s: jax.random.normal(k, shape, f32) * s
    gain = lambda k, shape: 1.0 + 0.02 * jax.random.normal(k, shape, f32)
    L = DEPTH
    return {
        "x": nrm(ks[0], (BATCH, SEQ, D_MODEL), 1.0),
        "p": nrm(ks[1], (L, BATCH, SEQ, PLE_DIM), 1.0),
        "norm_mix": gain(ks[2], (L, D_MODEL)),
        "w_in": nrm(ks[3], (L, D_MODEL, POOL_WIDTH + 3 * ATTN_WIDTH), D_MODEL ** -0.5),
        "w_pool": nrm(ks[4], (L, len(POOL_WINDOWS), POOL_GROUP, POOL_GROUP), POOL_GROUP ** -0.5),
        "pool_scale": gain(ks[5], (L, POOL_WIDTH)),
        "q_norm": gain(ks[6], (L, HEAD_DIM)),
        "k_norm": gain(ks[7], (L, HEAD_DIM)),
        "rpb": nrm(ks[8], (L, ATTN_HEADS, 2 * WIN_ROWS_MAX - 1, 2 * WIN_COLS - 1), 0.1),
        "w_out": nrm(ks[9], (L, MIX_WIDTH, D_MODEL), MIX_WIDTH ** -0.5),
        "norm_ffn": gain(ks[10], (L, D_MODEL)),
        "w_router": nrm(ks[11], (L, D_MODEL, N_EXPERTS), D_MODEL ** -0.5),
        "w_gate": nrm(ks[12], (L, N_EXPERTS, D_MODEL, D_EXPERT), D_MODEL ** -0.5),
        "w_up": nrm(ks[13], (L, N_EXPERTS, D_MODEL, D_EXPERT), D_MODEL ** -0.5),
        "w_down": nrm(ks[14], (L, N_EXPERTS, D_EXPERT, D_MODEL), D_EXPERT ** -0.5),
        "norm_ple": gain(ks[15], (L, D_MODEL)),
        "w_ple_gate": nrm(ks[16], (L, D_MODEL, D_MODEL), D_MODEL ** -0.5),
        "w_ple_proj": nrm(ks[17], (L, PLE_DIM, D_MODEL), PLE_DIM ** -0.5),
        "norm_ple_post": gain(ks[18], (L, D_MODEL)),
    }


def reference(x, p, norm_mix, w_in, w_pool, pool_scale, q_norm, k_norm, rpb, w_out,
              norm_ffn, w_router, w_gate, w_up, w_down, norm_ple, w_ple_gate,
              w_ple_proj, norm_ple_post):
    B, S, _ = x.shape
    for i in range(DEPTH):
        h = rms_norm(x, norm_mix[i])
        z = h @ w_in[i]
        u = z[..., :POOL_WIDTH]
        qkv = z[..., POOL_WIDTH:].reshape(B, S, 3, ATTN_HEADS, HEAD_DIM)
        y_pool = multiscale_pool(u, w_pool[i], pool_scale[i])
        y_attn = neighbourhood_attention(qkv[:, :, 0], qkv[:, :, 1], qkv[:, :, 2],
                                         q_norm[i], k_norm[i], rpb[i])
        x = x + jnp.concatenate([y_pool, y_attn], axis=-1) @ w_out[i]
        x = x + expert_choice_ffn(rms_norm(x, norm_ffn[i]), w_router[i], w_gate[i], w_up[i], w_down[i])
        g = jax.nn.sigmoid(rms_norm(x, norm_ple[i]) @ w_ple_gate[i])
        e = rms_norm(p[i] @ w_ple_proj[i], norm_ple_post[i])
        x = x + g * e
    return x
```

```cpp
#include <hip/hip_runtime.h>
#include <cstdio>
#include <cstdint>

namespace cfg {
constexpr int D = 1024, B = 8, S = 2048, T = B * S;
constexpr int GW = 64, ROWS = S / GW;
constexpr int PW = 512, PG = 128, AH = 8, HD = 64, NE = 16, CAP = 256, DE = 2048, PD = 256;
constexpr float EPS = 1e-6f;
}
using namespace cfg;

namespace nv {
__global__ void __launch_bounds__(256) rmsnorm_rows(const float* __restrict__ x, const float* __restrict__ g, float* __restrict__ out, int ncols) {
    __shared__ float red[256];
    const size_t row = blockIdx.x; const float* xr = x + row * ncols; float s = 0.f;
    for (int c = threadIdx.x; c < ncols; c += 256) { const float v = xr[c]; s += v * v; }
    red[threadIdx.x] = s; __syncthreads();
    for (int o = 128; o > 0; o >>= 1) { if ((int)threadIdx.x < o) red[threadIdx.x] += red[threadIdx.x + o]; __syncthreads(); }
    const float rstd = 1.0f / sqrtf(red[0] / (float)ncols + EPS);
    for (int c = threadIdx.x; c < ncols; c += 256) out[row * ncols + c] = xr[c] * rstd * g[c];
}
__global__ void __launch_bounds__(256) gemm_f32(const float* __restrict__ A, const float* __restrict__ Bm, float* __restrict__ C, int K, int lda, int ldb, int ldc, size_t sA, size_t sB, size_t sC) {
    __shared__ float As[16][65]; __shared__ float Bs[16][64];
    const int z = blockIdx.z; A += z * sA; Bm += z * sB; C += z * sC;
    const int m0 = blockIdx.y * 64, n0 = blockIdx.x * 64, tx = threadIdx.x & 15, ty = threadIdx.x >> 4;
    float acc[4][4] = {};
    for (int k0 = 0; k0 < K; k0 += 16) {
        for (int i = threadIdx.x; i < 1024; i += 256) { const int r = i >> 4, c = i & 15; As[c][r] = A[(size_t)(m0 + r) * lda + k0 + c]; }
        for (int i = threadIdx.x; i < 1024; i += 256) { const int r = i >> 6, c = i & 63; Bs[r][c] = Bm[(size_t)(k0 + r) * ldb + n0 + c]; }
        __syncthreads();
#pragma unroll
        for (int k = 0; k < 16; ++k) { float a[4], b[4];
#pragma unroll
            for (int i = 0; i < 4; ++i) { a[i] = As[k][ty * 4 + i]; b[i] = Bs[k][tx * 4 + i]; }
#pragma unroll
            for (int i = 0; i < 4; ++i)
#pragma unroll
                for (int j = 0; j < 4; ++j) acc[i][j] += a[i] * b[j]; }
        __syncthreads();
    }
#pragma unroll
    for (int i = 0; i < 4; ++i)
#pragma unroll
        for (int j = 0; j < 4; ++j) C[(size_t)(m0 + ty * 4 + i) * ldc + n0 + tx * 4 + j] = acc[i][j];
}
__global__ void __launch_bounds__(256) pool_diff(const float* __restrict__ z, float* __restrict__ d) {
    const size_t i = (size_t)blockIdx.x * 256 + threadIdx.x; if (i >= (size_t)T * PW) return;
    const int c = (int)(i % PW); const int tok = (int)(i / PW), b = tok / S, t = tok % S; const int gi = c / PG; const int w = 2 << gi;
    int lo = t - w / 2; if (lo < 0) lo = 0; int hi = t + (w - w / 2) - 1; if (hi > S - 1) hi = S - 1;
    float s = 0.f; for (int q = lo; q <= hi; ++q) s += z[((size_t)b * S + q) * 2048 + c];
    d[i] = s / (float)(hi - lo + 1) - z[(size_t)tok * 2048 + c];
}
__global__ void __launch_bounds__(256) scale_cols(float* __restrict__ y, int ld, int ncols, const float* __restrict__ sc, size_t n) {
    const size_t i = (size_t)blockIdx.x * 256 + threadIdx.x; if (i >= n) return; const int c = (int)(i % ncols); const size_t r = i / ncols; y[r * ld + c] *= sc[c];
}
__global__ void __launch_bounds__(128) natten(const float* __restrict__ z, const float* __restrict__ qn, const float* __restrict__ kn, const float* __restrict__ rpb, float* __restrict__ mix) {
    __shared__ float qs[64]; __shared__ float ps[128]; __shared__ float red[128];
    const int tok = blockIdx.x >> 3, h = blockIdx.x & 7, b = tok / S, t = tok % S, r = t / GW, c = t % GW, j = threadIdx.x;
    int rs = r - 4; if (rs < 0) rs = 0; if (rs > ROWS - 8) rs = ROWS - 8;
    int cs = c - 8; if (cs < 0) cs = 0; if (cs > GW - 16) cs = GW - 16;
    if (j < 64) qs[j] = z[(size_t)tok * 2048 + 512 + h * 64 + j];
    __syncthreads();
    float qss = 0.f; for (int d = 0; d < 64; ++d) qss += qs[d] * qs[d];
    const float rq = 1.0f / sqrtf(qss / 64.f + EPS);
    const int i = j >> 4, jj = j & 15; const int kt = b * S + (rs + i) * GW + cs + jj;
    const float* kr = z + (size_t)kt * 2048 + 1024 + h * 64;
    float kss = 0.f, dot = 0.f;
    for (int d = 0; d < 64; ++d) { const float kv = kr[d]; kss += kv * kv; dot += (qs[d] * rq * qn[d] * 0.125f) * (kv * kn[d]); }
    const float rk = 1.0f / sqrtf(kss / 64.f + EPS);
    const int dr = rs + i - r + 7, dc = cs + jj - c + 15;
    const float sc = dot * rk + rpb[(h * 15 + dr) * 31 + dc];
    red[j] = sc; __syncthreads();
    for (int o = 64; o > 0; o >>= 1) { if (j < o) red[j] = fmaxf(red[j], red[j + o]); __syncthreads(); }
    const float mx = red[0]; __syncthreads();
    const float p = expf(sc - mx); ps[j] = p; red[j] = p; __syncthreads();
    for (int o = 64; o > 0; o >>= 1) { if (j < o) red[j] += red[j + o]; __syncthreads(); }
    const float inv = 1.0f / red[0];
    if (j < 64) { float o = 0.f;
        for (int q = 0; q < 128; ++q) { const int vt = b * S + (rs + (q >> 4)) * GW + cs + (q & 15); o += ps[q] * z[(size_t)vt * 2048 + 1536 + h * 64 + j]; }
        mix[(size_t)tok * 1024 + 512 + h * 64 + j] = o * inv; }
}
__global__ void __launch_bounds__(256) add_to(float* __restrict__ o, const float* __restrict__ a, const float* __restrict__ b, size_t n) {
    const size_t i = (size_t)blockIdx.x * 256 + threadIdx.x; if (i < n) o[i] = a[i] + b[i];
}
__global__ void __launch_bounds__(256) router(const float* __restrict__ h2, const float* __restrict__ wr, float* __restrict__ aff) {
    __shared__ float red[16][256];
    const int tok = blockIdx.x; float acc[16] = {};
    for (int d = threadIdx.x; d < D; d += 256) { const float v = h2[(size_t)tok * D + d];
#pragma unroll
        for (int e = 0; e < 16; ++e) acc[e] += v * wr[d * 16 + e]; }
#pragma unroll
    for (int e = 0; e < 16; ++e) red[e][threadIdx.x] = acc[e];
    __syncthreads();
    for (int o = 128; o > 0; o >>= 1) { if ((int)threadIdx.x < o) { for (int e = 0; e < 16; ++e) red[e][threadIdx.x] += red[e][threadIdx.x + o]; } __syncthreads(); }
    if (threadIdx.x < 16) { float mx = -1e30f; for (int e = 0; e < 16; ++e) mx = fmaxf(mx, red[e][0]); float sum = 0.f; for (int e = 0; e < 16; ++e) sum += expf(red[e][0] - mx);
        const int e = threadIdx.x, b = tok / S, s = tok % S; aff[((size_t)b * NE + e) * S + s] = expf(red[e][0] - mx) / sum; }
}
__global__ void __launch_bounds__(1024) topk(const float* __restrict__ aff, int* __restrict__ idx, float* __restrict__ gates, int* __restrict__ slot_of) {
    __shared__ float v[S];
    const int be = blockIdx.x, b = be / NE, e = be % NE;
    for (int i = threadIdx.x; i < S; i += 1024) v[i] = aff[(size_t)be * S + i];
    __syncthreads();
    for (int i = threadIdx.x; i < S; i += 1024) { const float vi = v[i]; int rank = 0;
        for (int q = 0; q < S; ++q) { const float vq = v[q]; rank += (vq > vi || (vq == vi && q < i)) ? 1 : 0; }
        if (rank < CAP) { idx[be * CAP + rank] = i; gates[be * CAP + rank] = vi; }
        slot_of[((size_t)b * S + i) * NE + e] = rank < CAP ? rank : -1; }
}
__global__ void __launch_bounds__(256) gather_rows(const float* __restrict__ h2, const int* __restrict__ idx, float* __restrict__ xe) {
    const int slot = blockIdx.x; const int be = slot / CAP, b = be / NE; const int tok = b * S + idx[slot];
    for (int c = threadIdx.x; c < D; c += 256) xe[(size_t)slot * D + c] = h2[(size_t)tok * D + c];
}
__global__ void __launch_bounds__(256) silu_mul(float* __restrict__ a, const float* __restrict__ bb, size_t n) {
    const size_t i = (size_t)blockIdx.x * 256 + threadIdx.x; if (i < n) { const float x = a[i]; a[i] = x / (1.0f + expf(-x)) * bb[i]; }
}
__global__ void __launch_bounds__(256) combine(float* __restrict__ x, const float* __restrict__ ye, const float* __restrict__ gates, const int* __restrict__ slot_of) {
    const int tok = blockIdx.x, b = tok / S;
    for (int c = threadIdx.x; c < D; c += 256) { float acc = x[(size_t)tok * D + c];
        for (int e = 0; e < NE; ++e) { const int sl = slot_of[(size_t)tok * NE + e]; if (sl >= 0) { const int slot = (b * NE + e) * CAP + sl; acc += ye[(size_t)slot * D + c] * gates[slot]; } }
        x[(size_t)tok * D + c] = acc; }
}
__global__ void __launch_bounds__(256) ple_final(float* __restrict__ x, const float* __restrict__ glog, const float* __restrict__ en, size_t n) {
    const size_t i = (size_t)blockIdx.x * 256 + threadIdx.x; if (i < n) { const float g = 1.0f / (1.0f + expf(-glog[i])); x[i] = x[i] + g * en[i]; }
}
}

static inline dim3 g1(size_t n) { return dim3((unsigned)((n + 255) / 256)); }

extern "C" void kernel_launch(void* const* d_in, const int* in_sizes, int n_in, void* d_out, int out_size, void* d_ws, size_t ws_size, hipStream_t stream) {
    const float* x = (const float*)d_in[0]; const float* p = (const float*)d_in[1]; const float* norm_mix = (const float*)d_in[2]; const float* w_in = (const float*)d_in[3];
    const float* w_pool = (const float*)d_in[4]; const float* pool_scale = (const float*)d_in[5]; const float* q_norm = (const float*)d_in[6]; const float* k_norm = (const float*)d_in[7];
    const float* rpb = (const float*)d_in[8]; const float* w_out = (const float*)d_in[9]; const float* norm_ffn = (const float*)d_in[10]; const float* w_router = (const float*)d_in[11];
    const float* w_gate = (const float*)d_in[12]; const float* w_up = (const float*)d_in[13]; const float* w_down = (const float*)d_in[14]; const float* norm_ple = (const float*)d_in[15];
    const float* w_ple_gate = (const float*)d_in[16]; const float* w_ple_proj = (const float*)d_in[17]; const float* norm_ple_post = (const float*)d_in[18];
    float* out = (float*)d_out; char* ws = (char*)d_ws;
    const size_t MiB = 1u << 20;
    float* xn = (float*)(ws + 0 * MiB);
    float* z = (float*)(ws + 64 * MiB);
    float* dp = (float*)(ws + 192 * MiB);
    float* mix = (float*)(ws + 224 * MiB);
    float* ye = (float*)(ws + 288 * MiB);
    float* ga = (float*)(ws + 416 * MiB);
    float* gb = (float*)(ws + 448 * MiB);
    float* aff = (float*)(ws + 480 * MiB);
    int* idx = (int*)(ws + 481 * MiB); float* gates = (float*)(ws + 482 * MiB); int* slot_of = (int*)(ws + 483 * MiB);
    float* en = (float*)(ws + 484 * MiB);
    (void)en; (void)in_sizes; (void)n_in; (void)out_size; (void)ws_size;

    nv::rmsnorm_rows<<<T, 256, 0, stream>>>(x, norm_mix, xn, D);
    nv::gemm_f32<<<dim3(2048 / 64, T / 64, 1), 256, 0, stream>>>(xn, w_in, z, D, D, 2048, 2048, 0, 0, 0);
    nv::pool_diff<<<g1((size_t)T * PW), 256, 0, stream>>>(z, dp);
    nv::gemm_f32<<<dim3(PG / 64, T / 64, 4), 256, 0, stream>>>(dp, w_pool, mix, PG, PW, PG, D, PG, (size_t)PG * PG, PG);
    nv::scale_cols<<<g1((size_t)T * PW), 256, 0, stream>>>(mix, D, PW, pool_scale, (size_t)T * PW);
    nv::natten<<<T * AH, 128, 0, stream>>>(z, q_norm, k_norm, rpb, mix);
    nv::gemm_f32<<<dim3(D / 64, T / 64, 1), 256, 0, stream>>>(mix, w_out, xn, D, D, D, D, 0, 0, 0);
    nv::add_to<<<g1((size_t)T * D), 256, 0, stream>>>(out, x, xn, (size_t)T * D);
    nv::rmsnorm_rows<<<T, 256, 0, stream>>>(out, norm_ffn, xn, D);
    nv::router<<<T, 256, 0, stream>>>(xn, w_router, aff);
    nv::topk<<<B * NE, 1024, 0, stream>>>(aff, idx, gates, slot_of);
    float* xe = z;
    nv::gather_rows<<<B * NE * CAP, 256, 0, stream>>>(xn, idx, xe);
    for (int b = 0; b < B; ++b) {
        const float* xeb = xe + (size_t)b * NE * CAP * D;
        nv::gemm_f32<<<dim3(DE / 64, CAP / 64, NE), 256, 0, stream>>>(xeb, w_gate, ga, D, D, DE, DE, (size_t)CAP * D, (size_t)D * DE, (size_t)CAP * DE);
        nv::gemm_f32<<<dim3(DE / 64, CAP / 64, NE), 256, 0, stream>>>(xeb, w_up, gb, D, D, DE, DE, (size_t)CAP * D, (size_t)D * DE, (size_t)CAP * DE);
        nv::silu_mul<<<g1((size_t)NE * CAP * DE), 256, 0, stream>>>(ga, gb, (size_t)NE * CAP * DE);
        nv::gemm_f32<<<dim3(D / 64, CAP / 64, NE), 256, 0, stream>>>(ga, w_down, ye + (size_t)b * NE * CAP * D, DE, DE, D, D, (size_t)CAP * DE, (size_t)DE * D, (size_t)CAP * D);
    }
    nv::combine<<<T, 256, 0, stream>>>(out, ye, gates, slot_of);
    nv::rmsnorm_rows<<<T, 256, 0, stream>>>(out, norm_ple, xn, D);
    nv::gemm_f32<<<dim3(D / 64, T / 64, 1), 256, 0, stream>>>(xn, w_ple_gate, mix, D, D, D, D, 0, 0, 0);
    float* eraw = ye;
    nv::gemm_f32<<<dim3(D / 64, T / 64, 1), 256, 0, stream>>>(p, w_ple_proj, eraw, PD, PD, D, D, 0, 0, 0);
    nv::rmsnorm_rows<<<T, 256, 0, stream>>>(eraw, norm_ple_post, xn, D);
    nv::ple_final<<<g1((size_t)T * D), 256, 0, stream>>>(out, mix, xn, (size_t)T * D);
}
```

```cpp
#include <hip/hip_runtime.h>
#include <cstdio>
#include <cstdint>

namespace cfg {
constexpr int D = 1024, B = 8, S = 2048, T = B * S;
constexpr int GW = 64, ROWS = S / GW;
constexpr int PW = 512, PG = 128, AH = 8, HD = 64, NE = 16, CAP = 256, DE = 2048, PD = 256;
constexpr float EPS = 1e-6f;
}
using namespace cfg;

namespace nv {
__global__ void __launch_bounds__(256) rmsnorm_rows(const float* __restrict__ x, const float* __restrict__ g, float* __restrict__ out, int ncols) {
    __shared__ float red[256];
    const size_t row = blockIdx.x; const float* xr = x + row * ncols; float s = 0.f;
    for (int c = threadIdx.x; c < ncols; c += 256) { const float v = xr[c]; s += v * v; }
    red[threadIdx.x] = s; __syncthreads();
    for (int o = 128; o > 0; o >>= 1) { if ((int)threadIdx.x < o) red[threadIdx.x] += red[threadIdx.x + o]; __syncthreads(); }
    const float rstd = 1.0f / sqrtf(red[0] / (float)ncols + EPS);
    for (int c = threadIdx.x; c < ncols; c += 256) out[row * ncols + c] = xr[c] * rstd * g[c];
}
__global__ void __launch_bounds__(256) gemm_f32(const float* __restrict__ A, const float* __restrict__ Bm, float* __restrict__ C, int K, int lda, int ldb, int ldc, size_t sA, size_t sB, size_t sC) {
    __shared__ float As[16][65]; __shared__ float Bs[16][64];
    const int z = blockIdx.z; A += z * sA; Bm += z * sB; C += z * sC;
    const int m0 = blockIdx.y * 64, n0 = blockIdx.x * 64, tx = threadIdx.x & 15, ty = threadIdx.x >> 4;
    float acc[4][4] = {};
    for (int k0 = 0; k0 < K; k0 += 16) {
        for (int i = threadIdx.x; i < 1024; i += 256) { const int r = i >> 4, c = i & 15; As[c][r] = A[(size_t)(m0 + r) * lda + k0 + c]; }
        for (int i = threadIdx.x; i < 1024; i += 256) { const int r = i >> 6, c = i & 63; Bs[r][c] = Bm[(size_t)(k0 + r) * ldb + n0 + c]; }
        __syncthreads();
#pragma unroll
        for (int k = 0; k < 16; ++k) { float a[4], b[4];
#pragma unroll
            for (int i = 0; i < 4; ++i) { a[i] = As[k][ty * 4 + i]; b[i] = Bs[k][tx * 4 + i]; }
#pragma unroll
            for (int i = 0; i < 4; ++i)
#pragma unroll
                for (int j = 0; j < 4; ++j) acc[i][j] += a[i] * b[j]; }
        __syncthreads();
    }
#pragma unroll
    for (int i = 0; i < 4; ++i)
#pragma unroll
        for (int j = 0; j < 4; ++j) C[(size_t)(m0 + ty * 4 + i) * ldc + n0 + tx * 4 + j] = acc[i][j];
}
__global__ void __launch_bounds__(256) pool_diff(const float* __restrict__ z, float* __restrict__ d) {
    const size_t i = (size_t)blockIdx.x * 256 + threadIdx.x; if (i >= (size_t)T * PW) return;
    const int c = (int)(i % PW); const int tok = (int)(i / PW), b = tok / S, t = tok % S; const int gi = c / PG; const int w = 2 << gi;
    int lo = t - w / 2; if (lo < 0) lo = 0; int hi = t + (w - w / 2) - 1; if (hi > S - 1) hi = S - 1;
    float s = 0.f; for (int q = lo; q <= hi; ++q) s += z[((size_t)b * S + q) * 2048 + c];
    d[i] = s / (float)(hi - lo + 1) - z[(size_t)tok * 2048 + c];
}
__global__ void __launch_bounds__(256) scale_cols(float* __restrict__ y, int ld, int ncols, const float* __restrict__ sc, size_t n) {
    const size_t i = (size_t)blockIdx.x * 256 + threadIdx.x; if (i >= n) return; const int c = (int)(i % ncols); const size_t r = i / ncols; y[r * ld + c] *= sc[c];
}
__global__ void __launch_bounds__(128) natten(const float* __restrict__ z, const float* __restrict__ qn, const float* __restrict__ kn, const float* __restrict__ rpb, float* __restrict__ mix) {
    __shared__ float qs[64]; __shared__ float ps[128]; __shared__ float red[128];
    const int tok = blockIdx.x >> 3, h = blockIdx.x & 7, b = tok / S, t = tok % S, r = t / GW, c = t % GW, j = threadIdx.x;
    int rs = r - 4; if (rs < 0) rs = 0; if (rs > ROWS - 8) rs = ROWS - 8;
    int cs = c - 8; if (cs < 0) cs = 0; if (cs > GW - 16) cs = GW - 16;
    if (j < 64) qs[j] = z[(size_t)tok * 2048 + 512 + h * 64 + j];
    __syncthreads();
    float qss = 0.f; for (int d = 0; d < 64; ++d) qss += qs[d] * qs[d];
    const float rq = 1.0f / sqrtf(qss / 64.f + EPS);
    const int i = j >> 4, jj = j & 15; const int kt = b * S + (rs + i) * GW + cs + jj;
    const float* kr = z + (size_t)kt * 2048 + 1024 + h * 64;
    float kss = 0.f, dot = 0.f;
    for (int d = 0; d < 64; ++d) { const float kv = kr[d]; kss += kv * kv; dot += (qs[d] * rq * qn[d] * 0.125f) * (kv * kn[d]); }
    const float rk = 1.0f / sqrtf(kss / 64.f + EPS);
    const int dr = rs + i - r + 7, dc = cs + jj - c + 15;
    const float sc = dot * rk + rpb[(h * 15 + dr) * 31 + dc];
    red[j] = sc; __syncthreads();
    for (int o = 64; o > 0; o >>= 1) { if (j < o) red[j] = fmaxf(red[j], red[j + o]); __syncthreads(); }
    const float mx = red[0]; __syncthreads();
    const float p = expf(sc - mx); ps[j] = p; red[j] = p; __syncthreads();
    for (int o = 64; o > 0; o >>= 1) { if (j < o) red[j] += red[j + o]; __syncthreads(); }
    const float inv = 1.0f / red[0];
    if (j < 64) { float o = 0.f;
        for (int q = 0; q < 128; ++q) { const int vt = b * S + (rs + (q >> 4)) * GW + cs + (q & 15); o += ps[q] * z[(size_t)vt * 2048 + 1536 + h * 64 + j]; }
        mix[(size_t)tok * 1024 + 512 + h * 64 + j] = o * inv; }
}
__global__ void __launch_bounds__(256) add_to(float* __restrict__ o, const float* __restrict__ a, const float* __restrict__ b, size_t n) {
    const size_t i = (size_t)blockIdx.x * 256 + threadIdx.x; if (i < n) o[i] = a[i] + b[i];
}
__global__ void __launch_bounds__(256) router(const float* __restrict__ h2, const float* __restrict__ wr, float* __restrict__ aff) {
    __shared__ float red[16][256];
    const int tok = blockIdx.x; float acc[16] = {};
    for (int d = threadIdx.x; d < D; d += 256) { const float v = h2[(size_t)tok * D + d];
#pragma unroll
        for (int e = 0; e < 16; ++e) acc[e] += v * wr[d * 16 + e]; }
#pragma unroll
    for (int e = 0; e < 16; ++e) red[e][threadIdx.x] = acc[e];
    __syncthreads();
    for (int o = 128; o > 0; o >>= 1) { if ((int)threadIdx.x < o) { for (int e = 0; e < 16; ++e) red[e][threadIdx.x] += red[e][threadIdx.x + o]; } __syncthreads(); }
    if (threadIdx.x < 16) { float mx = -1e30f; for (int e = 0; e < 16; ++e) mx = fmaxf(mx, red[e][0]); float sum = 0.f; for (int e = 0; e < 16; ++e) sum += expf(red[e][0] - mx);
        const int e = threadIdx.x, b = tok / S, s = tok % S; aff[((size_t)b * NE + e) * S + s] = expf(red[e][0] - mx) / sum; }
}
__global__ void __launch_bounds__(1024) topk(const float* __restrict__ aff, int* __restrict__ idx, float* __restrict__ gates, int* __restrict__ slot_of) {
    __shared__ float v[S];
    const int be = blockIdx.x, b = be / NE, e = be % NE;
    for (int i = threadIdx.x; i < S; i += 1024) v[i] = aff[(size_t)be * S + i];
    __syncthreads();
    for (int i = threadIdx.x; i < S; i += 1024) { const float vi = v[i]; int rank = 0;
        for (int q = 0; q < S; ++q) { const float vq = v[q]; rank += (vq > vi || (vq == vi && q < i)) ? 1 : 0; }
        if (rank < CAP) { idx[be * CAP + rank] = i; gates[be * CAP + rank] = vi; }
        slot_of[((size_t)b * S + i) * NE + e] = rank < CAP ? rank : -1; }
}
__global__ void __launch_bounds__(256) gather_rows(const float* __restrict__ h2, const int* __restrict__ idx, float* __restrict__ xe) {
    const int slot = blockIdx.x; const int be = slot / CAP, b = be / NE; const int tok = b * S + idx[slot];
    for (int c = threadIdx.x; c < D; c += 256) xe[(size_t)slot * D + c] = h2[(size_t)tok * D + c];
}
__global__ void __launch_bounds__(256) silu_mul(float* __restrict__ a, const float* __restrict__ bb, size_t n) {
    const size_t i = (size_t)blockIdx.x * 256 + threadIdx.x; if (i < n) { const float x = a[i]; a[i] = x / (1.0f + expf(-x)) * bb[i]; }
}
__global__ void __launch_bounds__(256) combine(float* __restrict__ x, const float* __restrict__ ye, const float* __restrict__ gates, const int* __restrict__ slot_of) {
    const int tok = blockIdx.x, b = tok / S;
    for (int c = threadIdx.x; c < D; c += 256) { float acc = x[(size_t)tok * D + c];
        for (int e = 0; e < NE; ++e) { const int sl = slot_of[(size_t)tok * NE + e]; if (sl >= 0) { const int slot = (b * NE + e) * CAP + sl; acc += ye[(size_t)slot * D + c] * gates[slot]; } }
        x[(size_t)tok * D + c] = acc; }
}
__global__ void __launch_bounds__(256) ple_final(float* __restrict__ x, const float* __restrict__ glog, const float* __restrict__ en, size_t n) {
    const size_t i = (size_t)blockIdx.x * 256 + threadIdx.x; if (i < n) { const float g = 1.0f / (1.0f + expf(-glog[i])); x[i] = x[i] + g * en[i]; }
}
}

namespace nv {
__global__ void __launch_bounds__(256) bf16_to_f32(const unsigned short* __restrict__ in, float* __restrict__ out, int ncols, int ldo, size_t n) {
    const size_t i = (size_t)blockIdx.x * 256 + threadIdx.x; if (i >= n) return; const size_t r = i / ncols; const int c = (int)(i % ncols);
    out[r * ldo + c] = __builtin_bit_cast(float, (unsigned)in[i] << 16);
}
__global__ void __launch_bounds__(128) natten_pre(const unsigned short* __restrict__ Q, const unsigned short* __restrict__ Kk, const unsigned short* __restrict__ VT, const float* __restrict__ rpb, float* __restrict__ mix) {
    __shared__ float qs[64]; __shared__ float ps[128]; __shared__ float red[128];
    const int tok = blockIdx.x >> 3, h = blockIdx.x & 7, b = tok / S, t = tok % S, r = t / GW, c = t % GW, j = threadIdx.x; const int bh = b * 8 + h;
    int rs = r - 4; if (rs < 0) rs = 0; if (rs > ROWS - 8) rs = ROWS - 8;
    int cs = c - 8; if (cs < 0) cs = 0; if (cs > GW - 16) cs = GW - 16;
    if (j < 64) qs[j] = __builtin_bit_cast(float, (unsigned)Q[((size_t)bh * S + t) * 64 + j] << 16);
    __syncthreads();
    const int i = j >> 4, jj = j & 15; const int ks = (rs + i) * GW + cs + jj;
    float dot = 0.f;
    for (int d = 0; d < 64; ++d) dot += qs[d] * __builtin_bit_cast(float, (unsigned)Kk[((size_t)bh * S + ks) * 64 + d] << 16);
    const int dr = rs + i - r + 7, dc = cs + jj - c + 15;
    const float sc = dot + rpb[(h * 15 + dr) * 31 + dc] * 1.4426950408889634f;
    red[j] = sc; __syncthreads();
    for (int o = 64; o > 0; o >>= 1) { if (j < o) red[j] = fmaxf(red[j], red[j + o]); __syncthreads(); }
    const float mx = red[0]; __syncthreads();
    const float p = exp2f(sc - mx); ps[j] = p; red[j] = p; __syncthreads();
    for (int o = 64; o > 0; o >>= 1) { if (j < o) red[j] += red[j + o]; __syncthreads(); }
    const float inv = 1.0f / red[0];
    if (j < 64) { float o = 0.f;
        for (int q = 0; q < 128; ++q) { const int vs = (rs + (q >> 4)) * GW + cs + (q & 15); o += ps[q] * __builtin_bit_cast(float, (unsigned)VT[((size_t)bh * 64 + j) * S + vs] << 16); }
        mix[(size_t)tok * 1024 + 512 + h * 64 + j] = o * inv; }
}
__global__ void __launch_bounds__(256) combine_bf16(float* __restrict__ x, const unsigned short* __restrict__ ye, const int* __restrict__ slot_of) {
    const int tok = blockIdx.x, b = tok / S;
    for (int c = threadIdx.x; c < D; c += 256) { float acc = x[(size_t)tok * D + c];
        for (int e = 0; e < NE; ++e) { const int sl = slot_of[(size_t)tok * NE + e]; if (sl >= 0) { const int slot = (b * NE + e) * CAP + sl; acc += __builtin_bit_cast(float, (unsigned)ye[(size_t)slot * D + c] << 16); } }
        x[(size_t)tok * D + c] = acc; }
}
}
#define MODE 109
#define GAS __attribute__((address_space(1)))
#define LAS __attribute__((address_space(3)))
typedef unsigned short bf16_t;
typedef short bf16x8 __attribute__((ext_vector_type(8)));
typedef float f32x4 __attribute__((ext_vector_type(4)));
typedef float f32x2 __attribute__((ext_vector_type(2)));
typedef unsigned u32x4 __attribute__((ext_vector_type(4)));
typedef unsigned u32x2 __attribute__((ext_vector_type(2)));
typedef __bf16 bf16x2_t __attribute__((ext_vector_type(2)));

__device__ __forceinline__ unsigned pkbf(float lo, float hi) { f32x2 v = {lo, hi}; bf16x2_t b = __builtin_convertvector(v, bf16x2_t); return __builtin_bit_cast(unsigned, b); }
__device__ __forceinline__ float bf2f(unsigned short u) { return __builtin_bit_cast(float, (unsigned)u << 16); }
__device__ __forceinline__ float bflo(unsigned u) { return __builtin_bit_cast(float, u << 16); }
__device__ __forceinline__ float bfhi(unsigned u) { return __builtin_bit_cast(float, u & 0xffff0000u); }
__device__ __forceinline__ float wave_sum(float v) {
#pragma unroll
    for (int o = 1; o < 64; o <<= 1) v += __shfl_xor(v, o);
    return v;
}
constexpr float LOG2E = 1.4426950408889634f;

namespace pg8 {
constexpr int BM = 256, BK = 64, HALF = 128, HTB = HALF * BK * 2, STAGE_BYTES = 8 * HTB;
__host__ __device__ __forceinline__ int lds_byte(int r, int c) { const int st = (r >> 4) * 2 + (c >> 5), rr = r & 15, cc = c & 31, ob = rr * 64 + cc * 2; return st * 1024 + (ob ^ (((ob >> 9) & 1) << 5)); }
__host__ __device__ __forceinline__ void stage_rc(int b, int& R, int& C) { const int st = b / 1024, sb = b % 1024, swz = sb ^ (((sb >> 9) & 1) << 5); R = (st >> 1) * 16 + swz / 64; C = (st & 1) * 32 + (swz % 64) / 2; }
__host__ __device__ __forceinline__ int perm32(int rho) { const int n = rho >> 4, i = rho & 15; return 8 * (i >> 2) + 4 * n + (i & 3); }

struct Unit { int arow, brow, pm, pn, grp; };
struct Gemm { const bf16_t* A; const bf16_t* Bt; int K; };

struct StaticOrder {
    int nM, nN, nwg, G, c;
    __device__ void init(int M, int N, int G_, int c_) { nM = M / BM; nN = N / BM; nwg = nM * nN; G = G_; c = c_; }
    __device__ bool next(int i, Unit& u) const {
        const long L = (long)i * G + c; if (L >= nwg) return false;
        int wgid = (int)L; { const int q = nwg / 8, r = nwg % 8, xcd = wgid % 8, off = wgid / 8; wgid = (xcd < r ? xcd * (q + 1) : r * (q + 1) + (xcd - r) * q) + off; }
        const int nig = 8 * nN, gid = wgid / nig, fm = gid * 8, gsz = (nM - fm) < 8 ? (nM - fm) : 8;
        u.pm = fm + ((wgid % nig) % gsz); u.pn = (wgid % nig) / gsz; u.arow = u.pm * BM; u.brow = u.pn * BM; u.grp = 0; return true;
    }
};

template <class Epi, class Sched>
__device__ __forceinline__ void gemm_phase(LAS unsigned char* lds, const Gemm g, const Sched& S, const Epi& E) {
    const int tid = threadIdx.x, wid = __builtin_amdgcn_readfirstlane(tid >> 6), lane = tid & 63, wr = wid >> 2, wc = wid & 3, fr = lane & 15, fq = lane >> 4;
    int K = g.K; asm volatile("" : "+s"(K));
    const int nt = K / BK;
    unsigned voffA[2], voffB[2];
#pragma unroll
    for (int i = 0; i < 2; ++i) { int R, C; stage_rc(tid * 16 + i * 8192, R, C); const int Rb = 64 * (R >> 5) + perm32(R & 31);
        voffA[i] = (unsigned)(R * K + C) * 2u; voffB[i] = (unsigned)(Rb * K + C) * 2u; }
    const unsigned kstep = (unsigned)(BK * 2);
    const unsigned hstep = (unsigned)HALF * K * 2;
    const unsigned hstepB = (unsigned)32 * K * 2;
    const unsigned rstep = (unsigned)K * 2;
    const unsigned ldsw = (unsigned)wid * 1024u;
    const int aoff = lds_byte(wr * 64 + fr, fq * 8), boff = lds_byte(wc * 32 + fr, fq * 8);
#define PG8_SA(b, h) (((b) * 2 + (h)) * HTB)
#define PG8_SB(b, h) ((4 + (b) * 2 + (h)) * HTB)
#define PG8_STAGE(bufoff, gbase, voff) do { _Pragma("unroll") for (int _i = 0; _i < 2; ++_i) \
        __builtin_amdgcn_global_load_lds((const unsigned*)((const char*)(gbase) + (voff)[_i]), (LAS unsigned*)(lds + (bufoff) + ldsw + _i * 8192), 16, 0, 0); } while (0)
#define PG8_LDA(dst, b, h) do { _Pragma("unroll") for (int m = 0; m < 4; ++m) _Pragma("unroll") for (int k = 0; k < 2; ++k) dst[m][k] = *(const LAS bf16x8*)(lds + PG8_SA(b, h) + aoff + m * 2048 + k * 1024); } while (0)
#define PG8_LDB(dst, b, h) do { _Pragma("unroll") for (int n = 0; n < 2; ++n) _Pragma("unroll") for (int k = 0; k < 2; ++k) dst[n][k] = *(const LAS bf16x8*)(lds + PG8_SB(b, h) + boff + n * 2048 + k * 1024); } while (0)
#define PG8_MMA(ai, bj, At, Bt) do { __builtin_amdgcn_s_setprio(1); _Pragma("unroll") for (int m = 0; m < 4; ++m) _Pragma("unroll") for (int n = 0; n < 2; ++n) _Pragma("unroll") for (int k = 0; k < 2; ++k) \
        acc[ai][bj][m][n] = __builtin_amdgcn_mfma_f32_16x16x32_bf16(Bt[n][k], At[m][k], acc[ai][bj][m][n], 0, 0, 0); __builtin_amdgcn_s_setprio(0); } while (0)
#define PG8_WAIT_V(n) asm volatile("s_waitcnt vmcnt(" #n ")" ::: "memory")
#define PG8_WAIT_L(n) asm volatile("s_waitcnt lgkmcnt(" #n ")" ::: "memory")
#define PG8_BAR __builtin_amdgcn_s_barrier()
#define PG8_SCHED __builtin_amdgcn_sched_barrier(0)
    Unit cur, nxt; int ui = 0;
    if (!S.next(0, cur)) return;
    f32x4 acc[2][2][4][2];
#pragma unroll
    for (int a = 0; a < 2; ++a)
#pragma unroll
        for (int b = 0; b < 2; ++b)
#pragma unroll
            for (int m = 0; m < 4; ++m)
#pragma unroll
                for (int n = 0; n < 2; ++n) acc[a][b][m][n] = (f32x4){0.f, 0.f, 0.f, 0.f};
    bf16x8 At[4][2], B0[2][2], B1[2][2];
    const char* cA = (const char*)g.A + (size_t)cur.arow * rstep; const char* cB = (const char*)g.Bt + (size_t)cur.brow * rstep;
    PG8_STAGE(PG8_SB(0, 0), cB, voffB); PG8_STAGE(PG8_SB(0, 1), cB + hstepB, voffB); PG8_STAGE(PG8_SA(0, 0), cA, voffA); PG8_STAGE(PG8_SA(0, 1), cA + hstep, voffA);
    if (wr == 1) PG8_BAR;
    PG8_WAIT_V(2); PG8_BAR;
    PG8_STAGE(PG8_SB(1, 0), cB + kstep, voffB); PG8_STAGE(PG8_SA(1, 0), cA + kstep, voffA); PG8_STAGE(PG8_SB(1, 1), cB + hstepB + kstep, voffB);
    PG8_WAIT_V(6); PG8_BAR;
    for (;;) {
        const bool has_next = S.next(ui + 1, nxt);
        const char* nA = has_next ? (const char*)g.A + (size_t)nxt.arow * rstep : cA; const char* nB = has_next ? (const char*)g.Bt + (size_t)nxt.brow * rstep : cB;
        for (int t = 0; t < nt; t += 2) {
            const bool last = (t == nt - 2);
            const char* a1 = cA + (unsigned)(t + 1) * kstep;
            const char* a2 = last ? nA : cA + (unsigned)(t + 2) * kstep; const char* b2 = last ? nB : cB + (unsigned)(t + 2) * kstep;
            const char* a3 = a2 + kstep; const char* b3 = b2 + kstep;
            PG8_LDB(B0, 0, 0); PG8_LDB(B1, 0, 1); PG8_SCHED; PG8_LDA(At, 0, 0); PG8_STAGE(PG8_SA(1, 1), a1 + hstep, voffA);
            PG8_WAIT_V(8); PG8_WAIT_L(0); PG8_BAR; PG8_MMA(0, 0, At, B0); PG8_MMA(0, 1, At, B1); PG8_BAR; PG8_SCHED;
            PG8_LDA(At, 0, 1); PG8_STAGE(PG8_SB(0, 0), b2, voffB); PG8_STAGE(PG8_SB(0, 1), b2 + hstepB, voffB); PG8_STAGE(PG8_SA(0, 0), a2, voffA);
            PG8_WAIT_V(8); PG8_WAIT_L(0); PG8_BAR; PG8_MMA(1, 0, At, B0); PG8_MMA(1, 1, At, B1); PG8_BAR; PG8_SCHED;
            PG8_LDB(B0, 1, 0); PG8_LDB(B1, 1, 1); PG8_SCHED; PG8_LDA(At, 1, 0); PG8_STAGE(PG8_SA(0, 1), a2 + hstep, voffA);
            PG8_WAIT_V(8); PG8_WAIT_L(0); PG8_BAR; PG8_MMA(0, 0, At, B0); PG8_MMA(0, 1, At, B1); PG8_BAR; PG8_SCHED;
            PG8_LDA(At, 1, 1); PG8_STAGE(PG8_SB(1, 0), b3, voffB); PG8_STAGE(PG8_SB(1, 1), b3 + hstepB, voffB); PG8_STAGE(PG8_SA(1, 0), a3, voffA);
            PG8_WAIT_V(8); PG8_WAIT_L(0); PG8_BAR; PG8_MMA(1, 0, At, B0); PG8_MMA(1, 1, At, B1); PG8_BAR; PG8_SCHED;
        }
        if (wr == 0) PG8_BAR;
        E(acc, cur, wr, wc, fr, fq);
        if (!has_next) break;
#pragma unroll
        for (int a = 0; a < 2; ++a)
#pragma unroll
            for (int b = 0; b < 2; ++b)
#pragma unroll
                for (int m = 0; m < 4; ++m)
#pragma unroll
                    for (int n = 0; n < 2; ++n) acc[a][b][m][n] = (f32x4){0.f, 0.f, 0.f, 0.f};
        cur = nxt; cA = nA; cB = nB; ++ui;
        if (wr == 1) PG8_BAR;
    }
    PG8_WAIT_V(0);
    PG8_BAR;
#undef PG8_SA
#undef PG8_SB
#undef PG8_STAGE
#undef PG8_LDA
#undef PG8_LDB
#undef PG8_MMA
#undef PG8_WAIT_V
#undef PG8_WAIT_L
#undef PG8_BAR
#undef PG8_SCHED
}
}

constexpr size_t MiB = (size_t)1 << 20;
constexpr size_t WS_CTL = 0, CTL_ZERO_BYTES = 64 * 1024;
constexpr size_t WS_WIN = 4 * MiB, WS_WOUT = 8 * MiB, WS_WPG = 10 * MiB, WS_WPP = 12 * MiB, WS_WPOOL = 12 * MiB + 512 * 1024;
constexpr size_t WS_WGU = 16 * MiB, WS_WD = 144 * MiB;
constexpr size_t WS_HH = 208 * MiB;
constexpr size_t WS_U = 208 * MiB, WS_Q = 224 * MiB, WS_K = 240 * MiB, WS_VT = 256 * MiB, WS_MIX = 272 * MiB, WS_XN = 304 * MiB;
constexpr size_t WS_PB = 336 * MiB, WS_EB = 344 * MiB, WS_H2 = 376 * MiB  , WS_XE = 408 * MiB  ;
constexpr size_t WS_AFF = 480 * MiB, WS_GATES = 481 * MiB, WS_SLOT = 482 * MiB, WS_ESQ = 483 * MiB, WS_RSTDE = 484 * MiB;
constexpr size_t WS_MEGA_END = 485 * MiB;
constexpr int CW_BAR = 1024;

constexpr int RING_BYTES = 131072, LDSCTL_OFF = RING_BYTES, MISC_OFF = LDSCTL_OFF + 320, LDS_BYTES = 147456;

#define XB_TMO      128
#define XB_XCNT(j)  (256  + 64 * (j))
#define XB_XSUB(j)  (1280 + 64 * (j))
#define XB_XGEN(j)  (2304 + 64 * (j))
#define XB_TOP      3328
#define XB_TOPGEN   3392
#define XCD_BAR_WORDS 3456
#define XB_SPIN_CAP (1u << 18)
__device__ __forceinline__ unsigned xb_ld(unsigned* p)              { return __hip_atomic_load(p, __ATOMIC_RELAXED, __HIP_MEMORY_SCOPE_AGENT); }
__device__ __forceinline__ unsigned xb_add(unsigned* p, unsigned v) { return __hip_atomic_fetch_add(p, v, __ATOMIC_RELAXED, __HIP_MEMORY_SCOPE_AGENT); }
__device__ __forceinline__ unsigned xb_xcc_id() { return (unsigned)__builtin_amdgcn_s_getreg((3 << 11) | 20) & 0xFu; }
#define XB_SPIN(cond, bar) do { unsigned _sp = 0; while (cond) { __builtin_amdgcn_s_sleep(1); \
    if ((++_sp & 255u) == 0u) { if (xb_ld(&(bar)[XB_TMO])) break; if (_sp > XB_SPIN_CAP) { atomicAdd(&(bar)[XB_TMO], 1u); break; } } } } while (0)
__device__ __forceinline__ void xcd_barrier_post(unsigned* bar) { if (threadIdx.x == 0) (void)xb_add(&bar[XB_XCNT(xb_xcc_id())], 1u); }
__device__ __forceinline__ void xcd_barrier_complete(unsigned* bar, unsigned x, unsigned& nloc, unsigned& nx) {
    const unsigned G = gridDim.x * gridDim.y * gridDim.z;
    unsigned sum, cnt, mine, sp = 0u;
    for (;;) {
        sum = 0u; cnt = 0u; mine = 0u;
#pragma unroll
        for (unsigned j = 0; j < 16; ++j) { const unsigned c = xb_ld(&bar[XB_XCNT(j)]); sum += c; cnt += (c > 0u) ? 1u : 0u; mine = (j == x) ? c : mine; }
        if (sum == G) break;
        __builtin_amdgcn_s_sleep(1);
        if ((++sp & 255u) == 0u) { if (xb_ld(&bar[XB_TMO])) break; if (sp > XB_SPIN_CAP) { atomicAdd(&bar[XB_TMO], 1u); break; } }
    }
    nloc = mine > 0u ? mine : 1u; nx = cnt > 0u ? cnt : 1u;
}
__device__ __forceinline__ void xcd_barrier(unsigned* bar, volatile LAS unsigned* st) {
    asm volatile("s_waitcnt vmcnt(0)" ::: "memory");
    __syncthreads();
    if (threadIdx.x == 0) {
        const unsigned x = xb_xcc_id();
        __builtin_amdgcn_s_waitcnt(0);
        unsigned nloc = st[0], nx = st[1];
        if (nloc == 0u) { xcd_barrier_complete(bar, x, nloc, nx); st[0] = nloc; st[1] = nx; }
        const unsigned old = xb_add(&bar[XB_XSUB(x)], 1u);
        const unsigned gen = old / nloc;
        if (old + 1u == (gen + 1u) * nloc) {
            __builtin_amdgcn_fence(__ATOMIC_RELEASE, "agent");
            asm volatile("s_waitcnt vmcnt(0)" ::: "memory");
            const unsigned og = xb_add(&bar[XB_TOP], 1u);
            const unsigned tg = og / nx;
            if (og + 1u == (tg + 1u) * nx) xb_add(&bar[XB_TOPGEN], 1u);
            else XB_SPIN(xb_ld(&bar[XB_TOPGEN]) == tg, bar);
            __builtin_amdgcn_fence(__ATOMIC_ACQUIRE, "agent");
            xb_add(&bar[XB_XGEN(x)], 1u);
            asm volatile("s_waitcnt vmcnt(0)" ::: "memory");
        } else {
            XB_SPIN(xb_ld(&bar[XB_XGEN(x)]) == gen, bar);
            __builtin_amdgcn_fence(__ATOMIC_ACQUIRE, "agent");
            asm volatile("s_waitcnt vmcnt(0)" ::: "memory");
        }
    }
    __syncthreads();
}

struct MArgs { const float* in[19]; float* out; unsigned char* ws; int ph_lo, ph_hi; };
struct Frame {
    LAS unsigned char* lds; int tid, lane, wave, vcu, G;
    float* out; unsigned char* ws; const MArgs* a;
};
#define F_x (F.a->in[0])
#define F_p (F.a->in[1])
#define F_norm_mix (F.a->in[2])
#define F_w_in (F.a->in[3])
#define F_w_pool (F.a->in[4])
#define F_pool_scale (F.a->in[5])
#define F_q_norm (F.a->in[6])
#define F_k_norm (F.a->in[7])
#define F_rpb (F.a->in[8])
#define F_w_out (F.a->in[9])
#define F_norm_ffn (F.a->in[10])
#define F_w_router (F.a->in[11])
#define F_w_gate (F.a->in[12])
#define F_w_up (F.a->in[13])
#define F_w_down (F.a->in[14])
#define F_norm_ple (F.a->in[15])
#define F_w_ple_gate (F.a->in[16])
#define F_w_ple_proj (F.a->in[17])
#define F_norm_ple_post (F.a->in[18])
#define WSP(T, off) ((T*)(F.ws + (off)))

__device__ __forceinline__ void tr_item(const float* W, int K, int N, bf16_t* WT, int kb, int nb, int dst_row0, LAS float* scr, int lane) {
    const int k0 = 64 * kb, n0 = 32 * nb;
#pragma unroll 8
    for (int i = 0; i < 32; ++i) { const int kk = 2 * i + (lane >> 5); scr[kk * 33 + (lane & 31)] = W[(size_t)(k0 + kk) * N + n0 + (lane & 31)]; }
    asm volatile("s_waitcnt lgkmcnt(0)" ::: "memory");
    const int c = lane & 7;
#pragma unroll
    for (int j = 0; j < 4; ++j) { const int n = (lane >> 3) + 8 * j; const LAS float* s = scr + (8 * c) * 33 + n;
        u32x4 o; o.x = pkbf(s[0 * 33], s[1 * 33]); o.y = pkbf(s[2 * 33], s[3 * 33]); o.z = pkbf(s[4 * 33], s[5 * 33]); o.w = pkbf(s[6 * 33], s[7 * 33]);
        *(u32x4*)(WT + (size_t)(dst_row0 + n) * K + k0 + 8 * c) = o; }
    asm volatile("s_waitcnt lgkmcnt(0)" ::: "memory");
}
__device__ __forceinline__ void rms_row_to_bf16(const float* xrow, const float* g, bf16_t* orow, int lane) {
    const f32x4* xr = (const f32x4*)xrow + lane; const f32x4* gr = (const f32x4*)g + lane;
    f32x4 v[4]; float s = 0.f;
#pragma unroll
    for (int j = 0; j < 4; ++j) { v[j] = xr[64 * j]; s += (v[j].x * v[j].x + v[j].y * v[j].y) + (v[j].z * v[j].z + v[j].w * v[j].w); }
    const float rstd = 1.0f / sqrtf(wave_sum(s) * (1.0f / D) + EPS);
    u32x2* o8 = (u32x2*)orow + lane;
#pragma unroll
    for (int j = 0; j < 4; ++j) { const f32x4 gg = gr[64 * j]; u32x2 o; o.x = pkbf(v[j].x * rstd * gg.x, v[j].y * rstd * gg.y); o.y = pkbf(v[j].z * rstd * gg.z, v[j].w * rstd * gg.w); o8[64 * j] = o; }
}
__device__ __forceinline__ void p0_prologue(Frame& F) {
    LAS float* scr = (LAS float*)(F.lds + F.wave * 16384);
    const int gw = F.vcu * 8 + F.wave, NGW = F.G * 8;
    constexpr int I_IN = 16 * 64, I_OUT = 16 * 32, I_PG = 16 * 32, I_PP = 4 * 32, I_E = 1024;
    constexpr int NSMALL = I_IN + I_OUT + I_PG + I_PP, NITEMS = NSMALL + 3 * 16 * I_E;
    bf16_t* Win_t = WSP(bf16_t, WS_WIN); bf16_t* Wout_t = WSP(bf16_t, WS_WOUT); bf16_t* Wpg_t = WSP(bf16_t, WS_WPG); bf16_t* Wpp_t = WSP(bf16_t, WS_WPP);
    bf16_t* Wgu_t = WSP(bf16_t, WS_WGU); bf16_t* Wd_t = WSP(bf16_t, WS_WD);
    for (int it = gw; it < NITEMS; it += NGW) {
        int r = it;
        if (r < I_IN) { tr_item(F_w_in, 1024, 2048, Win_t, r / 64, r % 64, 32 * (r % 64), scr, F.lane); continue; } r -= I_IN;
        if (r < I_OUT) { tr_item(F_w_out, 1024, 1024, Wout_t, r / 32, r % 32, 32 * (r % 32), scr, F.lane); continue; } r -= I_OUT;
        if (r < I_PG) { tr_item(F_w_ple_gate, 1024, 1024, Wpg_t, r / 32, r % 32, 32 * (r % 32), scr, F.lane); continue; } r -= I_PG;
        if (r < I_PP) { tr_item(F_w_ple_proj, 256, 1024, Wpp_t, r / 32, r % 32, 32 * (r % 32), scr, F.lane); continue; } r -= I_PP;
        const int mat = r / (16 * I_E), e = (r / I_E) % 16, q = r % I_E;
        if (mat < 2) {
            const int kb = q / 64, nb = q % 64, n0 = 32 * nb;
            tr_item((mat == 0 ? F_w_gate : F_w_up) + (size_t)e * 1024 * 2048, 1024, 2048, Wgu_t, kb, nb, e * 4096 + (n0 >> 7) * 256 + ((n0 >> 5) & 3) * 64 + 32 * mat, scr, F.lane);
        } else {
            const int kb = q / 32, nb = q % 32;
            tr_item(F_w_down + (size_t)e * 2048 * 1024, 2048, 1024, Wd_t, kb, nb, e * 1024 + 32 * nb, scr, F.lane);
        }
    }
    bf16_t* XN = WSP(bf16_t, WS_XN);
    for (int m = gw; m < T; m += NGW) rms_row_to_bf16(F_x + (size_t)m * D, F_norm_mix, XN + (size_t)m * D, F.lane);
    { const int gt = F.vcu * 512 + F.tid, NT_ = F.G * 512; const f32x4* p4 = (const f32x4*)F_p; u32x2* o = WSP(u32x2, WS_PB);
      for (int i = gt; i < T * PD / 4; i += NT_) { const f32x4 v = p4[i]; u32x2 w; w.x = pkbf(v.x, v.y); w.y = pkbf(v.z, v.w); o[i] = w; }
      bf16_t* Wp = WSP(bf16_t, WS_WPOOL);
      for (int i = gt; i < 4 * 128 * 128; i += NT_) { const int gg = i >> 14, n = (i >> 7) & 127, k = i & 127; const float v = F_w_pool[(gg * 128 + k) * 128 + n] * F_pool_scale[gg * 128 + n]; Wp[i] = (bf16_t)(pkbf(v, 0.f) & 0xffffu); }
    }
}

typedef f32x4 AccT[2][2][4][2];
struct EpiQKV {
    bf16_t *U, *Q, *Kk, *VT; const float *qn, *kn;
    __device__ __forceinline__ void operator()(const AccT& acc, const pg8::Unit& u, int wr, int wc, int fr_, int fq_) const {
        int fr = fr_, fq = fq_; asm volatile("" : "+v"(fr), "+v"(fq));
        const int type = u.pn >> 1; const int row0 = u.pm * 256 + wr * 64 + fr;
        if (type == 0) {
#pragma unroll
            for (int ai = 0; ai < 2; ++ai)
#pragma unroll
                for (int m = 0; m < 4; ++m) { const int row = row0 + ai * 128 + m * 16; bf16_t* rp = U + (size_t)row * 512 + (u.pn & 1) * 256 + wc * 64 + 8 * fq;
#pragma unroll
                    for (int bj = 0; bj < 2; ++bj) { const f32x4 v0 = acc[ai][bj][m][0], v1 = acc[ai][bj][m][1]; u32x4 w; w.x = pkbf(v0[0], v0[1]); w.y = pkbf(v0[2], v0[3]); w.z = pkbf(v1[0], v1[1]); w.w = pkbf(v1[2], v1[3]); *(u32x4*)(rp + bj * 32) = w; } asm volatile("" ::: "memory"); }
        } else if (type == 3) {
            const int hh = (u.pn & 1) * 4 + wc;
#pragma unroll
            for (int ai = 0; ai < 2; ++ai)
#pragma unroll
                for (int m = 0; m < 4; ++m) { const int row = row0 + ai * 128 + m * 16; const int b = row >> 11, s = row & 2047; bf16_t* bp = VT + ((size_t)(b * 8 + hh) * 64) * 2048 + s;
#pragma unroll
                    for (int bj = 0; bj < 2; ++bj)
#pragma unroll
                        for (int n = 0; n < 2; ++n)
#pragma unroll
                            for (int i = 0; i < 4; ++i) { const int d = 32 * bj + 8 * fq + 4 * n + i; bp[(size_t)d * 2048] = (bf16_t)(pkbf(acc[ai][bj][m][n][i], 0.f) & 0xffffu); }
                    asm volatile("" ::: "memory"); }
        } else {
            const int hh = (u.pn & 1) * 4 + wc; const float* gn = (type == 1) ? qn : kn; const float sc = (type == 1) ? 0.125f * LOG2E : 1.0f; bf16_t* dst = (type == 1) ? Q : Kk;
            f32x4 gv[2][2];
#pragma unroll
            for (int bj = 0; bj < 2; ++bj)
#pragma unroll
                for (int n = 0; n < 2; ++n) gv[bj][n] = *(const f32x4*)(gn + 32 * bj + 8 * fq + 4 * n) * sc;
#pragma unroll
            for (int ai = 0; ai < 2; ++ai)
#pragma unroll
                for (int m = 0; m < 4; ++m) { const int row = row0 + ai * 128 + m * 16; const int b = row >> 11, s = row & 2047;
                    float ss = 0.f;
#pragma unroll
                    for (int bj = 0; bj < 2; ++bj)
#pragma unroll
                        for (int n = 0; n < 2; ++n) { const f32x4 v = acc[ai][bj][m][n]; ss += (v[0] * v[0] + v[1] * v[1]) + (v[2] * v[2] + v[3] * v[3]); }
                    ss += __shfl_xor(ss, 16); ss += __shfl_xor(ss, 32);
                    const float rstd = 1.0f / sqrtf(ss * (1.0f / 64.0f) + EPS);
                    bf16_t* rp = dst + ((size_t)(b * 8 + hh) * 2048 + s) * 64 + 8 * fq;
#pragma unroll
                    for (int bj = 0; bj < 2; ++bj) { const f32x4 v0 = acc[ai][bj][m][0] * gv[bj][0] * rstd, v1 = acc[ai][bj][m][1] * gv[bj][1] * rstd; u32x4 w; w.x = pkbf(v0[0], v0[1]); w.y = pkbf(v0[2], v0[3]); w.z = pkbf(v1[0], v1[1]); w.w = pkbf(v1[2], v1[3]); *(u32x4*)(rp + bj * 32) = w; } asm volatile("" ::: "memory"); }
        }
    }
};
struct EpiE {
    bf16_t* EB; float* esq;
    __device__ __forceinline__ void operator()(const AccT& acc, const pg8::Unit& u, int wr, int wc, int fr_, int fq_) const {
        int fr = fr_, fq = fq_; asm volatile("" : "+v"(fr), "+v"(fq));
        const int row0 = u.pm * 256 + wr * 64 + fr;
#pragma unroll
        for (int ai = 0; ai < 2; ++ai)
#pragma unroll
            for (int m = 0; m < 4; ++m) { const int row = row0 + ai * 128 + m * 16; bf16_t* rp = EB + (size_t)row * 1024 + u.pn * 256 + wc * 64 + 8 * fq; float ss = 0.f;
#pragma unroll
                for (int bj = 0; bj < 2; ++bj) { const f32x4 v0 = acc[ai][bj][m][0], v1 = acc[ai][bj][m][1];
                    ss += (v0[0] * v0[0] + v0[1] * v0[1]) + (v0[2] * v0[2] + v0[3] * v0[3]) + (v1[0] * v1[0] + v1[1] * v1[1]) + (v1[2] * v1[2] + v1[3] * v1[3]);
                    u32x4 w; w.x = pkbf(v0[0], v0[1]); w.y = pkbf(v0[2], v0[3]); w.z = pkbf(v1[0], v1[1]); w.w = pkbf(v1[2], v1[3]); *(u32x4*)(rp + bj * 32) = w; }
                ss += __shfl_xor(ss, 16); ss += __shfl_xor(ss, 32);
                if (fq == 0) esq[(size_t)row * 16 + u.pn * 4 + wc] = ss; asm volatile("" ::: "memory"); }
    }
};
struct EpiRes {
    const float* x; float* out;
    __device__ __forceinline__ void operator()(const AccT& acc, const pg8::Unit& u, int wr, int wc, int fr_, int fq_) const {
        int fr = fr_, fq = fq_; asm volatile("" : "+v"(fr), "+v"(fq));
        const int row0 = u.pm * 256 + wr * 64 + fr; const int col0 = u.pn * 256 + wc * 64 + 8 * fq;
#pragma unroll
        for (int ai = 0; ai < 2; ++ai)
#pragma unroll
            for (int m = 0; m < 4; ++m) { const size_t off = (size_t)(row0 + ai * 128 + m * 16) * 1024 + col0;
#pragma unroll
                for (int bj = 0; bj < 2; ++bj)
#pragma unroll
                    for (int n = 0; n < 2; ++n) { const f32x4 xv = *(const f32x4*)(x + off + bj * 32 + n * 4); *(f32x4*)(out + off + bj * 32 + n * 4) = xv + acc[ai][bj][m][n]; }
                if (m & 1) asm volatile("" ::: "memory"); }
    }
};
struct EpiGU {
    bf16_t* HH;
    __device__ __forceinline__ void operator()(const AccT& acc, const pg8::Unit& u, int wr, int wc, int fr_, int fq_) const {
        int fr = fr_, fq = fq_; asm volatile("" : "+v"(fr), "+v"(fq));
        const int row0 = u.arow + wr * 64 + fr; const int col0 = u.pn * 128 + wc * 32 + 8 * fq;
#pragma unroll
        for (int ai = 0; ai < 2; ++ai)
#pragma unroll
            for (int m = 0; m < 4; ++m) { float h[8];
#pragma unroll
                for (int n = 0; n < 2; ++n)
#pragma unroll
                    for (int i = 0; i < 4; ++i) { const float a = acc[ai][0][m][n][i], b = acc[ai][1][m][n][i]; h[4 * n + i] = a * __builtin_amdgcn_rcpf(1.0f + __builtin_amdgcn_exp2f(-LOG2E * a)) * b; }
                u32x4 w; w.x = pkbf(h[0], h[1]); w.y = pkbf(h[2], h[3]); w.z = pkbf(h[4], h[5]); w.w = pkbf(h[6], h[7]);
                *(u32x4*)(HH + (size_t)(row0 + ai * 128 + m * 16) * 2048 + col0) = w; }
    }
};
struct EpiDown {
    bf16_t* YE; const float* gates;
    __device__ __forceinline__ void operator()(const AccT& acc, const pg8::Unit& u, int wr, int wc, int fr_, int fq_) const {
        int fr = fr_, fq = fq_; asm volatile("" : "+v"(fr), "+v"(fq));
        const int row0 = u.arow + wr * 64 + fr; const int col0 = u.pn * 256 + wc * 64 + 8 * fq;
#pragma unroll
        for (int ai = 0; ai < 2; ++ai)
#pragma unroll
            for (int m = 0; m < 4; ++m) { const int row = row0 + ai * 128 + m * 16; const float gt = gates[row]; bf16_t* rp = YE + (size_t)row * 1024 + col0;
#pragma unroll
                for (int bj = 0; bj < 2; ++bj) { const f32x4 v0 = acc[ai][bj][m][0] * gt, v1 = acc[ai][bj][m][1] * gt; u32x4 w; w.x = pkbf(v0[0], v0[1]); w.y = pkbf(v0[2], v0[3]); w.z = pkbf(v1[0], v1[1]); w.w = pkbf(v1[2], v1[3]); *(u32x4*)(rp + bj * 32) = w; } }
    }
};
struct EpiFinal {
    float* out; const bf16_t* EB; const float* rstde; const float* gpost;
    __device__ __forceinline__ void operator()(const AccT& acc, const pg8::Unit& u, int wr, int wc, int fr_, int fq_) const {
        int fr = fr_, fq = fq_; asm volatile("" : "+v"(fr), "+v"(fq));
        const int row0 = u.pm * 256 + wr * 64 + fr; const int col0 = u.pn * 256 + wc * 64 + 8 * fq;
        f32x4 gp[2][2];
#pragma unroll
        for (int bj = 0; bj < 2; ++bj)
#pragma unroll
            for (int n = 0; n < 2; ++n) gp[bj][n] = *(const f32x4*)(gpost + col0 + bj * 32 + n * 4);
#pragma unroll
        for (int ai = 0; ai < 2; ++ai)
#pragma unroll
            for (int m = 0; m < 4; ++m) { const int row = row0 + ai * 128 + m * 16; const size_t off = (size_t)row * 1024 + col0; const float re = rstde[row];
#pragma unroll
                for (int bj = 0; bj < 2; ++bj) { const u32x4 ev = *(const u32x4*)(EB + off + bj * 32);
                    const f32x4 e0 = (f32x4){bflo(ev.x), bfhi(ev.x), bflo(ev.y), bfhi(ev.y)} * gp[bj][0] * re, e1 = (f32x4){bflo(ev.z), bfhi(ev.z), bflo(ev.w), bfhi(ev.w)} * gp[bj][1] * re;
                    const f32x4 a0 = acc[ai][bj][m][0], a1 = acc[ai][bj][m][1]; f32x4 g0, g1;
#pragma unroll
                    for (int i = 0; i < 4; ++i) { g0[i] = __builtin_amdgcn_rcpf(1.0f + __builtin_amdgcn_exp2f(-LOG2E * a0[i])); g1[i] = __builtin_amdgcn_rcpf(1.0f + __builtin_amdgcn_exp2f(-LOG2E * a1[i])); }
                    const f32x4 x0 = *(const f32x4*)(out + off + bj * 32), x1 = *(const f32x4*)(out + off + bj * 32 + 4);
                    *(f32x4*)(out + off + bj * 32) = x0 + g0 * e0; *(f32x4*)(out + off + bj * 32 + 4) = x1 + g1 * e1; }
                asm volatile("" ::: "memory"); }
    }
};
struct OrderGU {
    int G, vcu;
    __device__ bool next(int i, pg8::Unit& u) const {
        int e, b, nt;
        if (G == 256) { if (i >= 8) return false; const int x = vcu >> 5, cu = vcu & 31; e = 2 * x + (i >> 2); b = cu & 7; nt = 4 * (i & 3) + (cu >> 3); }
        else { const int L = i * G + vcu; if (L >= 2048) return false; e = L >> 7; b = L & 7; nt = (L >> 3) & 15; }
        u.arow = (b * 16 + e) * 256; u.brow = e * 4096 + nt * 256; u.pm = b; u.pn = nt; u.grp = e; return true;
    }
};
struct OrderDown {
    int G, vcu;
    __device__ bool next(int i, pg8::Unit& u) const {
        int e, b, nt;
        if (G == 256) { if (i >= 2) return false; const int x = vcu >> 5, cu = vcu & 31; e = 2 * x + i; b = cu & 7; nt = cu >> 3; }
        else { const int L = i * G + vcu; if (L >= 512) return false; e = L >> 5; b = L & 7; nt = (L >> 3) & 3; }
        u.arow = (b * 16 + e) * 256; u.brow = e * 1024 + nt * 256; u.pm = b; u.pn = nt; u.grp = e; return true;
    }
};

constexpr int B2_OFF = 1024;
constexpr int DT_OFF = 32768, DT_PITCH = 136;
__device__ __forceinline__ void attn_task(Frame& F, int bh, int r, int qb) {
    const int lane = F.lane, g = lane >> 4, m = lane & 15; const int b = bh >> 3, h = bh & 7;
    int rs = r - 4; rs = rs < 0 ? 0 : (rs > ROWS - 8 ? ROWS - 8 : rs);
    const int c = 16 * qb + m; int cs = c - 8; cs = cs < 0 ? 0 : (cs > GW - 16 ? GW - 16 : cs);
    const bf16_t* Qb = WSP(const bf16_t, WS_Q); const bf16_t* Kb = WSP(const bf16_t, WS_K); const bf16_t* Vb = WSP(const bf16_t, WS_VT);
    const bf16_t* Qp = Qb + ((size_t)(bh * 2048 + 64 * r + c) * 64 + 8 * g);
    const bf16x8 qf0 = *(const bf16x8*)Qp, qf1 = *(const bf16x8*)(Qp + 32);
    const int kp_lo = (qb == 3) ? 1 : 0, kp_hi = (qb == 0) ? 0 : 1;
    f32x4 o[4];
#pragma unroll
    for (int dt = 0; dt < 4; ++dt) o[dt] = (f32x4){0.f, 0.f, 0.f, 0.f};
    float lsum = 0.f;
    const int rowa = 8 * (m >> 2) + (m & 3);
    const LAS float* b2 = (const LAS float*)(F.lds + B2_OFF);
    for (int i = 0; i < 8; ++i) {
        const int rk = rs + i, dr = rk - r + 7;
        for (int kp = kp_lo; kp <= kp_hi; ++kp) {
            const bf16_t* Kp = Kb + ((size_t)(bh * 2048 + 64 * rk + 32 * kp + rowa) * 64 + 8 * g);
            const bf16x8 ka0 = *(const bf16x8*)Kp, ka1 = *(const bf16x8*)(Kp + 32), kb0 = *(const bf16x8*)(Kp + 256), kb1 = *(const bf16x8*)(Kp + 256 + 32);
            const bf16_t* Vp = Vb + ((size_t)(bh * 64 + m) * 2048 + 64 * rk + 32 * kp + 8 * g);
            bf16x8 vf[4];
#pragma unroll
            for (int dt = 0; dt < 4; ++dt) vf[dt] = *(const bf16x8*)(Vp + (size_t)dt * 16 * 2048);
            f32x4 sa = (f32x4){0.f, 0.f, 0.f, 0.f}, sb = (f32x4){0.f, 0.f, 0.f, 0.f};
            sa = __builtin_amdgcn_mfma_f32_16x16x32_bf16(ka0, qf0, sa, 0, 0, 0); sa = __builtin_amdgcn_mfma_f32_16x16x32_bf16(ka1, qf1, sa, 0, 0, 0);
            sb = __builtin_amdgcn_mfma_f32_16x16x32_bf16(kb0, qf0, sb, 0, 0, 0); sb = __builtin_amdgcn_mfma_f32_16x16x32_bf16(kb1, qf1, sb, 0, 0, 0);
            const int kc0 = 32 * kp + 8 * g;
            const LAS float* bp = b2 + ((h * 15 + dr) * 32 + 15 - c + kc0);
            float pa[4], pb[4];
#pragma unroll
            for (int q = 0; q < 4; ++q) {
                const bool va = (unsigned)(kc0 + q - cs) < 16u, vb = (unsigned)(kc0 + 4 + q - cs) < 16u;
                const float ea = __builtin_amdgcn_exp2f(sa[q] + bp[q]), eb = __builtin_amdgcn_exp2f(sb[q] + bp[4 + q]);
                pa[q] = va ? ea : 0.f; pb[q] = vb ? eb : 0.f; }
            lsum += ((pa[0] + pa[1]) + (pa[2] + pa[3])) + ((pb[0] + pb[1]) + (pb[2] + pb[3]));
            u32x4 pw; pw.x = pkbf(pa[0], pa[1]); pw.y = pkbf(pa[2], pa[3]); pw.z = pkbf(pb[0], pb[1]); pw.w = pkbf(pb[2], pb[3]);
            const bf16x8 pf = __builtin_bit_cast(bf16x8, pw);
#pragma unroll
            for (int dt = 0; dt < 4; ++dt) o[dt] = __builtin_amdgcn_mfma_f32_16x16x32_bf16(vf[dt], pf, o[dt], 0, 0, 0);
        }
    }
    lsum += __shfl_xor(lsum, 16); lsum += __shfl_xor(lsum, 32);
    const float inv = 1.0f / lsum;
    bf16_t* op = WSP(bf16_t, WS_MIX) + (size_t)(b * 2048 + 64 * r + c) * 1024 + 512 + h * 64 + 4 * g;
#pragma unroll
    for (int dt = 0; dt < 4; ++dt) { u32x2 w; w.x = pkbf(o[dt][0] * inv, o[dt][1] * inv); w.y = pkbf(o[dt][2] * inv, o[dt][3] * inv); *(u32x2*)(op + 16 * dt) = w; }
}
__device__ __forceinline__ void pool_unit(Frame& F, int pm, int grp) {
    LAS bf16_t* Dt = (LAS bf16_t*)(F.lds + DT_OFF);
    const int tid = F.tid;
    {
        const int c = tid & 127, seg = tid >> 7; const int w = 2 << grp, hw = w >> 1;
        const int tok0 = pm * 256, b = tok0 >> 11, t0 = (tok0 & 2047) + seg * 64;
        const bf16_t* Ub = WSP(const bf16_t, WS_U) + (size_t)b * 2048 * 512 + grp * 128 + c;
        float s = 0.f;
        for (int q = t0 - hw; q <= t0 + hw - 1; ++q) if (q >= 0 && q < S) s += bf2f(Ub[(size_t)q * 512]);
        for (int k = 0; k < 64; ++k) { const int t = t0 + k; const int lo = (t - hw) < 0 ? 0 : (t - hw), hi = (t + hw - 1) > (S - 1) ? (S - 1) : (t + hw - 1);
            const float ut = bf2f(Ub[(size_t)t * 512]); const float d = s / (float)(hi - lo + 1) - ut;
            Dt[(seg * 64 + k) * DT_PITCH + c] = (bf16_t)(pkbf(d, 0.f) & 0xffffu);
            if (t + hw <= S - 1) s += bf2f(Ub[(size_t)(t + hw) * 512]);
            if (t - hw >= 0) s -= bf2f(Ub[(size_t)(t - hw) * 512]); }
    }
    __syncthreads();
    {
        const int lane = F.lane, g = lane >> 4, m = lane & 15, w = F.wave;
        const bf16_t* Wp = WSP(const bf16_t, WS_WPOOL) + (size_t)grp * 128 * 128;
        f32x4 acc[2][8];
#pragma unroll
        for (int mt = 0; mt < 2; ++mt)
#pragma unroll
            for (int nt = 0; nt < 8; ++nt) acc[mt][nt] = (f32x4){0.f, 0.f, 0.f, 0.f};
#pragma unroll
        for (int ks = 0; ks < 4; ++ks) { bf16x8 af[2];
#pragma unroll
            for (int mt = 0; mt < 2; ++mt) af[mt] = *(const LAS bf16x8*)(Dt + (32 * w + 16 * mt + m) * DT_PITCH + 32 * ks + 8 * g);
#pragma unroll
            for (int nt = 0; nt < 8; ++nt) { const bf16x8 wf = *(const bf16x8*)(Wp + (size_t)(16 * nt + m) * 128 + 32 * ks + 8 * g);
#pragma unroll
                for (int mt = 0; mt < 2; ++mt) acc[mt][nt] = __builtin_amdgcn_mfma_f32_16x16x32_bf16(wf, af[mt], acc[mt][nt], 0, 0, 0); } }
        bf16_t* mix = WSP(bf16_t, WS_MIX);
#pragma unroll
        for (int mt = 0; mt < 2; ++mt)
#pragma unroll
            for (int nt = 0; nt < 8; ++nt) { u32x2 o; o.x = pkbf(acc[mt][nt][0], acc[mt][nt][1]); o.y = pkbf(acc[mt][nt][2], acc[mt][nt][3]);
                *(u32x2*)(mix + (size_t)(pm * 256 + 32 * w + 16 * mt + m) * 1024 + grp * 128 + 16 * nt + 4 * g) = o; }
    }
    __syncthreads();
}
__device__ __forceinline__ void p2_mixer(Frame& F) {
    LAS float* b2 = (LAS float*)(F.lds + B2_OFF);
    for (int i = F.tid; i < 8 * 15 * 32; i += 512) { const int dc = i & 31, hd = i >> 5; b2[i] = dc < 31 ? F_rpb[hd * 31 + dc] * LOG2E : 0.f; }
    __syncthreads();
    const int gw = F.vcu * 8 + F.wave, NGW = F.G * 8;
    for (int wt = gw; wt < B * AH * ROWS * 4; wt += NGW) attn_task(F, wt >> 7, (wt >> 2) & 31, wt & 3);
    for (int u = F.vcu; u < 64 * 4; u += F.G) pool_unit(F, u >> 2, u & 3);
}

__device__ __forceinline__ void p4_router(Frame& F) {
    LAS float* wt = (LAS float*)F.lds;
    for (int i = F.tid; i < D * NE; i += 512) wt[(i & 15) * D + (i >> 4)] = F_w_router[i];
    __syncthreads();
    const int gw = F.vcu * 8 + F.wave, NGW = F.G * 8, lane = F.lane;
    bf16_t* H2 = WSP(bf16_t, WS_H2); float* aff = WSP(float, WS_AFF);
    for (int row = gw; row < T; row += NGW) {
        const f32x4* xr = (const f32x4*)(F.out + (size_t)row * D) + lane; const f32x4* gr = (const f32x4*)F_norm_ffn + lane;
        f32x4 v[4]; float s = 0.f;
#pragma unroll
        for (int j = 0; j < 4; ++j) { v[j] = xr[64 * j]; s += (v[j].x * v[j].x + v[j].y * v[j].y) + (v[j].z * v[j].z + v[j].w * v[j].w); }
        const float rstd = 1.0f / sqrtf(wave_sum(s) * (1.0f / D) + EPS);
        u32x2* o8 = (u32x2*)(H2 + (size_t)row * D) + lane;
#pragma unroll
        for (int j = 0; j < 4; ++j) { v[j] = v[j] * rstd * gr[64 * j]; u32x2 o; o.x = pkbf(v[j].x, v[j].y); o.y = pkbf(v[j].z, v[j].w); o8[64 * j] = o; }
        float lg[16];
#pragma unroll
        for (int e = 0; e < 16; ++e) { float a = 0.f;
#pragma unroll
            for (int j = 0; j < 4; ++j) { const f32x4 w4 = *(const LAS f32x4*)(wt + e * D + 256 * j + 4 * lane); a += (v[j].x * w4.x + v[j].y * w4.y) + (v[j].z * w4.z + v[j].w * w4.w); }
            lg[e] = wave_sum(a); if (e & 1) asm volatile("" ::: "memory"); }
        float mx = lg[0];
#pragma unroll
        for (int e = 1; e < 16; ++e) mx = fmaxf(mx, lg[e]);
        float sum = 0.f, mine = 0.f;
#pragma unroll
        for (int e = 0; e < 16; ++e) { const float ex = expf(lg[e] - mx); sum += ex; mine = (lane == e) ? ex : mine; }
        if (lane < 16) aff[((size_t)(row >> 11) * NE + lane) * S + (row & 2047)] = mine / sum;
    }
}

__device__ __forceinline__ void p5_topk_gather(Frame& F) {
    LAS int* sidx = (LAS int*)F.lds;
    const int lane = F.lane; const float* aff = WSP(const float, WS_AFF); float* gates = WSP(float, WS_GATES); int* slot_of = WSP(int, WS_SLOT);
    const bf16_t* H2 = WSP(const bf16_t, WS_H2); bf16_t* XE = WSP(bf16_t, WS_XE);
    for (int task = F.vcu; task < B * NE * 2; task += F.G) {
        const int be = task >> 1, half = task & 1, b = be >> 4, e = be & 15;
        if (F.wave == 0) {
            unsigned v[32];
#pragma unroll
            for (int j = 0; j < 32; ++j) v[j] = __builtin_bit_cast(unsigned, aff[(size_t)be * S + 64 * j + lane]);
            unsigned Tt = 0u;
            for (int bit = 30; bit >= 0; --bit) { const unsigned cand = Tt | (1u << bit); int cnt = 0;
#pragma unroll
                for (int j = 0; j < 32; ++j) cnt += (v[j] >= cand) ? 1 : 0;
#pragma unroll
                for (int o = 1; o < 64; o <<= 1) cnt += __shfl_xor(cnt, o);
                if (cnt >= CAP) Tt = cand; }
            int ngt = 0;
#pragma unroll
            for (int j = 0; j < 32; ++j) ngt += (v[j] > Tt) ? 1 : 0;
#pragma unroll
            for (int o = 1; o < 64; o <<= 1) ngt += __shfl_xor(ngt, o);
            const int need = CAP - ngt; int eq_run = 0, sel_run = 0;
            const unsigned long long ltmask = (lane == 0) ? 0ull : (~0ull >> (64 - lane));
#pragma unroll
            for (int j = 0; j < 32; ++j) {
                const bool gt = v[j] > Tt, eq = v[j] == Tt;
                const unsigned long long em = __ballot(eq);
                const int eqb = eq_run + __popcll(em & ltmask);
                const bool sel = gt || (eq && eqb < need);
                eq_run += __popcll(em);
                const unsigned long long sm = __ballot(sel);
                const int slot = sel_run + __popcll(sm & ltmask);
                sel_run += __popcll(sm);
                const int tok = 64 * j + lane;
                if (sel) sidx[slot] = tok;
                if (half == 0) { if (sel) gates[be * CAP + slot] = __builtin_bit_cast(float, v[j]); slot_of[((size_t)b * S + tok) * NE + e] = sel ? slot : -1; }
            }
        }
        __syncthreads();
        for (int i = 0; i < 16; ++i) { const int slot = half * 128 + F.wave * 16 + i; const int tok = sidx[slot];
            const u32x4* src = (const u32x4*)(H2 + ((size_t)b * S + tok) * D) + lane; u32x4* dst = (u32x4*)(XE + ((size_t)be * CAP + slot) * D) + lane;
            const u32x4 a0 = src[0], a1 = src[64]; dst[0] = a0; dst[64] = a1; }
        __syncthreads();
    }
}

__device__ __forceinline__ void p8_combine(Frame& F) {
    const int gw = F.vcu * 8 + F.wave, NGW = F.G * 8, lane = F.lane;
    const bf16_t* YE = WSP(const bf16_t, WS_XE); const int* slot_of = WSP(const int, WS_SLOT); bf16_t* X2N = WSP(bf16_t, WS_H2);
    const float* esq = WSP(const float, WS_ESQ); float* rstde = WSP(float, WS_RSTDE);
    for (int row = gw; row < T; row += NGW) {
        f32x4* xr = (f32x4*)(F.out + (size_t)row * D) + lane; const f32x4* gr = (const f32x4*)F_norm_ple + lane;
        f32x4 v[4];
#pragma unroll
        for (int j = 0; j < 4; ++j) v[j] = xr[64 * j];
        const int b = row >> 11;
        const int myslot = (lane < 16) ? slot_of[(size_t)row * NE + lane] : -1;
        for (int e = 0; e < NE; ++e) { const int sl = __shfl(myslot, e);
            if (sl >= 0) { const u32x2* yr = (const u32x2*)(YE + ((size_t)(b * NE + e) * CAP + sl) * D) + lane;
#pragma unroll
                for (int j = 0; j < 4; ++j) { const u32x2 y = yr[64 * j]; v[j].x += bflo(y.x); v[j].y += bfhi(y.x); v[j].z += bflo(y.y); v[j].w += bfhi(y.y); } } }
        float s = 0.f;
#pragma unroll
        for (int j = 0; j < 4; ++j) { xr[64 * j] = v[j]; s += (v[j].x * v[j].x + v[j].y * v[j].y) + (v[j].z * v[j].z + v[j].w * v[j].w); }
        const float rstd = 1.0f / sqrtf(wave_sum(s) * (1.0f / D) + EPS);
        u32x2* o8 = (u32x2*)(X2N + (size_t)row * D) + lane;
#pragma unroll
        for (int j = 0; j < 4; ++j) { const f32x4 gg = gr[64 * j]; u32x2 o; o.x = pkbf(v[j].x * rstd * gg.x, v[j].y * rstd * gg.y); o.y = pkbf(v[j].z * rstd * gg.z, v[j].w * rstd * gg.w); o8[64 * j] = o; }
        float q = (lane < 16) ? esq[(size_t)row * 16 + lane] : 0.f; q = wave_sum(q);
        if (lane == 0) rstde[row] = 1.0f / sqrtf(q * (1.0f / D) + EPS);
    }
}

constexpr int N_PHASES = 10;
__global__ void __launch_bounds__(512, 2) mega_fwd(MArgs args) {
    extern __shared__ __attribute__((aligned(16))) unsigned char lds_raw[];
    Frame F;
    F.lds = (LAS unsigned char*)lds_raw; F.tid = threadIdx.x; F.lane = F.tid & 63; F.wave = __builtin_amdgcn_readfirstlane(F.tid >> 6);
    F.G = gridDim.x; { const int bx = blockIdx.x; F.vcu = (F.G % 8 == 0) ? (bx % 8) * (F.G / 8) + bx / 8 : bx; }
    F.out = args.out; F.ws = args.ws; F.a = &args;
    for (int u = F.tid; u < (LDS_BYTES - LDSCTL_OFF) / 4; u += 512) ((LAS unsigned*)(F.lds + LDSCTL_OFF))[u] = 0u;
    __syncthreads();
    const int lo = args.ph_lo, hi = args.ph_hi;
    if (hi - lo > 1) xcd_barrier_post(WSP(unsigned, WS_CTL) + CW_BAR);
#ifndef PH_ENABLE
#define PH_ENABLE 0x3ff
#endif
#define IN(k) (((PH_ENABLE >> (k)) & 1) && lo <= (k) && (k) < hi)
#define SEAM(k) do { if (IN(k) && IN((k) + 1)) xcd_barrier(WSP(unsigned, WS_CTL) + CW_BAR, (volatile LAS unsigned*)(F.lds + MISC_OFF) + 8); } while (0)
    if (IN(0)) { p0_prologue(F); } SEAM(0);
    if (IN(1)) {
#ifndef NO_P1A
        { pg8::Gemm g{WSP(const bf16_t, WS_XN), WSP(const bf16_t, WS_WIN), 1024}; pg8::StaticOrder So; So.init(T, 2048, F.G, (int)blockIdx.x);
          EpiQKV E{WSP(bf16_t, WS_U), WSP(bf16_t, WS_Q), WSP(bf16_t, WS_K), WSP(bf16_t, WS_VT), F_q_norm, F_k_norm};
          pg8::gemm_phase(F.lds, g, So, E); }
#endif
#ifndef NO_P1B
        { pg8::Gemm g{WSP(const bf16_t, WS_PB), WSP(const bf16_t, WS_WPP), 256}; pg8::StaticOrder So; So.init(T, 1024, F.G, (int)blockIdx.x);
          EpiE E{WSP(bf16_t, WS_EB), WSP(float, WS_ESQ)};
          pg8::gemm_phase(F.lds, g, So, E); }
#endif
    } SEAM(1);
    if (IN(2)) { p2_mixer(F); } SEAM(2);
    if (IN(3)) { pg8::Gemm g{WSP(const bf16_t, WS_MIX), WSP(const bf16_t, WS_WOUT), 1024}; pg8::StaticOrder So; So.init(T, 1024, F.G, (int)blockIdx.x);
        EpiRes E{F_x, F.out}; pg8::gemm_phase(F.lds, g, So, E); } SEAM(3);
    if (IN(4)) { p4_router(F); } SEAM(4);
    if (IN(5)) { p5_topk_gather(F); } SEAM(5);
    if (IN(6)) { pg8::Gemm g{WSP(const bf16_t, WS_XE), WSP(const bf16_t, WS_WGU), 1024}; OrderGU So{F.G, F.vcu};
        EpiGU E{WSP(bf16_t, WS_HH)}; pg8::gemm_phase(F.lds, g, So, E); } SEAM(6);
    if (IN(7)) { pg8::Gemm g{WSP(const bf16_t, WS_HH), WSP(const bf16_t, WS_WD), 2048}; OrderDown So{F.G, F.vcu};
        EpiDown E{WSP(bf16_t, WS_XE), WSP(const float, WS_GATES)}; pg8::gemm_phase(F.lds, g, So, E); } SEAM(7);
    if (IN(8)) { p8_combine(F); } SEAM(8);
    if (IN(9)) { pg8::Gemm g{WSP(const bf16_t, WS_H2), WSP(const bf16_t, WS_WPG), 1024}; pg8::StaticOrder So; So.init(T, 1024, F.G, (int)blockIdx.x);
        EpiFinal E{F.out, WSP(const bf16_t, WS_EB), WSP(const float, WS_RSTDE), F_norm_ple_post}; pg8::gemm_phase(F.lds, g, So, E); }
#undef IN
#undef SEAM
}
static inline dim3 g1(size_t n) { return dim3((unsigned)((n + 255) / 256)); }

#ifndef MODE
#define MODE 0
#endif

extern "C" void kernel_launch(void* const* d_in, const int* in_sizes, int n_in, void* d_out, int out_size, void* d_ws, size_t ws_size, hipStream_t stream) {
    const float* x = (const float*)d_in[0]; const float* p = (const float*)d_in[1]; const float* norm_mix = (const float*)d_in[2]; const float* w_in = (const float*)d_in[3];
    const float* w_pool = (const float*)d_in[4]; const float* pool_scale = (const float*)d_in[5]; const float* q_norm = (const float*)d_in[6]; const float* k_norm = (const float*)d_in[7];
    const float* rpb = (const float*)d_in[8]; const float* w_out = (const float*)d_in[9]; const float* norm_ffn = (const float*)d_in[10]; const float* w_router = (const float*)d_in[11];
    const float* w_gate = (const float*)d_in[12]; const float* w_up = (const float*)d_in[13]; const float* w_down = (const float*)d_in[14]; const float* norm_ple = (const float*)d_in[15];
    const float* w_ple_gate = (const float*)d_in[16]; const float* w_ple_proj = (const float*)d_in[17]; const float* norm_ple_post = (const float*)d_in[18];
    float* out = (float*)d_out; char* ws = (char*)d_ws;
    (void)in_sizes; (void)n_in; (void)out_size;
    static int grid = 0;
    if (grid == 0) {
        if (ws_size < (size_t)489 * MiB) { fprintf(stderr, "kernel_launch: workspace too small (%zu)\n", ws_size); grid = -1; return; }
        int dev = 0, cus = 0, per_cu = 0;
        if (hipGetDevice(&dev) != hipSuccess || hipDeviceGetAttribute(&cus, hipDeviceAttributeMultiprocessorCount, dev) != hipSuccess) { grid = -1; return; }
        if (hipFuncSetAttribute((const void*)mega_fwd, hipFuncAttributeMaxDynamicSharedMemorySize, LDS_BYTES) != hipSuccess) { fprintf(stderr, "kernel_launch: hipFuncSetAttribute failed\n"); grid = -1; return; }
        if (hipOccupancyMaxActiveBlocksPerMultiprocessor(&per_cu, (const void*)mega_fwd, 512, LDS_BYTES) != hipSuccess || per_cu < 1) { fprintf(stderr, "kernel_launch: occupancy query says %d blocks per CU\n", per_cu); grid = -1; (void)hipGetLastError(); return; }
        grid = cus;
    }
    if (grid < 0) return;
    (void)hipMemsetAsync((char*)d_ws + WS_CTL, 0, CTL_ZERO_BYTES, stream);
    MArgs a{};
    for (int i = 0; i < 19; ++i) a.in[i] = (const float*)d_in[i];
    a.out = out; a.ws = (unsigned char*)d_ws;
#if MODE == 0
    a.ph_lo = 0; a.ph_hi = N_PHASES;
    hipLaunchKernelGGL(mega_fwd, dim3(grid), dim3(512), LDS_BYTES, stream, a);
#else
    constexpr int KOPT = MODE - 100;
    for (int ph = 0; ph <= KOPT; ++ph) { a.ph_lo = ph; a.ph_hi = ph + 1; hipLaunchKernelGGL(mega_fwd, dim3(grid), dim3(512), LDS_BYTES, stream, a); }
    float* xn = (float*)(ws + 0 * MiB);
    float* z = (float*)(ws + 64 * MiB);
    float* dp = (float*)(ws + 192 * MiB);
    float* ye = (float*)(ws + 288 * MiB);
    float* ga = (float*)(ws + 416 * MiB); float* gb = (float*)(ws + 448 * MiB);
    float* mix = (float*)(ws + 416 * MiB);
    float* aff = (float*)(ws + 485 * MiB); int* idx = (int*)(ws + 486 * MiB); float* gates = (float*)(ws + 487 * MiB); int* slot_of = (int*)(ws + 488 * MiB);
    const unsigned short* mU = (const unsigned short*)(ws + WS_U); const unsigned short* mQ = (const unsigned short*)(ws + WS_Q); const unsigned short* mK = (const unsigned short*)(ws + WS_K); const unsigned short* mVT = (const unsigned short*)(ws + WS_VT);
    if (KOPT < 1) {
        nv::rmsnorm_rows<<<T, 256, 0, stream>>>(x, norm_mix, xn, D);
        nv::gemm_f32<<<dim3(2048 / 64, T / 64, 1), 256, 0, stream>>>(xn, w_in, z, D, D, 2048, 2048, 0, 0, 0);
    }
    if (KOPT < 2) {
        if (KOPT == 1) nv::bf16_to_f32<<<g1((size_t)T * PW), 256, 0, stream>>>(mU, z, PW, 2048, (size_t)T * PW);
        nv::pool_diff<<<g1((size_t)T * PW), 256, 0, stream>>>(z, dp);
        nv::gemm_f32<<<dim3(PG / 64, T / 64, 4), 256, 0, stream>>>(dp, w_pool, mix, PG, PW, PG, D, PG, (size_t)PG * PG, PG);
        nv::scale_cols<<<g1((size_t)T * PW), 256, 0, stream>>>(mix, D, PW, pool_scale, (size_t)T * PW);
        if (KOPT == 1) nv::natten_pre<<<T * AH, 128, 0, stream>>>(mQ, mK, mVT, rpb, mix);
        else nv::natten<<<T * AH, 128, 0, stream>>>(z, q_norm, k_norm, rpb, mix);
    }
    if (KOPT < 3) {
        if (KOPT == 2) nv::bf16_to_f32<<<g1((size_t)T * D), 256, 0, stream>>>((const unsigned short*)(ws + WS_MIX), mix, D, D, (size_t)T * D);
        nv::gemm_f32<<<dim3(D / 64, T / 64, 1), 256, 0, stream>>>(mix, w_out, xn, D, D, D, D, 0, 0, 0);
        nv::add_to<<<g1((size_t)T * D), 256, 0, stream>>>(out, x, xn, (size_t)T * D);
    }
    if (KOPT < 4) {
        nv::rmsnorm_rows<<<T, 256, 0, stream>>>(out, norm_ffn, xn, D);
        nv::router<<<T, 256, 0, stream>>>(xn, w_router, aff);
    } else { aff = (float*)(ws + WS_AFF); }
    if (KOPT < 5) {
        if (KOPT == 4) nv::bf16_to_f32<<<g1((size_t)T * D), 256, 0, stream>>>((const unsigned short*)(ws + WS_H2), xn, D, D, (size_t)T * D);
        nv::topk<<<B * NE, 1024, 0, stream>>>(aff, idx, gates, slot_of);
        nv::gather_rows<<<B * NE * CAP, 256, 0, stream>>>(xn, idx, z);
    } else { gates = (float*)(ws + WS_GATES); slot_of = (int*)(ws + WS_SLOT); }
    if (KOPT < 7) {
        float* xe = z;
        if (KOPT >= 5) nv::bf16_to_f32<<<g1((size_t)B * NE * CAP * D), 256, 0, stream>>>((const unsigned short*)(ws + WS_XE), xe, D, D, (size_t)B * NE * CAP * D);
        for (int b = 0; b < B; ++b) {
            const float* xeb = xe + (size_t)b * NE * CAP * D;
            nv::gemm_f32<<<dim3(DE / 64, CAP / 64, NE), 256, 0, stream>>>(xeb, w_gate, ga, D, D, DE, DE, (size_t)CAP * D, (size_t)D * DE, (size_t)CAP * DE);
            nv::gemm_f32<<<dim3(DE / 64, CAP / 64, NE), 256, 0, stream>>>(xeb, w_up, gb, D, D, DE, DE, (size_t)CAP * D, (size_t)D * DE, (size_t)CAP * DE);
            nv::silu_mul<<<g1((size_t)NE * CAP * DE), 256, 0, stream>>>(ga, gb, (size_t)NE * CAP * DE);
            nv::gemm_f32<<<dim3(D / 64, CAP / 64, NE), 256, 0, stream>>>(ga, w_down, ye + (size_t)b * NE * CAP * D, DE, DE, D, D, (size_t)CAP * DE, (size_t)DE * D, (size_t)CAP * D);
        }
    }
    if (KOPT < 8) {
        if (KOPT == 7) nv::combine_bf16<<<T, 256, 0, stream>>>(out, (const unsigned short*)(ws + WS_XE), slot_of);
        else nv::combine<<<T, 256, 0, stream>>>(out, ye, gates, slot_of);
    }
    if (KOPT < 9) {
        nv::rmsnorm_rows<<<T, 256, 0, stream>>>(out, norm_ple, xn, D);
        nv::gemm_f32<<<dim3(D / 64, T / 64, 1), 256, 0, stream>>>(xn, w_ple_gate, mix, D, D, D, D, 0, 0, 0);
        float* eraw = ye;
        nv::gemm_f32<<<dim3(D / 64, T / 64, 1), 256, 0, stream>>>(p, w_ple_proj, eraw, PD, PD, D, D, 0, 0, 0);
        nv::rmsnorm_rows<<<T, 256, 0, stream>>>(eraw, norm_ple_post, xn, D);
        nv::ple_final<<<g1((size_t)T * D), 256, 0, stream>>>(out, mix, xn, (size_t)T * D);
    }
#endif
}
```

```cpp
#include <hip/hip_runtime.h>
#include <cstdio>
#include <cstdint>

namespace cfg {
constexpr int D = 1024, B = 8, S = 2048, T = B * S;
constexpr int GW = 64, ROWS = S / GW;
constexpr int PW = 512, PG = 128, AH = 8, HD = 64, NE = 16, CAP = 256, DE = 2048, PD = 256;
constexpr float EPS = 1e-6f;
}
using namespace cfg;

namespace nv {
__global__ void __launch_bounds__(256) rmsnorm_rows(const float* __restrict__ x, const float* __restrict__ g, float* __restrict__ out, int ncols) {
    __shared__ float red[256];
    const size_t row = blockIdx.x; const float* xr = x + row * ncols; float s = 0.f;
    for (int c = threadIdx.x; c < ncols; c += 256) { const float v = xr[c]; s += v * v; }
    red[threadIdx.x] = s; __syncthreads();
    for (int o = 128; o > 0; o >>= 1) { if ((int)threadIdx.x < o) red[threadIdx.x] += red[threadIdx.x + o]; __syncthreads(); }
    const float rstd = 1.0f / sqrtf(red[0] / (float)ncols + EPS);
    for (int c = threadIdx.x; c < ncols; c += 256) out[row * ncols + c] = xr[c] * rstd * g[c];
}
__global__ void __launch_bounds__(256) gemm_f32(const float* __restrict__ A, const float* __restrict__ Bm, float* __restrict__ C, int K, int lda, int ldb, int ldc, size_t sA, size_t sB, size_t sC) {
    __shared__ float As[16][65]; __shared__ float Bs[16][64];
    const int z = blockIdx.z; A += z * sA; Bm += z * sB; C += z * sC;
    const int m0 = blockIdx.y * 64, n0 = blockIdx.x * 64, tx = threadIdx.x & 15, ty = threadIdx.x >> 4;
    float acc[4][4] = {};
    for (int k0 = 0; k0 < K; k0 += 16) {
        for (int i = threadIdx.x; i < 1024; i += 256) { const int r = i >> 4, c = i & 15; As[c][r] = A[(size_t)(m0 + r) * lda + k0 + c]; }
        for (int i = threadIdx.x; i < 1024; i += 256) { const int r = i >> 6, c = i & 63; Bs[r][c] = Bm[(size_t)(k0 + r) * ldb + n0 + c]; }
        __syncthreads();
#pragma unroll
        for (int k = 0; k < 16; ++k) { float a[4], b[4];
#pragma unroll
            for (int i = 0; i < 4; ++i) { a[i] = As[k][ty * 4 + i]; b[i] = Bs[k][tx * 4 + i]; }
#pragma unroll
            for (int i = 0; i < 4; ++i)
#pragma unroll
                for (int j = 0; j < 4; ++j) acc[i][j] += a[i] * b[j]; }
        __syncthreads();
    }
#pragma unroll
    for (int i = 0; i < 4; ++i)
#pragma unroll
        for (int j = 0; j < 4; ++j) C[(size_t)(m0 + ty * 4 + i) * ldc + n0 + tx * 4 + j] = acc[i][j];
}
__global__ void __launch_bounds__(256) pool_diff(const float* __restrict__ z, float* __restrict__ d) {
    const size_t i = (size_t)blockIdx.x * 256 + threadIdx.x; if (i >= (size_t)T * PW) return;
    const int c = (int)(i % PW); const int tok = (int)(i / PW), b = tok / S, t = tok % S; const int gi = c / PG; const int w = 2 << gi;
    int lo = t - w / 2; if (lo < 0) lo = 0; int hi = t + (w - w / 2) - 1; if (hi > S - 1) hi = S - 1;
    float s = 0.f; for (int q = lo; q <= hi; ++q) s += z[((size_t)b * S + q) * 2048 + c];
    d[i] = s / (float)(hi - lo + 1) - z[(size_t)tok * 2048 + c];
}
__global__ void __launch_bounds__(256) scale_cols(float* __restrict__ y, int ld, int ncols, const float* __restrict__ sc, size_t n) {
    const size_t i = (size_t)blockIdx.x * 256 + threadIdx.x; if (i >= n) return; const int c = (int)(i % ncols); const size_t r = i / ncols; y[r * ld + c] *= sc[c];
}
__global__ void __launch_bounds__(128) natten(const float* __restrict__ z, const float* __restrict__ qn, const float* __restrict__ kn, const float* __restrict__ rpb, float* __restrict__ mix) {
    __shared__ float qs[64]; __shared__ float ps[128]; __shared__ float red[128];
    const int tok = blockIdx.x >> 3, h = blockIdx.x & 7, b = tok / S, t = tok % S, r = t / GW, c = t % GW, j = threadIdx.x;
    int rs = r - 4; if (rs < 0) rs = 0; if (rs > ROWS - 8) rs = ROWS - 8;
    int cs = c - 8; if (cs < 0) cs = 0; if (cs > GW - 16) cs = GW - 16;
    if (j < 64) qs[j] = z[(size_t)tok * 2048 + 512 + h * 64 + j];
    __syncthreads();
    float qss = 0.f; for (int d = 0; d < 64; ++d) qss += qs[d] * qs[d];
    const float rq = 1.0f / sqrtf(qss / 64.f + EPS);
    const int i = j >> 4, jj = j & 15; const int kt = b * S + (rs + i) * GW + cs + jj;
    const float* kr = z + (size_t)kt * 2048 + 1024 + h * 64;
    float kss = 0.f, dot = 0.f;
    for (int d = 0; d < 64; ++d) { const float kv = kr[d]; kss += kv * kv; dot += (qs[d] * rq * qn[d] * 0.125f) * (kv * kn[d]); }
    const float rk = 1.0f / sqrtf(kss / 64.f + EPS);
    const int dr = rs + i - r + 7, dc = cs + jj - c + 15;
    const float sc = dot * rk + rpb[(h * 15 + dr) * 31 + dc];
    red[j] = sc; __syncthreads();
    for (int o = 64; o > 0; o >>= 1) { if (j < o) red[j] = fmaxf(red[j], red[j + o]); __syncthreads(); }
    const float mx = red[0]; __syncthreads();
    const float p = expf(sc - mx); ps[j] = p; red[j] = p; __syncthreads();
    for (int o = 64; o > 0; o >>= 1) { if (j < o) red[j] += red[j + o]; __syncthreads(); }
    const float inv = 1.0f / red[0];
    if (j < 64) { float o = 0.f;
        for (int q = 0; q < 128; ++q) { const int vt = b * S + (rs + (q >> 4)) * GW + cs + (q & 15); o += ps[q] * z[(size_t)vt * 2048 + 1536 + h * 64 + j]; }
        mix[(size_t)tok * 1024 + 512 + h * 64 + j] = o * inv; }
}
__global__ void __launch_bounds__(256) add_to(float* __restrict__ o, const float* __restrict__ a, const float* __restrict__ b, size_t n) {
    const size_t i = (size_t)blockIdx.x * 256 + threadIdx.x; if (i < n) o[i] = a[i] + b[i];
}
__global__ void __launch_bounds__(256) router(const float* __restrict__ h2, const float* __restrict__ wr, float* __restrict__ aff) {
    __shared__ float red[16][256];
    const int tok = blockIdx.x; float acc[16] = {};
    for (int d = threadIdx.x; d < D; d += 256) { const float v = h2[(size_t)tok * D + d];
#pragma unroll
        for (int e = 0; e < 16; ++e) acc[e] += v * wr[d * 16 + e]; }
#pragma unroll
    for (int e = 0; e < 16; ++e) red[e][threadIdx.x] = acc[e];
    __syncthreads();
    for (int o = 128; o > 0; o >>= 1) { if ((int)threadIdx.x < o) { for (int e = 0; e < 16; ++e) red[e][threadIdx.x] += red[e][threadIdx.x + o]; } __syncthreads(); }
    if (threadIdx.x < 16) { float mx = -1e30f; for (int e = 0; e < 16; ++e) mx = fmaxf(mx, red[e][0]); float sum = 0.f; for (int e = 0; e < 16; ++e) sum += expf(red[e][0] - mx);
        const int e = threadIdx.x, b = tok / S, s = tok % S; aff[((size_t)b * NE + e) * S + s] = expf(red[e][0] - mx) / sum; }
}
__global__ void __launch_bounds__(1024) topk(const float* __restrict__ aff, int* __restrict__ idx, float* __restrict__ gates, int* __restrict__ slot_of) {
    __shared__ float v[S];
    const int be = blockIdx.x, b = be / NE, e = be % NE;
    for (int i = threadIdx.x; i < S; i += 1024) v[i] = aff[(size_t)be * S + i];
    __syncthreads();
    for (int i = threadIdx.x; i < S; i += 1024) { const float vi = v[i]; int rank = 0;
        for (int q = 0; q < S; ++q) { const float vq = v[q]; rank += (vq > vi || (vq == vi && q < i)) ? 1 : 0; }
        if (rank < CAP) { idx[be * CAP + rank] = i; gates[be * CAP + rank] = vi; }
        slot_of[((size_t)b * S + i) * NE + e] = rank < CAP ? rank : -1; }
}
__global__ void __launch_bounds__(256) gather_rows(const float* __restrict__ h2, const int* __restrict__ idx, float* __restrict__ xe) {
    const int slot = blockIdx.x; const int be = slot / CAP, b = be / NE; const int tok = b * S + idx[slot];
    for (int c = threadIdx.x; c < D; c += 256) xe[(size_t)slot * D + c] = h2[(size_t)tok * D + c];
}
__global__ void __launch_bounds__(256) silu_mul(float* __restrict__ a, const float* __restrict__ bb, size_t n) {
    const size_t i = (size_t)blockIdx.x * 256 + threadIdx.x; if (i < n) { const float x = a[i]; a[i] = x / (1.0f + expf(-x)) * bb[i]; }
}
__global__ void __launch_bounds__(256) combine(float* __restrict__ x, const float* __restrict__ ye, const float* __restrict__ gates, const int* __restrict__ slot_of) {
    const int tok = blockIdx.x, b = tok / S;
    for (int c = threadIdx.x; c < D; c += 256) { float acc = x[(size_t)tok * D + c];
        for (int e = 0; e < NE; ++e) { const int sl = slot_of[(size_t)tok * NE + e]; if (sl >= 0) { const int slot = (b * NE + e) * CAP + sl; acc += ye[(size_t)slot * D + c] * gates[slot]; } }
        x[(size_t)tok * D + c] = acc; }
}
__global__ void __launch_bounds__(256) ple_final(float* __restrict__ x, const float* __restrict__ glog, const float* __restrict__ en, size_t n) {
    const size_t i = (size_t)blockIdx.x * 256 + threadIdx.x; if (i < n) { const float g = 1.0f / (1.0f + expf(-glog[i])); x[i] = x[i] + g * en[i]; }
}
}

#define MODE 0
#define GAS __attribute__((address_space(1)))
#define LAS __attribute__((address_space(3)))
typedef unsigned short bf16_t;
typedef short bf16x8 __attribute__((ext_vector_type(8)));
typedef float f32x4 __attribute__((ext_vector_type(4)));
typedef float f32x2 __attribute__((ext_vector_type(2)));
typedef unsigned u32x4 __attribute__((ext_vector_type(4)));
typedef unsigned u32x2 __attribute__((ext_vector_type(2)));
typedef __bf16 bf16x2_t __attribute__((ext_vector_type(2)));

__device__ __forceinline__ unsigned pkbf(float lo, float hi) { f32x2 v = {lo, hi}; bf16x2_t b = __builtin_convertvector(v, bf16x2_t); return __builtin_bit_cast(unsigned, b); }
__device__ __forceinline__ float bf2f(unsigned short u) { return __builtin_bit_cast(float, (unsigned)u << 16); }
__device__ __forceinline__ float bflo(unsigned u) { return __builtin_bit_cast(float, u << 16); }
__device__ __forceinline__ float bfhi(unsigned u) { return __builtin_bit_cast(float, u & 0xffff0000u); }
__device__ __forceinline__ float wave_sum(float v) {
#pragma unroll
    for (int o = 1; o < 64; o <<= 1) v += __shfl_xor(v, o);
    return v;
}
constexpr float LOG2E = 1.4426950408889634f;

namespace pg8 {
constexpr int BM = 256, BK = 64, HALF = 128, HTB = HALF * BK * 2, STAGE_BYTES = 8 * HTB;
__host__ __device__ __forceinline__ int lds_byte(int r, int c) { const int st = (r >> 4) * 2 + (c >> 5), rr = r & 15, cc = c & 31, ob = rr * 64 + cc * 2; return st * 1024 + (ob ^ (((ob >> 9) & 1) << 5)); }
__host__ __device__ __forceinline__ void stage_rc(int b, int& R, int& C) { const int st = b / 1024, sb = b % 1024, swz = sb ^ (((sb >> 9) & 1) << 5); R = (st >> 1) * 16 + swz / 64; C = (st & 1) * 32 + (swz % 64) / 2; }
__host__ __device__ __forceinline__ int perm32(int rho) { const int n = rho >> 4, i = rho & 15; return 8 * (i >> 2) + 4 * n + (i & 3); }

struct Unit { int arow, brow, pm, pn, grp; };
struct Gemm { const bf16_t* A; const bf16_t* Bt; int K; };

struct StaticOrder {
    int nM, nN, nwg, G, c;
    __device__ void init(int M, int N, int G_, int c_) { nM = M / BM; nN = N / BM; nwg = nM * nN; G = G_; c = c_; }
    __device__ bool next(int i, Unit& u) const {
        const long L = (long)i * G + c; if (L >= nwg) return false;
        int wgid = (int)L; { const int q = nwg / 8, r = nwg % 8, xcd = wgid % 8, off = wgid / 8; wgid = (xcd < r ? xcd * (q + 1) : r * (q + 1) + (xcd - r) * q) + off; }
        const int nig = 8 * nN, gid = wgid / nig, fm = gid * 8, gsz = (nM - fm) < 8 ? (nM - fm) : 8;
        u.pm = fm + ((wgid % nig) % gsz); u.pn = (wgid % nig) / gsz; u.arow = u.pm * BM; u.brow = u.pn * BM; u.grp = 0; return true;
    }
};

template <class Epi, class Sched>
__device__ __forceinline__ void gemm_phase(LAS unsigned char* lds, const Gemm g, const Sched& S, const Epi& E) {
    const int tid = threadIdx.x, wid = __builtin_amdgcn_readfirstlane(tid >> 6), lane = tid & 63, wr = wid >> 2, wc = wid & 3, fr = lane & 15, fq = lane >> 4;
    int K = g.K; asm volatile("" : "+s"(K));
    const int nt = K / BK;
    unsigned voffA[2], voffB[2];
#pragma unroll
    for (int i = 0; i < 2; ++i) { int R, C; stage_rc(tid * 16 + i * 8192, R, C); const int Rb = 64 * (R >> 5) + perm32(R & 31);
        voffA[i] = (unsigned)(R * K + C) * 2u; voffB[i] = (unsigned)(Rb * K + C) * 2u; }
    const unsigned kstep = (unsigned)(BK * 2);
    const unsigned hstep = (unsigned)HALF * K * 2;
    const unsigned hstepB = (unsigned)32 * K * 2;
    const unsigned rstep = (unsigned)K * 2;
    const unsigned ldsw = (unsigned)wid * 1024u;
    const int aoff = lds_byte(wr * 64 + fr, fq * 8), boff = lds_byte(wc * 32 + fr, fq * 8);
#define PG8_SA(b, h) (((b) * 2 + (h)) * HTB)
#define PG8_SB(b, h) ((4 + (b) * 2 + (h)) * HTB)
#define PG8_STAGE(bufoff, gbase, voff) do { _Pragma("unroll") for (int _i = 0; _i < 2; ++_i) \
        __builtin_amdgcn_global_load_lds((const unsigned*)((const char*)(gbase) + (voff)[_i]), (LAS unsigned*)(lds + (bufoff) + ldsw + _i * 8192), 16, 0, 0); } while (0)
#define PG8_LDA(dst, b, h) do { _Pragma("unroll") for (int m = 0; m < 4; ++m) _Pragma("unroll") for (int k = 0; k < 2; ++k) dst[m][k] = *(const LAS bf16x8*)(lds + PG8_SA(b, h) + aoff + m * 2048 + k * 1024); } while (0)
#define PG8_LDB(dst, b, h) do { _Pragma("unroll") for (int n = 0; n < 2; ++n) _Pragma("unroll") for (int k = 0; k < 2; ++k) dst[n][k] = *(const LAS bf16x8*)(lds + PG8_SB(b, h) + boff + n * 2048 + k * 1024); } while (0)
#define PG8_MMA(ai, bj, At, Bt) do { __builtin_amdgcn_s_setprio(1); _Pragma("unroll") for (int m = 0; m < 4; ++m) _Pragma("unroll") for (int n = 0; n < 2; ++n) _Pragma("unroll") for (int k = 0; k < 2; ++k) \
        acc[ai][bj][m][n] = __builtin_amdgcn_mfma_f32_16x16x32_bf16(Bt[n][k], At[m][k], acc[ai][bj][m][n], 0, 0, 0); __builtin_amdgcn_s_setprio(0); } while (0)
#define PG8_WAIT_V(n) asm volatile("s_waitcnt vmcnt(" #n ")" ::: "memory")
#define PG8_WAIT_L(n) asm volatile("s_waitcnt lgkmcnt(" #n ")" ::: "memory")
#define PG8_BAR __builtin_amdgcn_s_barrier()
#define PG8_SCHED __builtin_amdgcn_sched_barrier(0)
    Unit cur, nxt; int ui = 0;
    if (!S.next(0, cur)) return;
    f32x4 acc[2][2][4][2];
#pragma unroll
    for (int a = 0; a < 2; ++a)
#pragma unroll
        for (int b = 0; b < 2; ++b)
#pragma unroll
            for (int m = 0; m < 4; ++m)
#pragma unroll
                for (int n = 0; n < 2; ++n) acc[a][b][m][n] = (f32x4){0.f, 0.f, 0.f, 0.f};
    bf16x8 At[4][2], B0[2][2], B1[2][2];
    const char* cA = (const char*)g.A + (size_t)cur.arow * rstep; const char* cB = (const char*)g.Bt + (size_t)cur.brow * rstep;
    PG8_STAGE(PG8_SB(0, 0), cB, voffB); PG8_STAGE(PG8_SB(0, 1), cB + hstepB, voffB); PG8_STAGE(PG8_SA(0, 0), cA, voffA); PG8_STAGE(PG8_SA(0, 1), cA + hstep, voffA);
    if (wr == 1) PG8_BAR;
    PG8_WAIT_V(2); PG8_BAR;
    PG8_STAGE(PG8_SB(1, 0), cB + kstep, voffB); PG8_STAGE(PG8_SA(1, 0), cA + kstep, voffA); PG8_STAGE(PG8_SB(1, 1), cB + hstepB + kstep, voffB);
    PG8_WAIT_V(6); PG8_BAR;
    for (;;) {
        const bool has_next = S.next(ui + 1, nxt);
        const char* nA = has_next ? (const char*)g.A + (size_t)nxt.arow * rstep : cA; const char* nB = has_next ? (const char*)g.Bt + (size_t)nxt.brow * rstep : cB;
        for (int t = 0; t < nt; t += 2) {
            const bool last = (t == nt - 2);
            const char* a1 = cA + (unsigned)(t + 1) * kstep;
            const char* a2 = last ? nA : cA + (unsigned)(t + 2) * kstep; const char* b2 = last ? nB : cB + (unsigned)(t + 2) * kstep;
            const char* a3 = a2 + kstep; const char* b3 = b2 + kstep;
            PG8_LDB(B0, 0, 0); PG8_LDB(B1, 0, 1); PG8_SCHED; PG8_LDA(At, 0, 0); PG8_STAGE(PG8_SA(1, 1), a1 + hstep, voffA);
            PG8_WAIT_V(8); PG8_WAIT_L(0); PG8_BAR; PG8_MMA(0, 0, At, B0); PG8_MMA(0, 1, At, B1); PG8_BAR; PG8_SCHED;
            PG8_LDA(At, 0, 1); PG8_STAGE(PG8_SB(0, 0), b2, voffB); PG8_STAGE(PG8_SB(0, 1), b2 + hstepB, voffB); PG8_STAGE(PG8_SA(0, 0), a2, voffA);
            PG8_WAIT_V(8); PG8_WAIT_L(0); PG8_BAR; PG8_MMA(1, 0, At, B0); PG8_MMA(1, 1, At, B1); PG8_BAR; PG8_SCHED;
            PG8_LDB(B0, 1, 0); PG8_LDB(B1, 1, 1); PG8_SCHED; PG8_LDA(At, 1, 0); PG8_STAGE(PG8_SA(0, 1), a2 + hstep, voffA);
            PG8_WAIT_V(8); PG8_WAIT_L(0); PG8_BAR; PG8_MMA(0, 0, At, B0); PG8_MMA(0, 1, At, B1); PG8_BAR; PG8_SCHED;
            PG8_LDA(At, 1, 1); PG8_STAGE(PG8_SB(1, 0), b3, voffB); PG8_STAGE(PG8_SB(1, 1), b3 + hstepB, voffB); PG8_STAGE(PG8_SA(1, 0), a3, voffA);
            PG8_WAIT_V(8); PG8_WAIT_L(0); PG8_BAR; PG8_MMA(1, 0, At, B0); PG8_MMA(1, 1, At, B1); PG8_BAR; PG8_SCHED;
        }
        if (wr == 0) PG8_BAR;
        E(acc, cur, wr, wc, fr, fq);
        if (!has_next) break;
#pragma unroll
        for (int a = 0; a < 2; ++a)
#pragma unroll
            for (int b = 0; b < 2; ++b)
#pragma unroll
                for (int m = 0; m < 4; ++m)
#pragma unroll
                    for (int n = 0; n < 2; ++n) acc[a][b][m][n] = (f32x4){0.f, 0.f, 0.f, 0.f};
        cur = nxt; cA = nA; cB = nB; ++ui;
        if (wr == 1) PG8_BAR;
    }
    PG8_WAIT_V(0);
    PG8_BAR;
#undef PG8_SA
#undef PG8_SB
#undef PG8_STAGE
#undef PG8_LDA
#undef PG8_LDB
#undef PG8_MMA
#undef PG8_WAIT_V
#undef PG8_WAIT_L
#undef PG8_BAR
#undef PG8_SCHED
}
}

constexpr size_t MiB = (size_t)1 << 20;
constexpr size_t WS_CTL = 0, CTL_ZERO_BYTES = 64 * 1024;
constexpr size_t WS_WIN = 4 * MiB, WS_WOUT = 8 * MiB, WS_WPG = 10 * MiB, WS_WPP = 12 * MiB, WS_WPOOL = 12 * MiB + 512 * 1024;
constexpr size_t WS_WGU = 16 * MiB, WS_WD = 144 * MiB;
constexpr size_t WS_HH = 208 * MiB;
constexpr size_t WS_U = 208 * MiB, WS_Q = 224 * MiB, WS_K = 240 * MiB, WS_VT = 256 * MiB, WS_MIX = 272 * MiB, WS_XN = 304 * MiB;
constexpr size_t WS_PB = 336 * MiB, WS_EB = 344 * MiB, WS_H2 = 376 * MiB  , WS_XE = 408 * MiB  ;
constexpr size_t WS_AFF = 480 * MiB, WS_GATES = 481 * MiB, WS_SLOT = 482 * MiB, WS_ESQ = 483 * MiB, WS_RSTDE = 484 * MiB;
constexpr size_t WS_MEGA_END = 485 * MiB;
constexpr int CW_BAR = 1024;

constexpr int RING_BYTES = 131072, LDSCTL_OFF = RING_BYTES, MISC_OFF = LDSCTL_OFF + 320, LDS_BYTES = 147456;

#define XB_TMO      128
#define XB_XCNT(j)  (256  + 64 * (j))
#define XB_XSUB(j)  (1280 + 64 * (j))
#define XB_XGEN(j)  (2304 + 64 * (j))
#define XB_TOP      3328
#define XB_TOPGEN   3392
#define XCD_BAR_WORDS 3456
#define XB_SPIN_CAP (1u << 18)
__device__ __forceinline__ unsigned xb_ld(unsigned* p)              { return __hip_atomic_load(p, __ATOMIC_RELAXED, __HIP_MEMORY_SCOPE_AGENT); }
__device__ __forceinline__ unsigned xb_add(unsigned* p, unsigned v) { return __hip_atomic_fetch_add(p, v, __ATOMIC_RELAXED, __HIP_MEMORY_SCOPE_AGENT); }
__device__ __forceinline__ unsigned xb_xcc_id() { return (unsigned)__builtin_amdgcn_s_getreg((3 << 11) | 20) & 0xFu; }
#define XB_SPIN(cond, bar) do { unsigned _sp = 0; while (cond) { __builtin_amdgcn_s_sleep(1); \
    if ((++_sp & 255u) == 0u) { if (xb_ld(&(bar)[XB_TMO])) break; if (_sp > XB_SPIN_CAP) { atomicAdd(&(bar)[XB_TMO], 1u); break; } } } } while (0)
__device__ __forceinline__ void xcd_barrier_post(unsigned* bar) { if (threadIdx.x == 0) (void)xb_add(&bar[XB_XCNT(xb_xcc_id())], 1u); }
__device__ __forceinline__ void xcd_barrier_complete(unsigned* bar, unsigned x, unsigned& nloc, unsigned& nx) {
    const unsigned G = gridDim.x * gridDim.y * gridDim.z;
    unsigned sum, cnt, mine, sp = 0u;
    for (;;) {
        sum = 0u; cnt = 0u; mine = 0u;
#pragma unroll
        for (unsigned j = 0; j < 16; ++j) { const unsigned c = xb_ld(&bar[XB_XCNT(j)]); sum += c; cnt += (c > 0u) ? 1u : 0u; mine = (j == x) ? c : mine; }
        if (sum == G) break;
        __builtin_amdgcn_s_sleep(1);
        if ((++sp & 255u) == 0u) { if (xb_ld(&bar[XB_TMO])) break; if (sp > XB_SPIN_CAP) { atomicAdd(&bar[XB_TMO], 1u); break; } }
    }
    nloc = mine > 0u ? mine : 1u; nx = cnt > 0u ? cnt : 1u;
}
__device__ __forceinline__ void xcd_barrier(unsigned* bar, volatile LAS unsigned* st) {
    asm volatile("s_waitcnt vmcnt(0)" ::: "memory");
    __syncthreads();
    if (threadIdx.x == 0) {
        const unsigned x = xb_xcc_id();
        __builtin_amdgcn_s_waitcnt(0);
        unsigned nloc = st[0], nx = st[1];
        if (nloc == 0u) { xcd_barrier_complete(bar, x, nloc, nx); st[0] = nloc; st[1] = nx; }
        const unsigned old = xb_add(&bar[XB_XSUB(x)], 1u);
        const unsigned gen = old / nloc;
        if (old + 1u == (gen + 1u) * nloc) {
            __builtin_amdgcn_fence(__ATOMIC_RELEASE, "agent");
            asm volatile("s_waitcnt vmcnt(0)" ::: "memory");
            const unsigned og = xb_add(&bar[XB_TOP], 1u);
            const unsigned tg = og / nx;
            if (og + 1u == (tg + 1u) * nx) xb_add(&bar[XB_TOPGEN], 1u);
            else XB_SPIN(xb_ld(&bar[XB_TOPGEN]) == tg, bar);
            __builtin_amdgcn_fence(__ATOMIC_ACQUIRE, "agent");
            xb_add(&bar[XB_XGEN(x)], 1u);
            asm volatile("s_waitcnt vmcnt(0)" ::: "memory");
        } else {
            XB_SPIN(xb_ld(&bar[XB_XGEN(x)]) == gen, bar);
            __builtin_amdgcn_fence(__ATOMIC_ACQUIRE, "agent");
            asm volatile("s_waitcnt vmcnt(0)" ::: "memory");
        }
    }
    __syncthreads();
}

struct MArgs { const float* in[19]; float* out; unsigned char* ws; int ph_lo, ph_hi; };
struct Frame {
    LAS unsigned char* lds; int tid, lane, wave, vcu, G;
    float* out; unsigned char* ws; const MArgs* a;
};
#define F_x (F.a->in[0])
#define F_p (F.a->in[1])
#define F_norm_mix (F.a->in[2])
#define F_w_in (F.a->in[3])
#define F_w_pool (F.a->in[4])
#define F_pool_scale (F.a->in[5])
#define F_q_norm (F.a->in[6])
#define F_k_norm (F.a->in[7])
#define F_rpb (F.a->in[8])
#define F_w_out (F.a->in[9])
#define F_norm_ffn (F.a->in[10])
#define F_w_router (F.a->in[11])
#define F_w_gate (F.a->in[12])
#define F_w_up (F.a->in[13])
#define F_w_down (F.a->in[14])
#define F_norm_ple (F.a->in[15])
#define F_w_ple_gate (F.a->in[16])
#define F_w_ple_proj (F.a->in[17])
#define F_norm_ple_post (F.a->in[18])
#define WSP(T, off) ((T*)(F.ws + (off)))

__device__ __forceinline__ void tr_item(const float* W, int K, int N, bf16_t* WT, int kb, int nb, int dst_row0, LAS float* scr, int lane) {
    const int k0 = 64 * kb, n0 = 32 * nb;
#pragma unroll 8
    for (int i = 0; i < 32; ++i) { const int kk = 2 * i + (lane >> 5); scr[kk * 33 + (lane & 31)] = W[(size_t)(k0 + kk) * N + n0 + (lane & 31)]; }
    asm volatile("s_waitcnt lgkmcnt(0)" ::: "memory");
    const int c = lane & 7;
#pragma unroll
    for (int j = 0; j < 4; ++j) { const int n = (lane >> 3) + 8 * j; const LAS float* s = scr + (8 * c) * 33 + n;
        u32x4 o; o.x = pkbf(s[0 * 33], s[1 * 33]); o.y = pkbf(s[2 * 33], s[3 * 33]); o.z = pkbf(s[4 * 33], s[5 * 33]); o.w = pkbf(s[6 * 33], s[7 * 33]);
        *(u32x4*)(WT + (size_t)(dst_row0 + n) * K + k0 + 8 * c) = o; }
    asm volatile("s_waitcnt lgkmcnt(0)" ::: "memory");
}
__device__ __forceinline__ void rms_row_to_bf16(const float* xrow, const float* g, bf16_t* orow, int lane) {
    const f32x4* xr = (const f32x4*)xrow + lane; const f32x4* gr = (const f32x4*)g + lane;
    f32x4 v[4]; float s = 0.f;
#pragma unroll
    for (int j = 0; j < 4; ++j) { v[j] = xr[64 * j]; s += (v[j].x * v[j].x + v[j].y * v[j].y) + (v[j].z * v[j].z + v[j].w * v[j].w); }
    const float rstd = 1.0f / sqrtf(wave_sum(s) * (1.0f / D) + EPS);
    u32x2* o8 = (u32x2*)orow + lane;
#pragma unroll
    for (int j = 0; j < 4; ++j) { const f32x4 gg = gr[64 * j]; u32x2 o; o.x = pkbf(v[j].x * rstd * gg.x, v[j].y * rstd * gg.y); o.y = pkbf(v[j].z * rstd * gg.z, v[j].w * rstd * gg.w); o8[64 * j] = o; }
}
__device__ __forceinline__ void p0_prologue(Frame& F) {
    LAS float* scr = (LAS float*)(F.lds + F.wave * 16384);
    const int gw = F.vcu * 8 + F.wave, NGW = F.G * 8;
    constexpr int I_IN = 16 * 64, I_OUT = 16 * 32, I_PG = 16 * 32, I_PP = 4 * 32, I_E = 1024;
    constexpr int NSMALL = I_IN + I_OUT + I_PG + I_PP, NITEMS = NSMALL + 3 * 16 * I_E;
    bf16_t* Win_t = WSP(bf16_t, WS_WIN); bf16_t* Wout_t = WSP(bf16_t, WS_WOUT); bf16_t* Wpg_t = WSP(bf16_t, WS_WPG); bf16_t* Wpp_t = WSP(bf16_t, WS_WPP);
    bf16_t* Wgu_t = WSP(bf16_t, WS_WGU); bf16_t* Wd_t = WSP(bf16_t, WS_WD);
    for (int it = gw; it < NITEMS; it += NGW) {
        int r = it;
        if (r < I_IN) { tr_item(F_w_in, 1024, 2048, Win_t, r / 64, r % 64, 32 * (r % 64), scr, F.lane); continue; } r -= I_IN;
        if (r < I_OUT) { tr_item(F_w_out, 1024, 1024, Wout_t, r / 32, r % 32, 32 * (r % 32), scr, F.lane); continue; } r -= I_OUT;
        if (r < I_PG) { tr_item(F_w_ple_gate, 1024, 1024, Wpg_t, r / 32, r % 32, 32 * (r % 32), scr, F.lane); continue; } r -= I_PG;
        if (r < I_PP) { tr_item(F_w_ple_proj, 256, 1024, Wpp_t, r / 32, r % 32, 32 * (r % 32), scr, F.lane); continue; } r -= I_PP;
        const int mat = r / (16 * I_E), e = (r / I_E) % 16, q = r % I_E;
        if (mat < 2) {
            const int kb = q / 64, nb = q % 64, n0 = 32 * nb;
            tr_item((mat == 0 ? F_w_gate : F_w_up) + (size_t)e * 1024 * 2048, 1024, 2048, Wgu_t, kb, nb, e * 4096 + (n0 >> 7) * 256 + ((n0 >> 5) & 3) * 64 + 32 * mat, scr, F.lane);
        } else {
            const int kb = q / 32, nb = q % 32;
            tr_item(F_w_down + (size_t)e * 2048 * 1024, 2048, 1024, Wd_t, kb, nb, e * 1024 + 32 * nb, scr, F.lane);
        }
    }
    bf16_t* XN = WSP(bf16_t, WS_XN);
    for (int m = gw; m < T; m += NGW) rms_row_to_bf16(F_x + (size_t)m * D, F_norm_mix, XN + (size_t)m * D, F.lane);
    { const int gt = F.vcu * 512 + F.tid, NT_ = F.G * 512; const f32x4* p4 = (const f32x4*)F_p; u32x2* o = WSP(u32x2, WS_PB);
      for (int i = gt; i < T * PD / 4; i += NT_) { const f32x4 v = p4[i]; u32x2 w; w.x = pkbf(v.x, v.y); w.y = pkbf(v.z, v.w); o[i] = w; }
      bf16_t* Wp = WSP(bf16_t, WS_WPOOL);
      for (int i = gt; i < 4 * 128 * 128; i += NT_) { const int gg = i >> 14, n = (i >> 7) & 127, k = i & 127; const float v = F_w_pool[(gg * 128 + k) * 128 + n] * F_pool_scale[gg * 128 + n]; Wp[i] = (bf16_t)(pkbf(v, 0.f) & 0xffffu); }
    }
}

typedef f32x4 AccT[2][2][4][2];
struct EpiQKV {
    bf16_t *U, *Q, *Kk, *VT; const float *qn, *kn;
    __device__ __forceinline__ void operator()(const AccT& acc, const pg8::Unit& u, int wr, int wc, int fr_, int fq_) const {
        int fr = fr_, fq = fq_; asm volatile("" : "+v"(fr), "+v"(fq));
        const int type = u.pn >> 1; const int row0 = u.pm * 256 + wr * 64 + fr;
        if (type == 0) {
#pragma unroll
            for (int ai = 0; ai < 2; ++ai)
#pragma unroll
                for (int m = 0; m < 4; ++m) { const int row = row0 + ai * 128 + m * 16; bf16_t* rp = U + (size_t)row * 512 + (u.pn & 1) * 256 + wc * 64 + 8 * fq;
#pragma unroll
                    for (int bj = 0; bj < 2; ++bj) { const f32x4 v0 = acc[ai][bj][m][0], v1 = acc[ai][bj][m][1]; u32x4 w; w.x = pkbf(v0[0], v0[1]); w.y = pkbf(v0[2], v0[3]); w.z = pkbf(v1[0], v1[1]); w.w = pkbf(v1[2], v1[3]); *(u32x4*)(rp + bj * 32) = w; } asm volatile("" ::: "memory"); }
        } else if (type == 3) {
            const int hh = (u.pn & 1) * 4 + wc;
#pragma unroll
            for (int ai = 0; ai < 2; ++ai)
#pragma unroll
                for (int m = 0; m < 4; ++m) { const int row = row0 + ai * 128 + m * 16; const int b = row >> 11, s = row & 2047; bf16_t* bp = VT + ((size_t)(b * 8 + hh) * 64) * 2048 + s;
#pragma unroll
                    for (int bj = 0; bj < 2; ++bj)
#pragma unroll
                        for (int n = 0; n < 2; ++n)
#pragma unroll
                            for (int i = 0; i < 4; ++i) { const int d = 32 * bj + 8 * fq + 4 * n + i; bp[(size_t)d * 2048] = (bf16_t)(pkbf(acc[ai][bj][m][n][i], 0.f) & 0xffffu); }
                    asm volatile("" ::: "memory"); }
        } else {
            const int hh = (u.pn & 1) * 4 + wc; const float* gn = (type == 1) ? qn : kn; const float sc = (type == 1) ? 0.125f * LOG2E : 1.0f; bf16_t* dst = (type == 1) ? Q : Kk;
            f32x4 gv[2][2];
#pragma unroll
            for (int bj = 0; bj < 2; ++bj)
#pragma unroll
                for (int n = 0; n < 2; ++n) gv[bj][n] = *(const f32x4*)(gn + 32 * bj + 8 * fq + 4 * n) * sc;
#pragma unroll
            for (int ai = 0; ai < 2; ++ai)
#pragma unroll
                for (int m = 0; m < 4; ++m) { const int row = row0 + ai * 128 + m * 16; const int b = row >> 11, s = row & 2047;
                    float ss = 0.f;
#pragma unroll
                    for (int bj = 0; bj < 2; ++bj)
#pragma unroll
                        for (int n = 0; n < 2; ++n) { const f32x4 v = acc[ai][bj][m][n]; ss += (v[0] * v[0] + v[1] * v[1]) + (v[2] * v[2] + v[3] * v[3]); }
                    ss += __shfl_xor(ss, 16); ss += __shfl_xor(ss, 32);
                    const float rstd = 1.0f / sqrtf(ss * (1.0f / 64.0f) + EPS);
                    bf16_t* rp = dst + ((size_t)(b * 8 + hh) * 2048 + s) * 64 + 8 * fq;
#pragma unroll
                    for (int bj = 0; bj < 2; ++bj) { const f32x4 v0 = acc[ai][bj][m][0] * gv[bj][0] * rstd, v1 = acc[ai][bj][m][1] * gv[bj][1] * rstd; u32x4 w; w.x = pkbf(v0[0], v0[1]); w.y = pkbf(v0[2], v0[3]); w.z = pkbf(v1[0], v1[1]); w.w = pkbf(v1[2], v1[3]); *(u32x4*)(rp + bj * 32) = w; } asm volatile("" ::: "memory"); }
        }
    }
};
struct EpiE {
    bf16_t* EB; float* esq;
    __device__ __forceinline__ void operator()(const AccT& acc, const pg8::Unit& u, int wr, int wc, int fr_, int fq_) const {
        int fr = fr_, fq = fq_; asm volatile("" : "+v"(fr), "+v"(fq));
        const int row0 = u.pm * 256 + wr * 64 + fr;
#pragma unroll
        for (int ai = 0; ai < 2; ++ai)
#pragma unroll
            for (int m = 0; m < 4; ++m) { const int row = row0 + ai * 128 + m * 16; bf16_t* rp = EB + (size_t)row * 1024 + u.pn * 256 + wc * 64 + 8 * fq; float ss = 0.f;
#pragma unroll
                for (int bj = 0; bj < 2; ++bj) { const f32x4 v0 = acc[ai][bj][m][0], v1 = acc[ai][bj][m][1];
                    ss += (v0[0] * v0[0] + v0[1] * v0[1]) + (v0[2] * v0[2] + v0[3] * v0[3]) + (v1[0] * v1[0] + v1[1] * v1[1]) + (v1[2] * v1[2] + v1[3] * v1[3]);
                    u32x4 w; w.x = pkbf(v0[0], v0[1]); w.y = pkbf(v0[2], v0[3]); w.z = pkbf(v1[0], v1[1]); w.w = pkbf(v1[2], v1[3]); *(u32x4*)(rp + bj * 32) = w; }
                ss += __shfl_xor(ss, 16); ss += __shfl_xor(ss, 32);
                if (fq == 0) esq[(size_t)row * 16 + u.pn * 4 + wc] = ss; asm volatile("" ::: "memory"); }
    }
};
struct EpiRes {
    const float* x; float* out;
    __device__ __forceinline__ void operator()(const AccT& acc, const pg8::Unit& u, int wr, int wc, int fr_, int fq_) const {
        int fr = fr_, fq = fq_; asm volatile("" : "+v"(fr), "+v"(fq));
        const int row0 = u.pm * 256 + wr * 64 + fr; const int col0 = u.pn * 256 + wc * 64 + 8 * fq;
#pragma unroll
        for (int ai = 0; ai < 2; ++ai)
#pragma unroll
            for (int m = 0; m < 4; ++m) { const size_t off = (size_t)(row0 + ai * 128 + m * 16) * 1024 + col0;
#pragma unroll
                for (int bj = 0; bj < 2; ++bj)
#pragma unroll
                    for (int n = 0; n < 2; ++n) { const f32x4 xv = *(const f32x4*)(x + off + bj * 32 + n * 4); *(f32x4*)(out + off + bj * 32 + n * 4) = xv + acc[ai][bj][m][n]; }
                if (m & 1) asm volatile("" ::: "memory"); }
    }
};
struct EpiGU {
    bf16_t* HH;
    __device__ __forceinline__ void operator()(const AccT& acc, const pg8::Unit& u, int wr, int wc, int fr_, int fq_) const {
        int fr = fr_, fq = fq_; asm volatile("" : "+v"(fr), "+v"(fq));
        const int row0 = u.arow + wr * 64 + fr; const int col0 = u.pn * 128 + wc * 32 + 8 * fq;
#pragma unroll
        for (int ai = 0; ai < 2; ++ai)
#pragma unroll
            for (int m = 0; m < 4; ++m) { float h[8];
#pragma unroll
                for (int n = 0; n < 2; ++n)
#pragma unroll
                    for (int i = 0; i < 4; ++i) { const float a = acc[ai][0][m][n][i], b = acc[ai][1][m][n][i]; h[4 * n + i] = a * __builtin_amdgcn_rcpf(1.0f + __builtin_amdgcn_exp2f(-LOG2E * a)) * b; }
                u32x4 w; w.x = pkbf(h[0], h[1]); w.y = pkbf(h[2], h[3]); w.z = pkbf(h[4], h[5]); w.w = pkbf(h[6], h[7]);
                *(u32x4*)(HH + (size_t)(row0 + ai * 128 + m * 16) * 2048 + col0) = w; }
    }
};
struct EpiDown {
    bf16_t* YE; const float* gates;
    __device__ __forceinline__ void operator()(const AccT& acc, const pg8::Unit& u, int wr, int wc, int fr_, int fq_) const {
        int fr = fr_, fq = fq_; asm volatile("" : "+v"(fr), "+v"(fq));
        const int row0 = u.arow + wr * 64 + fr; const int col0 = u.pn * 256 + wc * 64 + 8 * fq;
#pragma unroll
        for (int ai = 0; ai < 2; ++ai)
#pragma unroll
            for (int m = 0; m < 4; ++m) { const int row = row0 + ai * 128 + m * 16; const float gt = gates[row]; bf16_t* rp = YE + (size_t)row * 1024 + col0;
#pragma unroll
                for (int bj = 0; bj < 2; ++bj) { const f32x4 v0 = acc[ai][bj][m][0] * gt, v1 = acc[ai][bj][m][1] * gt; u32x4 w; w.x = pkbf(v0[0], v0[1]); w.y = pkbf(v0[2], v0[3]); w.z = pkbf(v1[0], v1[1]); w.w = pkbf(v1[2], v1[3]); *(u32x4*)(rp + bj * 32) = w; } }
    }
};
struct EpiFinal {
    float* out; const bf16_t* EB; const float* rstde; const float* gpost;
    __device__ __forceinline__ void operator()(const AccT& acc, const pg8::Unit& u, int wr, int wc, int fr_, int fq_) const {
        int fr = fr_, fq = fq_; asm volatile("" : "+v"(fr), "+v"(fq));
        const int row0 = u.pm * 256 + wr * 64 + fr; const int col0 = u.pn * 256 + wc * 64 + 8 * fq;
        f32x4 gp[2][2];
#pragma unroll
        for (int bj = 0; bj < 2; ++bj)
#pragma unroll
            for (int n = 0; n < 2; ++n) gp[bj][n] = *(const f32x4*)(gpost + col0 + bj * 32 + n * 4);
#pragma unroll
        for (int ai = 0; ai < 2; ++ai)
#pragma unroll
            for (int m = 0; m < 4; ++m) { const int row = row0 + ai * 128 + m * 16; const size_t off = (size_t)row * 1024 + col0; const float re = rstde[row];
#pragma unroll
                for (int bj = 0; bj < 2; ++bj) { const u32x4 ev = *(const u32x4*)(EB + off + bj * 32);
                    const f32x4 e0 = (f32x4){bflo(ev.x), bfhi(ev.x), bflo(ev.y), bfhi(ev.y)} * gp[bj][0] * re, e1 = (f32x4){bflo(ev.z), bfhi(ev.z), bflo(ev.w), bfhi(ev.w)} * gp[bj][1] * re;
                    const f32x4 a0 = acc[ai][bj][m][0], a1 = acc[ai][bj][m][1]; f32x4 g0, g1;
#pragma unroll
                    for (int i = 0; i < 4; ++i) { g0[i] = __builtin_amdgcn_rcpf(1.0f + __builtin_amdgcn_exp2f(-LOG2E * a0[i])); g1[i] = __builtin_amdgcn_rcpf(1.0f + __builtin_amdgcn_exp2f(-LOG2E * a1[i])); }
                    const f32x4 x0 = *(const f32x4*)(out + off + bj * 32), x1 = *(const f32x4*)(out + off + bj * 32 + 4);
                    *(f32x4*)(out + off + bj * 32) = x0 + g0 * e0; *(f32x4*)(out + off + bj * 32 + 4) = x1 + g1 * e1; }
                asm volatile("" ::: "memory"); }
    }
};
struct OrderGU {
    int G, vcu;
    __device__ bool next(int i, pg8::Unit& u) const {
        int e, b, nt;
        if (G == 256) { if (i >= 8) return false; const int x = vcu >> 5, cu = vcu & 31; e = 2 * x + (i >> 2); b = cu & 7; nt = 4 * (i & 3) + (cu >> 3); }
        else { const int L = i * G + vcu; if (L >= 2048) return false; e = L >> 7; b = L & 7; nt = (L >> 3) & 15; }
        u.arow = (b * 16 + e) * 256; u.brow = e * 4096 + nt * 256; u.pm = b; u.pn = nt; u.grp = e; return true;
    }
};
struct OrderDown {
    int G, vcu;
    __device__ bool next(int i, pg8::Unit& u) const {
        int e, b, nt;
        if (G == 256) { if (i >= 2) return false; const int x = vcu >> 5, cu = vcu & 31; e = 2 * x + i; b = cu & 7; nt = cu >> 3; }
        else { const int L = i * G + vcu; if (L >= 512) return false; e = L >> 5; b = L & 7; nt = (L >> 3) & 3; }
        u.arow = (b * 16 + e) * 256; u.brow = e * 1024 + nt * 256; u.pm = b; u.pn = nt; u.grp = e; return true;
    }
};

constexpr int B2_OFF = 1024;
constexpr int DT_OFF = 32768, DT_PITCH = 136;
__device__ __forceinline__ void attn_task(Frame& F, int bh, int r, int qb) {
    const int lane = F.lane, g = lane >> 4, m = lane & 15; const int b = bh >> 3, h = bh & 7;
    int rs = r - 4; rs = rs < 0 ? 0 : (rs > ROWS - 8 ? ROWS - 8 : rs);
    const int c = 16 * qb + m; int cs = c - 8; cs = cs < 0 ? 0 : (cs > GW - 16 ? GW - 16 : cs);
    const bf16_t* Qb = WSP(const bf16_t, WS_Q); const bf16_t* Kb = WSP(const bf16_t, WS_K); const bf16_t* Vb = WSP(const bf16_t, WS_VT);
    const bf16_t* Qp = Qb + ((size_t)(bh * 2048 + 64 * r + c) * 64 + 8 * g);
    const bf16x8 qf0 = *(const bf16x8*)Qp, qf1 = *(const bf16x8*)(Qp + 32);
    const int kp_lo = (qb == 3) ? 1 : 0, kp_hi = (qb == 0) ? 0 : 1;
    f32x4 o[4];
#pragma unroll
    for (int dt = 0; dt < 4; ++dt) o[dt] = (f32x4){0.f, 0.f, 0.f, 0.f};
    float lsum = 0.f;
    const int rowa = 8 * (m >> 2) + (m & 3);
    const LAS float* b2 = (const LAS float*)(F.lds + B2_OFF);
    for (int i = 0; i < 8; ++i) {
        const int rk = rs + i, dr = rk - r + 7;
        for (int kp = kp_lo; kp <= kp_hi; ++kp) {
            const bf16_t* Kp = Kb + ((size_t)(bh * 2048 + 64 * rk + 32 * kp + rowa) * 64 + 8 * g);
            const bf16x8 ka0 = *(const bf16x8*)Kp, ka1 = *(const bf16x8*)(Kp + 32), kb0 = *(const bf16x8*)(Kp + 256), kb1 = *(const bf16x8*)(Kp + 256 + 32);
            const bf16_t* Vp = Vb + ((size_t)(bh * 64 + m) * 2048 + 64 * rk + 32 * kp + 8 * g);
            bf16x8 vf[4];
#pragma unroll
            for (int dt = 0; dt < 4; ++dt) vf[dt] = *(const bf16x8*)(Vp + (size_t)dt * 16 * 2048);
            f32x4 sa = (f32x4){0.f, 0.f, 0.f, 0.f}, sb = (f32x4){0.f, 0.f, 0.f, 0.f};
            sa = __builtin_amdgcn_mfma_f32_16x16x32_bf16(ka0, qf0, sa, 0, 0, 0); sa = __builtin_amdgcn_mfma_f32_16x16x32_bf16(ka1, qf1, sa, 0, 0, 0);
            sb = __builtin_amdgcn_mfma_f32_16x16x32_bf16(kb0, qf0, sb, 0, 0, 0); sb = __builtin_amdgcn_mfma_f32_16x16x32_bf16(kb1, qf1, sb, 0, 0, 0);
            const int kc0 = 32 * kp + 8 * g;
            const LAS float* bp = b2 + ((h * 15 + dr) * 32 + 15 - c + kc0);
            float pa[4], pb[4];
#pragma unroll
            for (int q = 0; q < 4; ++q) {
                const bool va = (unsigned)(kc0 + q - cs) < 16u, vb = (unsigned)(kc0 + 4 + q - cs) < 16u;
                const float ea = __builtin_amdgcn_exp2f(sa[q] + bp[q]), eb = __builtin_amdgcn_exp2f(sb[q] + bp[4 + q]);
                pa[q] = va ? ea : 0.f; pb[q] = vb ? eb : 0.f; }
            lsum += ((pa[0] + pa[1]) + (pa[2] + pa[3])) + ((pb[0] + pb[1]) + (pb[2] + pb[3]));
            u32x4 pw; pw.x = pkbf(pa[0], pa[1]); pw.y = pkbf(pa[2], pa[3]); pw.z = pkbf(pb[0], pb[1]); pw.w = pkbf(pb[2], pb[3]);
            const bf16x8 pf = __builtin_bit_cast(bf16x8, pw);
#pragma unroll
            for (int dt = 0; dt < 4; ++dt) o[dt] = __builtin_amdgcn_mfma_f32_16x16x32_bf16(vf[dt], pf, o[dt], 0, 0, 0);
        }
    }
    lsum += __shfl_xor(lsum, 16); lsum += __shfl_xor(lsum, 32);
    const float inv = 1.0f / lsum;
    bf16_t* op = WSP(bf16_t, WS_MIX) + (size_t)(b * 2048 + 64 * r + c) * 1024 + 512 + h * 64 + 4 * g;
#pragma unroll
    for (int dt = 0; dt < 4; ++dt) { u32x2 w; w.x = pkbf(o[dt][0] * inv, o[dt][1] * inv); w.y = pkbf(o[dt][2] * inv, o[dt][3] * inv); *(u32x2*)(op + 16 * dt) = w; }
}
__device__ __forceinline__ void pool_unit(Frame& F, int pm, int grp) {
    LAS bf16_t* Dt = (LAS bf16_t*)(F.lds + DT_OFF);
    const int tid = F.tid;
    {
        const int c = tid & 127, seg = tid >> 7; const int w = 2 << grp, hw = w >> 1;
        const int tok0 = pm * 256, b = tok0 >> 11, t0 = (tok0 & 2047) + seg * 64;
        const bf16_t* Ub = WSP(const bf16_t, WS_U) + (size_t)b * 2048 * 512 + grp * 128 + c;
        float s = 0.f;
        for (int q = t0 - hw; q <= t0 + hw - 1; ++q) if (q >= 0 && q < S) s += bf2f(Ub[(size_t)q * 512]);
        for (int k = 0; k < 64; ++k) { const int t = t0 + k; const int lo = (t - hw) < 0 ? 0 : (t - hw), hi = (t + hw - 1) > (S - 1) ? (S - 1) : (t + hw - 1);
            const float ut = bf2f(Ub[(size_t)t * 512]); const float d = s / (float)(hi - lo + 1) - ut;
            Dt[(seg * 64 + k) * DT_PITCH + c] = (bf16_t)(pkbf(d, 0.f) & 0xffffu);
            if (t + hw <= S - 1) s += bf2f(Ub[(size_t)(t + hw) * 512]);
            if (t - hw >= 0) s -= bf2f(Ub[(size_t)(t - hw) * 512]); }
    }
    __syncthreads();
    {
        const int lane = F.lane, g = lane >> 4, m = lane & 15, w = F.wave;
        const bf16_t* Wp = WSP(const bf16_t, WS_WPOOL) + (size_t)grp * 128 * 128;
        f32x4 acc[2][8];
#pragma unroll
        for (int mt = 0; mt < 2; ++mt)
#pragma unroll
            for (int nt = 0; nt < 8; ++nt) acc[mt][nt] = (f32x4){0.f, 0.f, 0.f, 0.f};
#pragma unroll
        for (int ks = 0; ks < 4; ++ks) { bf16x8 af[2];
#pragma unroll
            for (int mt = 0; mt < 2; ++mt) af[mt] = *(const LAS bf16x8*)(Dt + (32 * w + 16 * mt + m) * DT_PITCH + 32 * ks + 8 * g);
#pragma unroll
            for (int nt = 0; nt < 8; ++nt) { const bf16x8 wf = *(const bf16x8*)(Wp + (size_t)(16 * nt + m) * 128 + 32 * ks + 8 * g);
#pragma unroll
                for (int mt = 0; mt < 2; ++mt) acc[mt][nt] = __builtin_amdgcn_mfma_f32_16x16x32_bf16(wf, af[mt], acc[mt][nt], 0, 0, 0); } }
        bf16_t* mix = WSP(bf16_t, WS_MIX);
#pragma unroll
        for (int mt = 0; mt < 2; ++mt)
#pragma unroll
            for (int nt = 0; nt < 8; ++nt) { u32x2 o; o.x = pkbf(acc[mt][nt][0], acc[mt][nt][1]); o.y = pkbf(acc[mt][nt][2], acc[mt][nt][3]);
                *(u32x2*)(mix + (size_t)(pm * 256 + 32 * w + 16 * mt + m) * 1024 + grp * 128 + 16 * nt + 4 * g) = o; }
    }
    __syncthreads();
}
__device__ __forceinline__ void p2_mixer(Frame& F) {
    LAS float* b2 = (LAS float*)(F.lds + B2_OFF);
    for (int i = F.tid; i < 8 * 15 * 32; i += 512) { const int dc = i & 31, hd = i >> 5; b2[i] = dc < 31 ? F_rpb[hd * 31 + dc] * LOG2E : 0.f; }
    __syncthreads();
    const int gw = F.vcu * 8 + F.wave, NGW = F.G * 8;
    for (int wt = gw; wt < B * AH * ROWS * 4; wt += NGW) attn_task(F, wt >> 7, (wt >> 2) & 31, wt & 3);
    for (int u = F.vcu; u < 64 * 4; u += F.G) pool_unit(F, u >> 2, u & 3);
}

__device__ __forceinline__ void p4_router(Frame& F) {
    LAS float* wt = (LAS float*)F.lds;
    for (int i = F.tid; i < D * NE; i += 512) wt[(i & 15) * D + (i >> 4)] = F_w_router[i];
    __syncthreads();
    const int gw = F.vcu * 8 + F.wave, NGW = F.G * 8, lane = F.lane;
    bf16_t* H2 = WSP(bf16_t, WS_H2); float* aff = WSP(float, WS_AFF);
    for (int row = gw; row < T; row += NGW) {
        const f32x4* xr = (const f32x4*)(F.out + (size_t)row * D) + lane; const f32x4* gr = (const f32x4*)F_norm_ffn + lane;
        f32x4 v[4]; float s = 0.f;
#pragma unroll
        for (int j = 0; j < 4; ++j) { v[j] = xr[64 * j]; s += (v[j].x * v[j].x + v[j].y * v[j].y) + (v[j].z * v[j].z + v[j].w * v[j].w); }
        const float rstd = 1.0f / sqrtf(wave_sum(s) * (1.0f / D) + EPS);
        u32x2* o8 = (u32x2*)(H2 + (size_t)row * D) + lane;
#pragma unroll
        for (int j = 0; j < 4; ++j) { v[j] = v[j] * rstd * gr[64 * j]; u32x2 o; o.x = pkbf(v[j].x, v[j].y); o.y = pkbf(v[j].z, v[j].w); o8[64 * j] = o; }
        float lg[16];
#pragma unroll
        for (int e = 0; e < 16; ++e) { float a = 0.f;
#pragma unroll
            for (int j = 0; j < 4; ++j) { const f32x4 w4 = *(const LAS f32x4*)(wt + e * D + 256 * j + 4 * lane); a += (v[j].x * w4.x + v[j].y * w4.y) + (v[j].z * w4.z + v[j].w * w4.w); }
            lg[e] = wave_sum(a); if (e & 1) asm volatile("" ::: "memory"); }
        float mx = lg[0];
#pragma unroll
        for (int e = 1; e < 16; ++e) mx = fmaxf(mx, lg[e]);
        float sum = 0.f, mine = 0.f;
#pragma unroll
        for (int e = 0; e < 16; ++e) { const float ex = expf(lg[e] - mx); sum += ex; mine = (lane == e) ? ex : mine; }
        if (lane < 16) aff[((size_t)(row >> 11) * NE + lane) * S + (row & 2047)] = mine / sum;
    }
}

__device__ __forceinline__ void p5_topk_gather(Frame& F) {
    LAS int* sidx = (LAS int*)F.lds;
    const int lane = F.lane; const float* aff = WSP(const float, WS_AFF); float* gates = WSP(float, WS_GATES); int* slot_of = WSP(int, WS_SLOT);
    const bf16_t* H2 = WSP(const bf16_t, WS_H2); bf16_t* XE = WSP(bf16_t, WS_XE);
    for (int task = F.vcu; task < B * NE * 2; task += F.G) {
        const int be = task >> 1, half = task & 1, b = be >> 4, e = be & 15;
        if (F.wave == 0) {
            unsigned v[32];
#pragma unroll
            for (int j = 0; j < 32; ++j) v[j] = __builtin_bit_cast(unsigned, aff[(size_t)be * S + 64 * j + lane]);
            unsigned Tt = 0u;
            for (int bit = 30; bit >= 0; --bit) { const unsigned cand = Tt | (1u << bit); int cnt = 0;
#pragma unroll
                for (int j = 0; j < 32; ++j) cnt += (v[j] >= cand) ? 1 : 0;
#pragma unroll
                for (int o = 1; o < 64; o <<= 1) cnt += __shfl_xor(cnt, o);
                if (cnt >= CAP) Tt = cand; }
            int ngt = 0;
#pragma unroll
            for (int j = 0; j < 32; ++j) ngt += (v[j] > Tt) ? 1 : 0;
#pragma unroll
            for (int o = 1; o < 64; o <<= 1) ngt += __shfl_xor(ngt, o);
            const int need = CAP - ngt; int eq_run = 0, sel_run = 0;
            const unsigned long long ltmask = (lane == 0) ? 0ull : (~0ull >> (64 - lane));
#pragma unroll
            for (int j = 0; j < 32; ++j) {
                const bool gt = v[j] > Tt, eq = v[j] == Tt;
                const unsigned long long em = __ballot(eq);
                const int eqb = eq_run + __popcll(em & ltmask);
                const bool sel = gt || (eq && eqb < need);
                eq_run += __popcll(em);
                const unsigned long long sm = __ballot(sel);
                const int slot = sel_run + __popcll(sm & ltmask);
                sel_run += __popcll(sm);
                const int tok = 64 * j + lane;
                if (sel) sidx[slot] = tok;
                if (half == 0) { if (sel) gates[be * CAP + slot] = __builtin_bit_cast(float, v[j]); slot_of[((size_t)b * S + tok) * NE + e] = sel ? slot : -1; }
            }
        }
        __syncthreads();
        for (int i = 0; i < 16; ++i) { const int slot = half * 128 + F.wave * 16 + i; const int tok = sidx[slot];
            const u32x4* src = (const u32x4*)(H2 + ((size_t)b * S + tok) * D) + lane; u32x4* dst = (u32x4*)(XE + ((size_t)be * CAP + slot) * D) + lane;
            const u32x4 a0 = src[0], a1 = src[64]; dst[0] = a0; dst[64] = a1; }
        __syncthreads();
    }
}

__device__ __forceinline__ void p8_combine(Frame& F) {
    const int gw = F.vcu * 8 + F.wave, NGW = F.G * 8, lane = F.lane;
    const bf16_t* YE = WSP(const bf16_t, WS_XE); const int* slot_of = WSP(const int, WS_SLOT); bf16_t* X2N = WSP(bf16_t, WS_H2);
    const float* esq = WSP(const float, WS_ESQ); float* rstde = WSP(float, WS_RSTDE);
    for (int row = gw; row < T; row += NGW) {
        f32x4* xr = (f32x4*)(F.out + (size_t)row * D) + lane; const f32x4* gr = (const f32x4*)F_norm_ple + lane;
        f32x4 v[4];
#pragma unroll
        for (int j = 0; j < 4; ++j) v[j] = xr[64 * j];
        const int b = row >> 11;
        const int myslot = (lane < 16) ? slot_of[(size_t)row * NE + lane] : -1;
        for (int e = 0; e < NE; ++e) { const int sl = __shfl(myslot, e);
            if (sl >= 0) { const u32x2* yr = (const u32x2*)(YE + ((size_t)(b * NE + e) * CAP + sl) * D) + lane;
#pragma unroll
                for (int j = 0; j < 4; ++j) { const u32x2 y = yr[64 * j]; v[j].x += bflo(y.x); v[j].y += bfhi(y.x); v[j].z += bflo(y.y); v[j].w += bfhi(y.y); } } }
        float s = 0.f;
#pragma unroll
        for (int j = 0; j < 4; ++j) { xr[64 * j] = v[j]; s += (v[j].x * v[j].x + v[j].y * v[j].y) + (v[j].z * v[j].z + v[j].w * v[j].w); }
        const float rstd = 1.0f / sqrtf(wave_sum(s) * (1.0f / D) + EPS);
        u32x2* o8 = (u32x2*)(X2N + (size_t)row * D) + lane;
#pragma unroll
        for (int j = 0; j < 4; ++j) { const f32x4 gg = gr[64 * j]; u32x2 o; o.x = pkbf(v[j].x * rstd * gg.x, v[j].y * rstd * gg.y); o.y = pkbf(v[j].z * rstd * gg.z, v[j].w * rstd * gg.w); o8[64 * j] = o; }
        float q = (lane < 16) ? esq[(size_t)row * 16 + lane] : 0.f; q = wave_sum(q);
        if (lane == 0) rstde[row] = 1.0f / sqrtf(q * (1.0f / D) + EPS);
    }
}

constexpr int N_PHASES = 10;
__global__ void __launch_bounds__(512, 2) mega_fwd(MArgs args) {
    extern __shared__ __attribute__((aligned(16))) unsigned char lds_raw[];
    Frame F;
    F.lds = (LAS unsigned char*)lds_raw; F.tid = threadIdx.x; F.lane = F.tid & 63; F.wave = __builtin_amdgcn_readfirstlane(F.tid >> 6);
    F.G = gridDim.x; { const int bx = blockIdx.x; F.vcu = (F.G % 8 == 0) ? (bx % 8) * (F.G / 8) + bx / 8 : bx; }
    F.out = args.out; F.ws = args.ws; F.a = &args;
    for (int u = F.tid; u < (LDS_BYTES - LDSCTL_OFF) / 4; u += 512) ((LAS unsigned*)(F.lds + LDSCTL_OFF))[u] = 0u;
    __syncthreads();
    const int lo = args.ph_lo, hi = args.ph_hi;
    if (hi - lo > 1) xcd_barrier_post(WSP(unsigned, WS_CTL) + CW_BAR);
#ifndef PH_ENABLE
#define PH_ENABLE 0x3ff
#endif
#define IN(k) (((PH_ENABLE >> (k)) & 1) && lo <= (k) && (k) < hi)
#define SEAM(k) do { if (IN(k) && IN((k) + 1)) xcd_barrier(WSP(unsigned, WS_CTL) + CW_BAR, (volatile LAS unsigned*)(F.lds + MISC_OFF) + 8); } while (0)
    if (IN(0)) { p0_prologue(F); } SEAM(0);
    if (IN(1)) {
#ifndef NO_P1A
        { pg8::Gemm g{WSP(const bf16_t, WS_XN), WSP(const bf16_t, WS_WIN), 1024}; pg8::StaticOrder So; So.init(T, 2048, F.G, (int)blockIdx.x);
          EpiQKV E{WSP(bf16_t, WS_U), WSP(bf16_t, WS_Q), WSP(bf16_t, WS_K), WSP(bf16_t, WS_VT), F_q_norm, F_k_norm};
          pg8::gemm_phase(F.lds, g, So, E); }
#endif
#ifndef NO_P1B
        { pg8::Gemm g{WSP(const bf16_t, WS_PB), WSP(const bf16_t, WS_WPP), 256}; pg8::StaticOrder So; So.init(T, 1024, F.G, (int)blockIdx.x);
          EpiE E{WSP(bf16_t, WS_EB), WSP(float, WS_ESQ)};
          pg8::gemm_phase(F.lds, g, So, E); }
#endif
    } SEAM(1);
    if (IN(2)) { p2_mixer(F); } SEAM(2);
    if (IN(3)) { pg8::Gemm g{WSP(const bf16_t, WS_MIX), WSP(const bf16_t, WS_WOUT), 1024}; pg8::StaticOrder So; So.init(T, 1024, F.G, (int)blockIdx.x);
        EpiRes E{F_x, F.out}; pg8::gemm_phase(F.lds, g, So, E); } SEAM(3);
    if (IN(4)) { p4_router(F); } SEAM(4);
    if (IN(5)) { p5_topk_gather(F); } SEAM(5);
    if (IN(6)) { pg8::Gemm g{WSP(const bf16_t, WS_XE), WSP(const bf16_t, WS_WGU), 1024}; OrderGU So{F.G, F.vcu};
        EpiGU E{WSP(bf16_t, WS_HH)}; pg8::gemm_phase(F.lds, g, So, E); } SEAM(6);
    if (IN(7)) { pg8::Gemm g{WSP(const bf16_t, WS_HH), WSP(const bf16_t, WS_WD), 2048}; OrderDown So{F.G, F.vcu};
        EpiDown E{WSP(bf16_t, WS_XE), WSP(const float, WS_GATES)}; pg8::gemm_phase(F.lds, g, So, E); } SEAM(7);
    if (IN(8)) { p8_combine(F); } SEAM(8);
    if (IN(9)) { pg8::Gemm g{WSP(const bf16_t, WS_H2), WSP(const bf16_t, WS_WPG), 1024}; pg8::StaticOrder So; So.init(T, 1024, F.G, (int)blockIdx.x);
        EpiFinal E{F.out, WSP(const bf16_t, WS_EB), WSP(const float, WS_RSTDE), F_norm_ple_post}; pg8::gemm_phase(F.lds, g, So, E); }
#undef IN
#undef SEAM
}
static inline dim3 g1(size_t n) { return dim3((unsigned)((n + 255) / 256)); }

#ifndef MODE
#define MODE 0
#endif

extern "C" void kernel_launch(void* const* d_in, const int* in_sizes, int n_in, void* d_out, int out_size, void* d_ws, size_t ws_size, hipStream_t stream) {
    const float* x = (const float*)d_in[0]; const float* p = (const float*)d_in[1]; const float* norm_mix = (const float*)d_in[2]; const float* w_in = (const float*)d_in[3];
    const float* w_pool = (const float*)d_in[4]; const float* pool_scale = (const float*)d_in[5]; const float* q_norm = (const float*)d_in[6]; const float* k_norm = (const float*)d_in[7];
    const float* rpb = (const float*)d_in[8]; const float* w_out = (const float*)d_in[9]; const float* norm_ffn = (const float*)d_in[10]; const float* w_router = (const float*)d_in[11];
    const float* w_gate = (const float*)d_in[12]; const float* w_up = (const float*)d_in[13]; const float* w_down = (const float*)d_in[14]; const float* norm_ple = (const float*)d_in[15];
    const float* w_ple_gate = (const float*)d_in[16]; const float* w_ple_proj = (const float*)d_in[17]; const float* norm_ple_post = (const float*)d_in[18];
    float* out = (float*)d_out; char* ws = (char*)d_ws;
    (void)in_sizes; (void)n_in; (void)out_size;
    static int grid = 0;
    if (grid == 0) {
        if (ws_size < (size_t)489 * MiB) { fprintf(stderr, "kernel_launch: workspace too small (%zu)\n", ws_size); grid = -1; return; }
        int dev = 0, cus = 0, per_cu = 0;
        if (hipGetDevice(&dev) != hipSuccess || hipDeviceGetAttribute(&cus, hipDeviceAttributeMultiprocessorCount, dev) != hipSuccess) { grid = -1; return; }
        if (hipFuncSetAttribute((const void*)mega_fwd, hipFuncAttributeMaxDynamicSharedMemorySize, LDS_BYTES) != hipSuccess) { fprintf(stderr, "kernel_launch: hipFuncSetAttribute failed\n"); grid = -1; return; }
        if (hipOccupancyMaxActiveBlocksPerMultiprocessor(&per_cu, (const void*)mega_fwd, 512, LDS_BYTES) != hipSuccess || per_cu < 1) { fprintf(stderr, "kernel_launch: occupancy query says %d blocks per CU\n", per_cu); grid = -1; (void)hipGetLastError(); return; }
        grid = cus;
    }
    if (grid < 0) return;
    (void)hipMemsetAsync((char*)d_ws + WS_CTL, 0, CTL_ZERO_BYTES, stream);
    MArgs a{};
    for (int i = 0; i < 19; ++i) a.in[i] = (const float*)d_in[i];
    a.out = out; a.ws = (unsigned char*)d_ws;
#if MODE == 0
    a.ph_lo = 0; a.ph_hi = N_PHASES;
    hipLaunchKernelGGL(mega_fwd, dim3(grid), dim3(512), LDS_BYTES, stream, a);
#else
    constexpr int KOPT = MODE - 100;
    for (int ph = 0; ph <= KOPT; ++ph) { a.ph_lo = ph; a.ph_hi = ph + 1; hipLaunchKernelGGL(mega_fwd, dim3(grid), dim3(512), LDS_BYTES, stream, a); }
    float* xn = (float*)(ws + 0 * MiB);
    float* z = (float*)(ws + 64 * MiB);
    float* dp = (float*)(ws + 192 * MiB);
    float* ye = (float*)(ws + 288 * MiB);
    float* ga = (float*)(ws + 416 * MiB); float* gb = (float*)(ws + 448 * MiB);
    float* mix = (float*)(ws + 416 * MiB);
    float* aff = (float*)(ws + 485 * MiB); int* idx = (int*)(ws + 486 * MiB); float* gates = (float*)(ws + 487 * MiB); int* slot_of = (int*)(ws + 488 * MiB);
    const unsigned short* mU = (const unsigned short*)(ws + WS_U); const unsigned short* mQ = (const unsigned short*)(ws + WS_Q); const unsigned short* mK = (const unsigned short*)(ws + WS_K); const unsigned short* mVT = (const unsigned short*)(ws + WS_VT);
    if (KOPT < 1) {
        nv::rmsnorm_rows<<<T, 256, 0, stream>>>(x, norm_mix, xn, D);
        nv::gemm_f32<<<dim3(2048 / 64, T / 64, 1), 256, 0, stream>>>(xn, w_in, z, D, D, 2048, 2048, 0, 0, 0);
    }
    if (KOPT < 2) {
        if (KOPT == 1) nv::bf16_to_f32<<<g1((size_t)T * PW), 256, 0, stream>>>(mU, z, PW, 2048, (size_t)T * PW);
        nv::pool_diff<<<g1((size_t)T * PW), 256, 0, stream>>>(z, dp);
        nv::gemm_f32<<<dim3(PG / 64, T / 64, 4), 256, 0, stream>>>(dp, w_pool, mix, PG, PW, PG, D, PG, (size_t)PG * PG, PG);
        nv::scale_cols<<<g1((size_t)T * PW), 256, 0, stream>>>(mix, D, PW, pool_scale, (size_t)T * PW);
        if (KOPT == 1) nv::natten_pre<<<T * AH, 128, 0, stream>>>(mQ, mK, mVT, rpb, mix);
        else nv::natten<<<T * AH, 128, 0, stream>>>(z, q_norm, k_norm, rpb, mix);
    }
    if (KOPT < 3) {
        if (KOPT == 2) nv::bf16_to_f32<<<g1((size_t)T * D), 256, 0, stream>>>((const unsigned short*)(ws + WS_MIX), mix, D, D, (size_t)T * D);
        nv::gemm_f32<<<dim3(D / 64, T / 64, 1), 256, 0, stream>>>(mix, w_out, xn, D, D, D, D, 0, 0, 0);
        nv::add_to<<<g1((size_t)T * D), 256, 0, stream>>>(out, x, xn, (size_t)T * D);
    }
    if (KOPT < 4) {
        nv::rmsnorm_rows<<<T, 256, 0, stream>>>(out, norm_ffn, xn, D);
        nv::router<<<T, 256, 0, stream>>>(xn, w_router, aff);
    } else { aff = (float*)(ws + WS_AFF); }
    if (KOPT < 5) {
        if (KOPT == 4) nv::bf16_to_f32<<<g1((size_t)T * D), 256, 0, stream>>>((const unsigned short*)(ws + WS_H2), xn, D, D, (size_t)T * D);
        nv::topk<<<B * NE, 1024, 0, stream>>>(aff, idx, gates, slot_of);
        nv::gather_rows<<<B * NE * CAP, 256, 0, stream>>>(xn, idx, z);
    } else { gates = (float*)(ws + WS_GATES); slot_of = (int*)(ws + WS_SLOT); }
    if (KOPT < 7) {
        float* xe = z;
        if (KOPT >= 5) nv::bf16_to_f32<<<g1((size_t)B * NE * CAP * D), 256, 0, stream>>>((const unsigned short*)(ws + WS_XE), xe, D, D, (size_t)B * NE * CAP * D);
        for (int b = 0; b < B; ++b) {
            const float* xeb = xe + (size_t)b * NE * CAP * D;
            nv::gemm_f32<<<dim3(DE / 64, CAP / 64, NE), 256, 0, stream>>>(xeb, w_gate, ga, D, D, DE, DE, (size_t)CAP * D, (size_t)D * DE, (size_t)CAP * DE);
            nv::gemm_f32<<<dim3(DE / 64, CAP / 64, NE), 256, 0, stream>>>(xeb, w_up, gb, D, D, DE, DE, (size_t)CAP * D, (size_t)D * DE, (size_t)CAP * DE);
            nv::silu_mul<<<g1((size_t)NE * CAP * DE), 256, 0, stream>>>(ga, gb, (size_t)NE * CAP * DE);
            nv::gemm_f32<<<dim3(D / 64, CAP / 64, NE), 256, 0, stream>>>(ga, w_down, ye + (size_t)b * NE * CAP * D, DE, DE, D, D, (size_t)CAP * DE, (size_t)DE * D, (size_t)CAP * D);
        }
    }
    if (KOPT < 8) {
        if (KOPT == 7) nv::combine_bf16<<<T, 256, 0, stream>>>(out, (const unsigned short*)(ws + WS_XE), slot_of);
        else nv::combine<<<T, 256, 0, stream>>>(out, ye, gates, slot_of);
    }
    if (KOPT < 9) {
        nv::rmsnorm_rows<<<T, 256, 0, stream>>>(out, norm_ple, xn, D);
        nv::gemm_f32<<<dim3(D / 64, T / 64, 1), 256, 0, stream>>>(xn, w_ple_gate, mix, D, D, D, D, 0, 0, 0);
        float* eraw = ye;
        nv::gemm_f32<<<dim3(D / 64, T / 64, 1), 256, 0, stream>>>(p, w_ple_proj, eraw, PD, PD, D, D, 0, 0, 0);
        nv::rmsnorm_rows<<<T, 256, 0, stream>>>(eraw, norm_ple_post, xn, D);
        nv::ple_final<<<g1((size_t)T * D), 256, 0, stream>>>(out, mix, xn, (size_t)T * D);
    }
#endif
}
```

```cpp
#include <hip/hip_runtime.h>
#include <cstdio>
#include <cstdint>

namespace cfg {
constexpr int D = 1024, B = 8, S = 2048, T = B * S;
constexpr int GW = 64, ROWS = S / GW;
constexpr int PW = 512, PG = 128, AH = 8, HD = 64, NE = 16, CAP = 256, DE = 2048, PD = 256;
constexpr float EPS = 1e-6f;
}
using namespace cfg;

namespace nv {
__global__ void __launch_bounds__(256) rmsnorm_rows(const float* __restrict__ x, const float* __restrict__ g, float* __restrict__ out, int ncols) {
    __shared__ float red[256];
    const size_t row = blockIdx.x; const float* xr = x + row * ncols; float s = 0.f;
    for (int c = threadIdx.x; c < ncols; c += 256) { const float v = xr[c]; s += v * v; }
    red[threadIdx.x] = s; __syncthreads();
    for (int o = 128; o > 0; o >>= 1) { if ((int)threadIdx.x < o) red[threadIdx.x] += red[threadIdx.x + o]; __syncthreads(); }
    const float rstd = 1.0f / sqrtf(red[0] / (float)ncols + EPS);
    for (int c = threadIdx.x; c < ncols; c += 256) out[row * ncols + c] = xr[c] * rstd * g[c];
}
__global__ void __launch_bounds__(256) gemm_f32(const float* __restrict__ A, const float* __restrict__ Bm, float* __restrict__ C, int K, int lda, int ldb, int ldc, size_t sA, size_t sB, size_t sC) {
    __shared__ float As[16][65]; __shared__ float Bs[16][64];
    const int z = blockIdx.z; A += z * sA; Bm += z * sB; C += z * sC;
    const int m0 = blockIdx.y * 64, n0 = blockIdx.x * 64, tx = threadIdx.x & 15, ty = threadIdx.x >> 4;
    float acc[4][4] = {};
    for (int k0 = 0; k0 < K; k0 += 16) {
        for (int i = threadIdx.x; i < 1024; i += 256) { const int r = i >> 4, c = i & 15; As[c][r] = A[(size_t)(m0 + r) * lda + k0 + c]; }
        for (int i = threadIdx.x; i < 1024; i += 256) { const int r = i >> 6, c = i & 63; Bs[r][c] = Bm[(size_t)(k0 + r) * ldb + n0 + c]; }
        __syncthreads();
#pragma unroll
        for (int k = 0; k < 16; ++k) { float a[4], b[4];
#pragma unroll
            for (int i = 0; i < 4; ++i) { a[i] = As[k][ty * 4 + i]; b[i] = Bs[k][tx * 4 + i]; }
#pragma unroll
            for (int i = 0; i < 4; ++i)
#pragma unroll
                for (int j = 0; j < 4; ++j) acc[i][j] += a[i] * b[j]; }
        __syncthreads();
    }
#pragma unroll
    for (int i = 0; i < 4; ++i)
#pragma unroll
        for (int j = 0; j < 4; ++j) C[(size_t)(m0 + ty * 4 + i) * ldc + n0 + tx * 4 + j] = acc[i][j];
}
__global__ void __launch_bounds__(256) pool_diff(const float* __restrict__ z, float* __restrict__ d) {
    const size_t i = (size_t)blockIdx.x * 256 + threadIdx.x; if (i >= (size_t)T * PW) return;
    const int c = (int)(i % PW); const int tok = (int)(i / PW), b = tok / S, t = tok % S; const int gi = c / PG; const int w = 2 << gi;
    int lo = t - w / 2; if (lo < 0) lo = 0; int hi = t + (w - w / 2) - 1; if (hi > S - 1) hi = S - 1;
    float s = 0.f; for (int q = lo; q <= hi; ++q) s += z[((size_t)b * S + q) * 2048 + c];
    d[i] = s / (float)(hi - lo + 1) - z[(size_t)tok * 2048 + c];
}
__global__ void __launch_bounds__(256) scale_cols(float* __restrict__ y, int ld, int ncols, const float* __restrict__ sc, size_t n) {
    const size_t i = (size_t)blockIdx.x * 256 + threadIdx.x; if (i >= n) return; const int c = (int)(i % ncols); const size_t r = i / ncols; y[r * ld + c] *= sc[c];
}
__global__ void __launch_bounds__(128) natten(const float* __restrict__ z, const float* __restrict__ qn, const float* __restrict__ kn, const float* __restrict__ rpb, float* __restrict__ mix) {
    __shared__ float qs[64]; __shared__ float ps[128]; __shared__ float red[128];
    const int tok = blockIdx.x >> 3, h = blockIdx.x & 7, b = tok / S, t = tok % S, r = t / GW, c = t % GW, j = threadIdx.x;
    int rs = r - 4; if (rs < 0) rs = 0; if (rs > ROWS - 8) rs = ROWS - 8;
    int cs = c - 8; if (cs < 0) cs = 0; if (cs > GW - 16) cs = GW - 16;
    if (j < 64) qs[j] = z[(size_t)tok * 2048 + 512 + h * 64 + j];
    __syncthreads();
    float qss = 0.f; for (int d = 0; d < 64; ++d) qss += qs[d] * qs[d];
    const float rq = 1.0f / sqrtf(qss / 64.f + EPS);
    const int i = j >> 4, jj = j & 15; const int kt = b * S + (rs + i) * GW + cs + jj;
    const float* kr = z + (size_t)kt * 2048 + 1024 + h * 64;
    float kss = 0.f, dot = 0.f;
    for (int d = 0; d < 64; ++d) { const float kv = kr[d]; kss += kv * kv; dot += (qs[d] * rq * qn[d] * 0.125f) * (kv * kn[d]); }
    const float rk = 1.0f / sqrtf(kss / 64.f + EPS);
    const int dr = rs + i - r + 7, dc = cs + jj - c + 15;
    const float sc = dot * rk + rpb[(h * 15 + dr) * 31 + dc];
    red[j] = sc; __syncthreads();
    for (int o = 64; o > 0; o >>= 1) { if (j < o) red[j] = fmaxf(red[j], red[j + o]); __syncthreads(); }
    const float mx = red[0]; __syncthreads();
    const float p = expf(sc - mx); ps[j] = p; red[j] = p; __syncthreads();
    for (int o = 64; o > 0; o >>= 1) { if (j < o) red[j] += red[j + o]; __syncthreads(); }
    const float inv = 1.0f / red[0];
    if (j < 64) { float o = 0.f;
        for (int q = 0; q < 128; ++q) { const int vt = b * S + (rs + (q >> 4)) * GW + cs + (q & 15); o += ps[q] * z[(size_t)vt * 2048 + 1536 + h * 64 + j]; }
        mix[(size_t)tok * 1024 + 512 + h * 64 + j] = o * inv; }
}
__global__ void __launch_bounds__(256) add_to(float* __restrict__ o, const float* __restrict__ a, const float* __restrict__ b, size_t n) {
    const size_t i = (size_t)blockIdx.x * 256 + threadIdx.x; if (i < n) o[i] = a[i] + b[i];
}
__global__ void __launch_bounds__(256) router(const float* __restrict__ h2, const float* __restrict__ wr, float* __restrict__ aff) {
    __shared__ float red[16][256];
    const int tok = blockIdx.x; float acc[16] = {};
    for (int d = threadIdx.x; d < D; d += 256) { const float v = h2[(size_t)tok * D + d];
#pragma unroll
        for (int e = 0; e < 16; ++e) acc[e] += v * wr[d * 16 + e]; }
#pragma unroll
    for (int e = 0; e < 16; ++e) red[e][threadIdx.x] = acc[e];
    __syncthreads();
    for (int o = 128; o > 0; o >>= 1) { if ((int)threadIdx.x < o) { for (int e = 0; e < 16; ++e) red[e][threadIdx.x] += red[e][threadIdx.x + o]; } __syncthreads(); }
    if (threadIdx.x < 16) { float mx = -1e30f; for (int e = 0; e < 16; ++e) mx = fmaxf(mx, red[e][0]); float sum = 0.f; for (int e = 0; e < 16; ++e) sum += expf(red[e][0] - mx);
        const int e = threadIdx.x, b = tok / S, s = tok % S; aff[((size_t)b * NE + e) * S + s] = expf(red[e][0] - mx) / sum; }
}
__global__ void __launch_bounds__(1024) topk(const float* __restrict__ aff, int* __restrict__ idx, float* __restrict__ gates, int* __restrict__ slot_of) {
    __shared__ float v[S];
    const int be = blockIdx.x, b = be / NE, e = be % NE;
    for (int i = threadIdx.x; i < S; i += 1024) v[i] = aff[(size_t)be * S + i];
    __syncthreads();
    for (int i = threadIdx.x; i < S; i += 1024) { const float vi = v[i]; int rank = 0;
        for (int q = 0; q < S; ++q) { const float vq = v[q]; rank += (vq > vi || (vq == vi && q < i)) ? 1 : 0; }
        if (rank < CAP) { idx[be * CAP + rank] = i; gates[be * CAP + rank] = vi; }
        slot_of[((size_t)b * S + i) * NE + e] = rank < CAP ? rank : -1; }
}
__global__ void __launch_bounds__(256) gather_rows(const float* __restrict__ h2, const int* __restrict__ idx, float* __restrict__ xe) {
    const int slot = blockIdx.x; const int be = slot / CAP, b = be / NE; const int tok = b * S + idx[slot];
    for (int c = threadIdx.x; c < D; c += 256) xe[(size_t)slot * D + c] = h2[(size_t)tok * D + c];
}
__global__ void __launch_bounds__(256) silu_mul(float* __restrict__ a, const float* __restrict__ bb, size_t n) {
    const size_t i = (size_t)blockIdx.x * 256 + threadIdx.x; if (i < n) { const float x = a[i]; a[i] = x / (1.0f + expf(-x)) * bb[i]; }
}
__global__ void __launch_bounds__(256) combine(float* __restrict__ x, const float* __restrict__ ye, const float* __restrict__ gates, const int* __restrict__ slot_of) {
    const int tok = blockIdx.x, b = tok / S;
    for (int c = threadIdx.x; c < D; c += 256) { float acc = x[(size_t)tok * D + c];
        for (int e = 0; e < NE; ++e) { const int sl = slot_of[(size_t)tok * NE + e]; if (sl >= 0) { const int slot = (b * NE + e) * CAP + sl; acc += ye[(size_t)slot * D + c] * gates[slot]; } }
        x[(size_t)tok * D + c] = acc; }
}
__global__ void __launch_bounds__(256) ple_final(float* __restrict__ x, const float* __restrict__ glog, const float* __restrict__ en, size_t n) {
    const size_t i = (size_t)blockIdx.x * 256 + threadIdx.x; if (i < n) { const float g = 1.0f / (1.0f + expf(-glog[i])); x[i] = x[i] + g * en[i]; }
}
}

#define MODE 0
#define GAS __attribute__((address_space(1)))
#define LAS __attribute__((address_space(3)))
typedef unsigned short bf16_t;
typedef short bf16x8 __attribute__((ext_vector_type(8)));
typedef float f32x4 __attribute__((ext_vector_type(4)));
typedef float f32x2 __attribute__((ext_vector_type(2)));
typedef unsigned u32x4 __attribute__((ext_vector_type(4)));
typedef unsigned u32x2 __attribute__((ext_vector_type(2)));
typedef __bf16 bf16x2_t __attribute__((ext_vector_type(2)));

__device__ __forceinline__ unsigned pkbf(float lo, float hi) { f32x2 v = {lo, hi}; bf16x2_t b = __builtin_convertvector(v, bf16x2_t); return __builtin_bit_cast(unsigned, b); }
__device__ __forceinline__ float bf2f(unsigned short u) { return __builtin_bit_cast(float, (unsigned)u << 16); }
__device__ __forceinline__ float bflo(unsigned u) { return __builtin_bit_cast(float, u << 16); }
__device__ __forceinline__ float bfhi(unsigned u) { return __builtin_bit_cast(float, u & 0xffff0000u); }
__device__ __forceinline__ float wave_sum(float v) {
#pragma unroll
    for (int o = 1; o < 64; o <<= 1) v += __shfl_xor(v, o);
    return v;
}
constexpr float LOG2E = 1.4426950408889634f;

namespace pg8 {
constexpr int BM = 256, BK = 64, HALF = 128, HTB = HALF * BK * 2, STAGE_BYTES = 8 * HTB;
__host__ __device__ __forceinline__ int lds_byte(int r, int c) { const int st = (r >> 4) * 2 + (c >> 5), rr = r & 15, cc = c & 31, ob = rr * 64 + cc * 2; return st * 1024 + (ob ^ (((ob >> 9) & 1) << 5)); }
__host__ __device__ __forceinline__ void stage_rc(int b, int& R, int& C) { const int st = b / 1024, sb = b % 1024, swz = sb ^ (((sb >> 9) & 1) << 5); R = (st >> 1) * 16 + swz / 64; C = (st & 1) * 32 + (swz % 64) / 2; }
__host__ __device__ __forceinline__ int perm32(int rho) { const int n = rho >> 4, i = rho & 15; return 8 * (i >> 2) + 4 * n + (i & 3); }

struct Unit { int arow, brow, pm, pn, grp; };
struct Gemm { const bf16_t* A; const bf16_t* Bt; int K; };

struct StaticOrder {
    int nM, nN, nwg, G, c;
    __device__ void init(int M, int N, int G_, int c_) { nM = M / BM; nN = N / BM; nwg = nM * nN; G = G_; c = c_; }
    __device__ bool next(int i, Unit& u) const {
        const long L = (long)i * G + c; if (L >= nwg) return false;
        int wgid = (int)L; { const int q = nwg / 8, r = nwg % 8, xcd = wgid % 8, off = wgid / 8; wgid = (xcd < r ? xcd * (q + 1) : r * (q + 1) + (xcd - r) * q) + off; }
        const int nig = 8 * nN, gid = wgid / nig, fm = gid * 8, gsz = (nM - fm) < 8 ? (nM - fm) : 8;
        u.pm = fm + ((wgid % nig) % gsz); u.pn = (wgid % nig) / gsz; u.arow = u.pm * BM; u.brow = u.pn * BM; u.grp = 0; return true;
    }
};

template <class Epi, class Sched>
__device__ __forceinline__ void gemm_phase(LAS unsigned char* lds, const Gemm g, const Sched& S, const Epi& E) {
    const int tid = threadIdx.x, wid = __builtin_amdgcn_readfirstlane(tid >> 6), lane = tid & 63, wr = wid >> 2, wc = wid & 3, fr = lane & 15, fq = lane >> 4;
    int K = g.K; asm volatile("" : "+s"(K));
    const int nt = K / BK;
    unsigned voffA[2], voffB[2];
#pragma unroll
    for (int i = 0; i < 2; ++i) { int R, C; stage_rc(tid * 16 + i * 8192, R, C); const int Rb = 64 * (R >> 5) + perm32(R & 31);
        voffA[i] = (unsigned)(R * K + C) * 2u; voffB[i] = (unsigned)(Rb * K + C) * 2u; }
    const unsigned kstep = (unsigned)(BK * 2);
    const unsigned hstep = (unsigned)HALF * K * 2;
    const unsigned hstepB = (unsigned)32 * K * 2;
    const unsigned rstep = (unsigned)K * 2;
    const unsigned ldsw = (unsigned)wid * 1024u;
    const int aoff = lds_byte(wr * 64 + fr, fq * 8), boff = lds_byte(wc * 32 + fr, fq * 8);
#define PG8_SA(b, h) (((b) * 2 + (h)) * HTB)
#define PG8_SB(b, h) ((4 + (b) * 2 + (h)) * HTB)
#define PG8_STAGE(bufoff, gbase, voff) do { _Pragma("unroll") for (int _i = 0; _i < 2; ++_i) \
        __builtin_amdgcn_global_load_lds((const unsigned*)((const char*)(gbase) + (voff)[_i]), (LAS unsigned*)(lds + (bufoff) + ldsw + _i * 8192), 16, 0, 0); } while (0)
#define PG8_LDA(dst, b, h) do { _Pragma("unroll") for (int m = 0; m < 4; ++m) _Pragma("unroll") for (int k = 0; k < 2; ++k) dst[m][k] = *(const LAS bf16x8*)(lds + PG8_SA(b, h) + aoff + m * 2048 + k * 1024); } while (0)
#define PG8_LDB(dst, b, h) do { _Pragma("unroll") for (int n = 0; n < 2; ++n) _Pragma("unroll") for (int k = 0; k < 2; ++k) dst[n][k] = *(const LAS bf16x8*)(lds + PG8_SB(b, h) + boff + n * 2048 + k * 1024); } while (0)
#define PG8_MMA(ai, bj, At, Bt) do { __builtin_amdgcn_s_setprio(1); _Pragma("unroll") for (int m = 0; m < 4; ++m) _Pragma("unroll") for (int n = 0; n < 2; ++n) _Pragma("unroll") for (int k = 0; k < 2; ++k) \
        acc[ai][bj][m][n] = __builtin_amdgcn_mfma_f32_16x16x32_bf16(Bt[n][k], At[m][k], acc[ai][bj][m][n], 0, 0, 0); __builtin_amdgcn_s_setprio(0); } while (0)
#define PG8_WAIT_V(n) asm volatile("s_waitcnt vmcnt(" #n ")" ::: "memory")
#define PG8_WAIT_L(n) asm volatile("s_waitcnt lgkmcnt(" #n ")" ::: "memory")
#define PG8_BAR __builtin_amdgcn_s_barrier()
#define PG8_SCHED __builtin_amdgcn_sched_barrier(0)
    Unit cur, nxt; int ui = 0;
    if (!S.next(0, cur)) return;
    f32x4 acc[2][2][4][2];
#pragma unroll
    for (int a = 0; a < 2; ++a)
#pragma unroll
        for (int b = 0; b < 2; ++b)
#pragma unroll
            for (int m = 0; m < 4; ++m)
#pragma unroll
                for (int n = 0; n < 2; ++n) acc[a][b][m][n] = (f32x4){0.f, 0.f, 0.f, 0.f};
    bf16x8 At[4][2], B0[2][2], B1[2][2];
    const char* cA = (const char*)g.A + (size_t)cur.arow * rstep; const char* cB = (const char*)g.Bt + (size_t)cur.brow * rstep;
    PG8_STAGE(PG8_SB(0, 0), cB, voffB); PG8_STAGE(PG8_SB(0, 1), cB + hstepB, voffB); PG8_STAGE(PG8_SA(0, 0), cA, voffA); PG8_STAGE(PG8_SA(0, 1), cA + hstep, voffA);
    if (wr == 1) PG8_BAR;
    PG8_WAIT_V(2); PG8_BAR;
    PG8_STAGE(PG8_SB(1, 0), cB + kstep, voffB); PG8_STAGE(PG8_SA(1, 0), cA + kstep, voffA); PG8_STAGE(PG8_SB(1, 1), cB + hstepB + kstep, voffB);
    PG8_WAIT_V(6); PG8_BAR;
    for (;;) {
        const bool has_next = S.next(ui + 1, nxt);
        const char* nA = has_next ? (const char*)g.A + (size_t)nxt.arow * rstep : cA; const char* nB = has_next ? (const char*)g.Bt + (size_t)nxt.brow * rstep : cB;
        for (int t = 0; t < nt; t += 2) {
            const bool last = (t == nt - 2);
            const char* a1 = cA + (unsigned)(t + 1) * kstep;
            const char* a2 = last ? nA : cA + (unsigned)(t + 2) * kstep; const char* b2 = last ? nB : cB + (unsigned)(t + 2) * kstep;
            const char* a3 = a2 + kstep; const char* b3 = b2 + kstep;
            PG8_LDB(B0, 0, 0); PG8_LDB(B1, 0, 1); PG8_SCHED; PG8_LDA(At, 0, 0); PG8_STAGE(PG8_SA(1, 1), a1 + hstep, voffA);
            PG8_WAIT_V(8); PG8_WAIT_L(0); PG8_BAR; PG8_MMA(0, 0, At, B0); PG8_MMA(0, 1, At, B1); PG8_BAR; PG8_SCHED;
            PG8_LDA(At, 0, 1); PG8_STAGE(PG8_SB(0, 0), b2, voffB); PG8_STAGE(PG8_SB(0, 1), b2 + hstepB, voffB); PG8_STAGE(PG8_SA(0, 0), a2, voffA);
            PG8_WAIT_V(8); PG8_WAIT_L(0); PG8_BAR; PG8_MMA(1, 0, At, B0); PG8_MMA(1, 1, At, B1); PG8_BAR; PG8_SCHED;
            PG8_LDB(B0, 1, 0); PG8_LDB(B1, 1, 1); PG8_SCHED; PG8_LDA(At, 1, 0); PG8_STAGE(PG8_SA(0, 1), a2 + hstep, voffA);
            PG8_WAIT_V(8); PG8_WAIT_L(0); PG8_BAR; PG8_MMA(0, 0, At, B0); PG8_MMA(0, 1, At, B1); PG8_BAR; PG8_SCHED;
            PG8_LDA(At, 1, 1); PG8_STAGE(PG8_SB(1, 0), b3, voffB); PG8_STAGE(PG8_SB(1, 1), b3 + hstepB, voffB); PG8_STAGE(PG8_SA(1, 0), a3, voffA);
            PG8_WAIT_V(8); PG8_WAIT_L(0); PG8_BAR; PG8_MMA(1, 0, At, B0); PG8_MMA(1, 1, At, B1); PG8_BAR; PG8_SCHED;
        }
        if (wr == 0) PG8_BAR;
        E(acc, cur, wr, wc, fr, fq);
        if (!has_next) break;
#pragma unroll
        for (int a = 0; a < 2; ++a)
#pragma unroll
            for (int b = 0; b < 2; ++b)
#pragma unroll
                for (int m = 0; m < 4; ++m)
#pragma unroll
                    for (int n = 0; n < 2; ++n) acc[a][b][m][n] = (f32x4){0.f, 0.f, 0.f, 0.f};
        cur = nxt; cA = nA; cB = nB; ++ui;
        if (wr == 1) PG8_BAR;
    }
    PG8_WAIT_V(0);
    PG8_BAR;
#undef PG8_SA
#undef PG8_SB
#undef PG8_STAGE
#undef PG8_LDA
#undef PG8_LDB
#undef PG8_MMA
#undef PG8_WAIT_V
#undef PG8_WAIT_L
#undef PG8_BAR
#undef PG8_SCHED
}
}

constexpr size_t MiB = (size_t)1 << 20;
constexpr size_t WS_CTL = 0, CTL_ZERO_BYTES = 64 * 1024;
constexpr size_t WS_WIN = 4 * MiB, WS_WOUT = 8 * MiB, WS_WPG = 10 * MiB, WS_WPP = 12 * MiB, WS_WPOOL = 12 * MiB + 512 * 1024;
constexpr size_t WS_WGU = 16 * MiB, WS_WD = 144 * MiB;
constexpr size_t WS_HH = 208 * MiB;
constexpr size_t WS_U = 208 * MiB, WS_Q = 224 * MiB, WS_K = 240 * MiB, WS_VT = 256 * MiB, WS_MIX = 272 * MiB, WS_XN = 304 * MiB;
constexpr size_t WS_PB = 336 * MiB, WS_EB = 344 * MiB, WS_H2 = 376 * MiB  , WS_XE = 408 * MiB  ;
constexpr size_t WS_AFF = 480 * MiB, WS_GATES = 481 * MiB, WS_SLOT = 482 * MiB, WS_ESQ = 483 * MiB, WS_RSTDE = 484 * MiB;
constexpr size_t WS_MEGA_END = 485 * MiB;
constexpr int CW_BAR = 1024;

constexpr int RING_BYTES = 131072, LDSCTL_OFF = RING_BYTES, MISC_OFF = LDSCTL_OFF + 320, LDS_BYTES = 147456;

#define XB_TMO      128
#define XB_XCNT(j)  (256  + 64 * (j))
#define XB_XSUB(j)  (1280 + 64 * (j))
#define XB_XGEN(j)  (2304 + 64 * (j))
#define XB_TOP      3328
#define XB_TOPGEN   3392
#define XCD_BAR_WORDS 3456
#define XB_SPIN_CAP (1u << 18)
__device__ __forceinline__ unsigned xb_ld(unsigned* p)              { return __hip_atomic_load(p, __ATOMIC_RELAXED, __HIP_MEMORY_SCOPE_AGENT); }
__device__ __forceinline__ unsigned xb_add(unsigned* p, unsigned v) { return __hip_atomic_fetch_add(p, v, __ATOMIC_RELAXED, __HIP_MEMORY_SCOPE_AGENT); }
__device__ __forceinline__ unsigned xb_xcc_id() { return (unsigned)__builtin_amdgcn_s_getreg((3 << 11) | 20) & 0xFu; }
#define XB_SPIN(cond, bar) do { unsigned _sp = 0; while (cond) { __builtin_amdgcn_s_sleep(1); \
    if ((++_sp & 255u) == 0u) { if (xb_ld(&(bar)[XB_TMO])) break; if (_sp > XB_SPIN_CAP) { atomicAdd(&(bar)[XB_TMO], 1u); break; } } } } while (0)
__device__ __forceinline__ void xcd_barrier_post(unsigned* bar) { if (threadIdx.x == 0) (void)xb_add(&bar[XB_XCNT(xb_xcc_id())], 1u); }
__device__ __forceinline__ void xcd_barrier_complete(unsigned* bar, unsigned x, unsigned& nloc, unsigned& nx) {
    const unsigned G = gridDim.x * gridDim.y * gridDim.z;
    unsigned sum, cnt, mine, sp = 0u;
    for (;;) {
        sum = 0u; cnt = 0u; mine = 0u;
#pragma unroll
        for (unsigned j = 0; j < 16; ++j) { const unsigned c = xb_ld(&bar[XB_XCNT(j)]); sum += c; cnt += (c > 0u) ? 1u : 0u; mine = (j == x) ? c : mine; }
        if (sum == G) break;
        __builtin_amdgcn_s_sleep(1);
        if ((++sp & 255u) == 0u) { if (xb_ld(&bar[XB_TMO])) break; if (sp > XB_SPIN_CAP) { atomicAdd(&bar[XB_TMO], 1u); break; } }
    }
    nloc = mine > 0u ? mine : 1u; nx = cnt > 0u ? cnt : 1u;
}
__device__ __forceinline__ void xcd_barrier(unsigned* bar, volatile LAS unsigned* st) {
    asm volatile("s_waitcnt vmcnt(0)" ::: "memory");
    __syncthreads();
    if (threadIdx.x == 0) {
        const unsigned x = xb_xcc_id();
        __builtin_amdgcn_s_waitcnt(0);
        unsigned nloc = st[0], nx = st[1];
        if (nloc == 0u) { xcd_barrier_complete(bar, x, nloc, nx); st[0] = nloc; st[1] = nx; }
        const unsigned old = xb_add(&bar[XB_XSUB(x)], 1u);
        const unsigned gen = old / nloc;
        if (old + 1u == (gen + 1u) * nloc) {
            __builtin_amdgcn_fence(__ATOMIC_RELEASE, "agent");
            asm volatile("s_waitcnt vmcnt(0)" ::: "memory");
            const unsigned og = xb_add(&bar[XB_TOP], 1u);
            const unsigned tg = og / nx;
            if (og + 1u == (tg + 1u) * nx) xb_add(&bar[XB_TOPGEN], 1u);
            else XB_SPIN(xb_ld(&bar[XB_TOPGEN]) == tg, bar);
            __builtin_amdgcn_fence(__ATOMIC_ACQUIRE, "agent");
            xb_add(&bar[XB_XGEN(x)], 1u);
            asm volatile("s_waitcnt vmcnt(0)" ::: "memory");
        } else {
            XB_SPIN(xb_ld(&bar[XB_XGEN(x)]) == gen, bar);
            __builtin_amdgcn_fence(__ATOMIC_ACQUIRE, "agent");
            asm volatile("s_waitcnt vmcnt(0)" ::: "memory");
        }
    }
    __syncthreads();
}

struct MArgs { const float* in[19]; float* out; unsigned char* ws; int ph_lo, ph_hi; };
struct Frame {
    LAS unsigned char* lds; int tid, lane, wave, vcu, G;
    float* out; unsigned char* ws; const MArgs* a;
};
#define F_x (F.a->in[0])
#define F_p (F.a->in[1])
#define F_norm_mix (F.a->in[2])
#define F_w_in (F.a->in[3])
#define F_w_pool (F.a->in[4])
#define F_pool_scale (F.a->in[5])
#define F_q_norm (F.a->in[6])
#define F_k_norm (F.a->in[7])
#define F_rpb (F.a->in[8])
#define F_w_out (F.a->in[9])
#define F_norm_ffn (F.a->in[10])
#define F_w_router (F.a->in[11])
#define F_w_gate (F.a->in[12])
#define F_w_up (F.a->in[13])
#define F_w_down (F.a->in[14])
#define F_norm_ple (F.a->in[15])
#define F_w_ple_gate (F.a->in[16])
#define F_w_ple_proj (F.a->in[17])
#define F_norm_ple_post (F.a->in[18])
#define WSP(T, off) ((T*)(F.ws + (off)))

__device__ __forceinline__ void tr_item(const float* W, int K, int N, bf16_t* WT, int kb, int nb, int dst_row0, LAS float* scr, int lane) {
    const int k0 = 64 * kb, n0 = 32 * nb;
#pragma unroll 8
    for (int i = 0; i < 32; ++i) { const int kk = 2 * i + (lane >> 5); scr[kk * 33 + (lane & 31)] = W[(size_t)(k0 + kk) * N + n0 + (lane & 31)]; }
    asm volatile("s_waitcnt lgkmcnt(0)" ::: "memory");
    const int c = lane & 7;
#pragma unroll
    for (int j = 0; j < 4; ++j) { const int n = (lane >> 3) + 8 * j; const LAS float* s = scr + (8 * c) * 33 + n;
        u32x4 o; o.x = pkbf(s[0 * 33], s[1 * 33]); o.y = pkbf(s[2 * 33], s[3 * 33]); o.z = pkbf(s[4 * 33], s[5 * 33]); o.w = pkbf(s[6 * 33], s[7 * 33]);
        *(u32x4*)(WT + (size_t)(dst_row0 + n) * K + k0 + 8 * c) = o; }
    asm volatile("s_waitcnt lgkmcnt(0)" ::: "memory");
}
__device__ __forceinline__ void rms_row_to_bf16(const float* xrow, const float* g, bf16_t* orow, int lane) {
    const f32x4* xr = (const f32x4*)xrow + lane; const f32x4* gr = (const f32x4*)g + lane;
    f32x4 v[4]; float s = 0.f;
#pragma unroll
    for (int j = 0; j < 4; ++j) { v[j] = xr[64 * j]; s += (v[j].x * v[j].x + v[j].y * v[j].y) + (v[j].z * v[j].z + v[j].w * v[j].w); }
    const float rstd = 1.0f / sqrtf(wave_sum(s) * (1.0f / D) + EPS);
    u32x2* o8 = (u32x2*)orow + lane;
#pragma unroll
    for (int j = 0; j < 4; ++j) { const f32x4 gg = gr[64 * j]; u32x2 o; o.x = pkbf(v[j].x * rstd * gg.x, v[j].y * rstd * gg.y); o.y = pkbf(v[j].z * rstd * gg.z, v[j].w * rstd * gg.w); o8[64 * j] = o; }
}
__device__ __forceinline__ void p0_prologue(Frame& F) {
    LAS float* scr = (LAS float*)(F.lds + F.wave * 16384);
    const int gw = F.vcu * 8 + F.wave, NGW = F.G * 8;
    constexpr int I_IN = 16 * 64, I_OUT = 16 * 32, I_PG = 16 * 32, I_PP = 4 * 32, I_E = 1024;
    constexpr int NSMALL = I_IN + I_OUT + I_PG + I_PP, NITEMS = NSMALL + 3 * 16 * I_E;
    bf16_t* Win_t = WSP(bf16_t, WS_WIN); bf16_t* Wout_t = WSP(bf16_t, WS_WOUT); bf16_t* Wpg_t = WSP(bf16_t, WS_WPG); bf16_t* Wpp_t = WSP(bf16_t, WS_WPP);
    bf16_t* Wgu_t = WSP(bf16_t, WS_WGU); bf16_t* Wd_t = WSP(bf16_t, WS_WD);
    for (int it = gw; it < NITEMS; it += NGW) {
        int r = it;
        if (r < I_IN) { tr_item(F_w_in, 1024, 2048, Win_t, r / 64, r % 64, 32 * (r % 64), scr, F.lane); continue; } r -= I_IN;
        if (r < I_OUT) { tr_item(F_w_out, 1024, 1024, Wout_t, r / 32, r % 32, 32 * (r % 32), scr, F.lane); continue; } r -= I_OUT;
        if (r < I_PG) { tr_item(F_w_ple_gate, 1024, 1024, Wpg_t, r / 32, r % 32, 32 * (r % 32), scr, F.lane); continue; } r -= I_PG;
        if (r < I_PP) { tr_item(F_w_ple_proj, 256, 1024, Wpp_t, r / 32, r % 32, 32 * (r % 32), scr, F.lane); continue; } r -= I_PP;
        const int mat = r / (16 * I_E), e = (r / I_E) % 16, q = r % I_E;
        if (mat < 2) {
            const int kb = q / 64, nb = q % 64, n0 = 32 * nb;
            tr_item((mat == 0 ? F_w_gate : F_w_up) + (size_t)e * 1024 * 2048, 1024, 2048, Wgu_t, kb, nb, e * 4096 + (n0 >> 7) * 256 + ((n0 >> 5) & 3) * 64 + 32 * mat, scr, F.lane);
        } else {
            const int kb = q / 32, nb = q % 32;
            tr_item(F_w_down + (size_t)e * 2048 * 1024, 2048, 1024, Wd_t, kb, nb, e * 1024 + 32 * nb, scr, F.lane);
        }
    }
    bf16_t* XN = WSP(bf16_t, WS_XN);
    for (int m = gw; m < T; m += NGW) rms_row_to_bf16(F_x + (size_t)m * D, F_norm_mix, XN + (size_t)m * D, F.lane);
    { const int gt = F.vcu * 512 + F.tid, NT_ = F.G * 512; const f32x4* p4 = (const f32x4*)F_p; u32x2* o = WSP(u32x2, WS_PB);
      for (int i = gt; i < T * PD / 4; i += NT_) { const f32x4 v = p4[i]; u32x2 w; w.x = pkbf(v.x, v.y); w.y = pkbf(v.z, v.w); o[i] = w; }
      bf16_t* Wp = WSP(bf16_t, WS_WPOOL);
      for (int i = gt; i < 4 * 128 * 128; i += NT_) { const int gg = i >> 14, n = (i >> 7) & 127, k = i & 127; const float v = F_w_pool[(gg * 128 + k) * 128 + n] * F_pool_scale[gg * 128 + n]; Wp[i] = (bf16_t)(pkbf(v, 0.f) & 0xffffu); }
    }
}

typedef f32x4 AccT[2][2][4][2];
struct EpiQKV {
    bf16_t *U, *Q, *Kk, *VT; const float *qn, *kn;
    __device__ __forceinline__ void operator()(const AccT& acc, const pg8::Unit& u, int wr, int wc, int fr_, int fq_) const {
        int fr = fr_, fq = fq_; asm volatile("" : "+v"(fr), "+v"(fq));
        const int type = u.pn >> 1; const int row0 = u.pm * 256 + wr * 64 + fr;
        if (type == 0) {
#pragma unroll
            for (int ai = 0; ai < 2; ++ai)
#pragma unroll
                for (int m = 0; m < 4; ++m) { const int row = row0 + ai * 128 + m * 16; bf16_t* rp = U + (size_t)row * 512 + (u.pn & 1) * 256 + wc * 64 + 8 * fq;
#pragma unroll
                    for (int bj = 0; bj < 2; ++bj) { const f32x4 v0 = acc[ai][bj][m][0], v1 = acc[ai][bj][m][1]; u32x4 w; w.x = pkbf(v0[0], v0[1]); w.y = pkbf(v0[2], v0[3]); w.z = pkbf(v1[0], v1[1]); w.w = pkbf(v1[2], v1[3]); *(u32x4*)(rp + bj * 32) = w; } asm volatile("" ::: "memory"); }
        } else if (type == 3) {
            const int hh = (u.pn & 1) * 4 + wc;
#pragma unroll
            for (int ai = 0; ai < 2; ++ai)
#pragma unroll
                for (int m = 0; m < 4; ++m) { const int row = row0 + ai * 128 + m * 16; const int b = row >> 11, s = row & 2047; bf16_t* bp = VT + ((size_t)(b * 8 + hh) * 64) * 2048 + s;
#pragma unroll
                    for (int bj = 0; bj < 2; ++bj)
#pragma unroll
                        for (int n = 0; n < 2; ++n)
#pragma unroll
                            for (int i = 0; i < 4; ++i) { const int d = 32 * bj + 8 * fq + 4 * n + i; bp[(size_t)d * 2048] = (bf16_t)(pkbf(acc[ai][bj][m][n][i], 0.f) & 0xffffu); }
                    asm volatile("" ::: "memory"); }
        } else {
            const int hh = (u.pn & 1) * 4 + wc; const float* gn = (type == 1) ? qn : kn; const float sc = (type == 1) ? 0.125f * LOG2E : 1.0f; bf16_t* dst = (type == 1) ? Q : Kk;
            f32x4 gv[2][2];
#pragma unroll
            for (int bj = 0; bj < 2; ++bj)
#pragma unroll
                for (int n = 0; n < 2; ++n) gv[bj][n] = *(const f32x4*)(gn + 32 * bj + 8 * fq + 4 * n) * sc;
#pragma unroll
            for (int ai = 0; ai < 2; ++ai)
#pragma unroll
                for (int m = 0; m < 4; ++m) { const int row = row0 + ai * 128 + m * 16; const int b = row >> 11, s = row & 2047;
                    float ss = 0.f;
#pragma unroll
                    for (int bj = 0; bj < 2; ++bj)
#pragma unroll
                        for (int n = 0; n < 2; ++n) { const f32x4 v = acc[ai][bj][m][n]; ss += (v[0] * v[0] + v[1] * v[1]) + (v[2] * v[2] + v[3] * v[3]); }
                    ss += __shfl_xor(ss, 16); ss += __shfl_xor(ss, 32);
                    const float rstd = 1.0f / sqrtf(ss * (1.0f / 64.0f) + EPS);
                    bf16_t* rp = dst + ((size_t)(b * 8 + hh) * 2048 + s) * 64 + 8 * fq;
#pragma unroll
                    for (int bj = 0; bj < 2; ++bj) { const f32x4 v0 = acc[ai][bj][m][0] * gv[bj][0] * rstd, v1 = acc[ai][bj][m][1] * gv[bj][1] * rstd; u32x4 w; w.x = pkbf(v0[0], v0[1]); w.y = pkbf(v0[2], v0[3]); w.z = pkbf(v1[0], v1[1]); w.w = pkbf(v1[2], v1[3]); *(u32x4*)(rp + bj * 32) = w; } asm volatile("" ::: "memory"); }
        }
    }
};
struct EpiE {
    bf16_t* EB; float* esq;
    __device__ __forceinline__ void operator()(const AccT& acc, const pg8::Unit& u, int wr, int wc, int fr_, int fq_) const {
        int fr = fr_, fq = fq_; asm volatile("" : "+v"(fr), "+v"(fq));
        const int row0 = u.pm * 256 + wr * 64 + fr;
#pragma unroll
        for (int ai = 0; ai < 2; ++ai)
#pragma unroll
            for (int m = 0; m < 4; ++m) { const int row = row0 + ai * 128 + m * 16; bf16_t* rp = EB + (size_t)row * 1024 + u.pn * 256 + wc * 64 + 8 * fq; float ss = 0.f;
#pragma unroll
                for (int bj = 0; bj < 2; ++bj) { const f32x4 v0 = acc[ai][bj][m][0], v1 = acc[ai][bj][m][1];
                    ss += (v0[0] * v0[0] + v0[1] * v0[1]) + (v0[2] * v0[2] + v0[3] * v0[3]) + (v1[0] * v1[0] + v1[1] * v1[1]) + (v1[2] * v1[2] + v1[3] * v1[3]);
                    u32x4 w; w.x = pkbf(v0[0], v0[1]); w.y = pkbf(v0[2], v0[3]); w.z = pkbf(v1[0], v1[1]); w.w = pkbf(v1[2], v1[3]); *(u32x4*)(rp + bj * 32) = w; }
                ss += __shfl_xor(ss, 16); ss += __shfl_xor(ss, 32);
                if (fq == 0) esq[(size_t)row * 16 + u.pn * 4 + wc] = ss; asm volatile("" ::: "memory"); }
    }
};
struct EpiRes {
    const float* x; float* out;
    __device__ __forceinline__ void operator()(const AccT& acc, const pg8::Unit& u, int wr, int wc, int fr_, int fq_) const {
        int fr = fr_, fq = fq_; asm volatile("" : "+v"(fr), "+v"(fq));
        const int row0 = u.pm * 256 + wr * 64 + fr; const int col0 = u.pn * 256 + wc * 64 + 8 * fq;
#pragma unroll
        for (int ai = 0; ai < 2; ++ai)
#pragma unroll
            for (int m = 0; m < 4; ++m) { const size_t off = (size_t)(row0 + ai * 128 + m * 16) * 1024 + col0;
#pragma unroll
                for (int bj = 0; bj < 2; ++bj)
#pragma unroll
                    for (int n = 0; n < 2; ++n) { const f32x4 xv = *(const f32x4*)(x + off + bj * 32 + n * 4); *(f32x4*)(out + off + bj * 32 + n * 4) = xv + acc[ai][bj][m][n]; }
                if (m & 1) asm volatile("" ::: "memory"); }
    }
};
struct EpiGU {
    bf16_t* HH;
    __device__ __forceinline__ void operator()(const AccT& acc, const pg8::Unit& u, int wr, int wc, int fr_, int fq_) const {
        int fr = fr_, fq = fq_; asm volatile("" : "+v"(fr), "+v"(fq));
        const int row0 = u.arow + wr * 64 + fr; const int col0 = u.pn * 128 + wc * 32 + 8 * fq;
#pragma unroll
        for (int ai = 0; ai < 2; ++ai)
#pragma unroll
            for (int m = 0; m < 4; ++m) { float h[8];
#pragma unroll
                for (int n = 0; n < 2; ++n)
#pragma unroll
                    for (int i = 0; i < 4; ++i) { const float a = acc[ai][0][m][n][i], b = acc[ai][1][m][n][i]; h[4 * n + i] = a * __builtin_amdgcn_rcpf(1.0f + __builtin_amdgcn_exp2f(-LOG2E * a)) * b; }
                u32x4 w; w.x = pkbf(h[0], h[1]); w.y = pkbf(h[2], h[3]); w.z = pkbf(h[4], h[5]); w.w = pkbf(h[6], h[7]);
                *(u32x4*)(HH + (size_t)(row0 + ai * 128 + m * 16) * 2048 + col0) = w; }
    }
};
struct EpiDown {
    bf16_t* YE; const float* gates;
    __device__ __forceinline__ void operator()(const AccT& acc, const pg8::Unit& u, int wr, int wc, int fr_, int fq_) const {
        int fr = fr_, fq = fq_; asm volatile("" : "+v"(fr), "+v"(fq));
        const int row0 = u.arow + wr * 64 + fr; const int col0 = u.pn * 256 + wc * 64 + 8 * fq;
#pragma unroll
        for (int ai = 0; ai < 2; ++ai)
#pragma unroll
            for (int m = 0; m < 4; ++m) { const int row = row0 + ai * 128 + m * 16; const float gt = gates[row]; bf16_t* rp = YE + (size_t)row * 1024 + col0;
#pragma unroll
                for (int bj = 0; bj < 2; ++bj) { const f32x4 v0 = acc[ai][bj][m][0] * gt, v1 = acc[ai][bj][m][1] * gt; u32x4 w; w.x = pkbf(v0[0], v0[1]); w.y = pkbf(v0[2], v0[3]); w.z = pkbf(v1[0], v1[1]); w.w = pkbf(v1[2], v1[3]); *(u32x4*)(rp + bj * 32) = w; } }
    }
};
struct EpiFinal {
    float* out; const bf16_t* EB; const float* rstde; const float* gpost;
    __device__ __forceinline__ void operator()(const AccT& acc, const pg8::Unit& u, int wr, int wc, int fr_, int fq_) const {
        int fr = fr_, fq = fq_; asm volatile("" : "+v"(fr), "+v"(fq));
        const int row0 = u.pm * 256 + wr * 64 + fr; const int col0 = u.pn * 256 + wc * 64 + 8 * fq;
        f32x4 gp[2][2];
#pragma unroll
        for (int bj = 0; bj < 2; ++bj)
#pragma unroll
            for (int n = 0; n < 2; ++n) gp[bj][n] = *(const f32x4*)(gpost + col0 + bj * 32 + n * 4);
#pragma unroll
        for (int ai = 0; ai < 2; ++ai)
#pragma unroll
            for (int m = 0; m < 4; ++m) { const int row = row0 + ai * 128 + m * 16; const size_t off = (size_t)row * 1024 + col0; const float re = rstde[row];
#pragma unroll
                for (int bj = 0; bj < 2; ++bj) { const u32x4 ev = *(const u32x4*)(EB + off + bj * 32);
                    const f32x4 e0 = (f32x4){bflo(ev.x), bfhi(ev.x), bflo(ev.y), bfhi(ev.y)} * gp[bj][0] * re, e1 = (f32x4){bflo(ev.z), bfhi(ev.z), bflo(ev.w), bfhi(ev.w)} * gp[bj][1] * re;
                    const f32x4 a0 = acc[ai][bj][m][0], a1 = acc[ai][bj][m][1]; f32x4 g0, g1;
#pragma unroll
                    for (int i = 0; i < 4; ++i) { g0[i] = __builtin_amdgcn_rcpf(1.0f + __builtin_amdgcn_exp2f(-LOG2E * a0[i])); g1[i] = __builtin_amdgcn_rcpf(1.0f + __builtin_amdgcn_exp2f(-LOG2E * a1[i])); }
                    const f32x4 x0 = *(const f32x4*)(out + off + bj * 32), x1 = *(const f32x4*)(out + off + bj * 32 + 4);
                    *(f32x4*)(out + off + bj * 32) = x0 + g0 * e0; *(f32x4*)(out + off + bj * 32 + 4) = x1 + g1 * e1; }
                asm volatile("" ::: "memory"); }
    }
};
struct OrderGU {
    int G, vcu;
    __device__ bool next(int i, pg8::Unit& u) const {
        int e, b, nt;
        if (G == 256) { if (i >= 8) return false; const int x = vcu >> 5, cu = vcu & 31; e = 2 * x + (i >> 2); b = cu & 7; nt = 4 * (i & 3) + (cu >> 3); }
        else { const int L = i * G + vcu; if (L >= 2048) return false; e = L >> 7; b = L & 7; nt = (L >> 3) & 15; }
        u.arow = (b * 16 + e) * 256; u.brow = e * 4096 + nt * 256; u.pm = b; u.pn = nt; u.grp = e; return true;
    }
};
struct OrderDown {
    int G, vcu;
    __device__ bool next(int i, pg8::Unit& u) const {
        int e, b, nt;
        if (G == 256) { if (i >= 2) return false; const int x = vcu >> 5, cu = vcu & 31; e = 2 * x + i; b = cu & 7; nt = cu >> 3; }
        else { const int L = i * G + vcu; if (L >= 512) return false; e = L >> 5; b = L & 7; nt = (L >> 3) & 3; }
        u.arow = (b * 16 + e) * 256; u.brow = e * 1024 + nt * 256; u.pm = b; u.pn = nt; u.grp = e; return true;
    }
};

constexpr int B2_OFF = 1024;
constexpr int UT_OFF = 32768, UT_PITCH = 136, UT_ROWS = 272;
__device__ __forceinline__ void attn_task(Frame& F, int bh, int r, int t3) {
    const int lane = F.lane, g = lane >> 4, m = lane & 15; const int b = bh >> 3, h = bh & 7;
    int rs = r - 4; rs = rs < 0 ? 0 : (rs > ROWS - 8 ? ROWS - 8 : rs);
    const int qb0 = (t3 == 0) ? 0 : t3, qb1 = (t3 == 0) ? 3 : t3;
    const int c0 = 16 * qb0 + m, c1 = 16 * qb1 + m;
    int cs0 = c0 - 8; cs0 = cs0 < 0 ? 0 : (cs0 > GW - 16 ? GW - 16 : cs0);
    int cs1 = c1 - 8; cs1 = cs1 < 0 ? 0 : (cs1 > GW - 16 ? GW - 16 : cs1);
    const bf16_t* Qb = WSP(const bf16_t, WS_Q); const bf16_t* Kb = WSP(const bf16_t, WS_K); const bf16_t* Vb = WSP(const bf16_t, WS_VT);
    const bf16_t* Qp0 = Qb + ((size_t)(bh * 2048 + 64 * r + c0) * 64 + 8 * g); const bf16_t* Qp1 = Qb + ((size_t)(bh * 2048 + 64 * r + c1) * 64 + 8 * g);
    const bf16x8 q00 = *(const bf16x8*)Qp0, q01 = *(const bf16x8*)(Qp0 + 32), q10 = *(const bf16x8*)Qp1, q11 = *(const bf16x8*)(Qp1 + 32);
    f32x4 o0[4], o1[4];
#pragma unroll
    for (int dt = 0; dt < 4; ++dt) { o0[dt] = (f32x4){0.f, 0.f, 0.f, 0.f}; o1[dt] = (f32x4){0.f, 0.f, 0.f, 0.f}; }
    float l0 = 0.f, l1 = 0.f;
    const int rowa = 8 * (m >> 2) + (m & 3);
    const LAS float* b2 = (const LAS float*)(F.lds + B2_OFF) + h * 15 * 32;
    const bf16_t* Kp = Kb + ((size_t)(bh * 2048 + 64 * rs + rowa) * 64 + 8 * g);
    const bf16_t* Vp = Vb + ((size_t)(bh * 64 + m) * 2048 + 64 * rs + 8 * g);
    bf16x8 kA[4], vA[4], kB[4], vB[4];
#define AT_LOAD(kk, vv, i, kp) do { const bf16_t* kp_ = Kp + (i) * 4096 + (kp) * 2048; kk[0] = *(const bf16x8*)kp_; kk[1] = *(const bf16x8*)(kp_ + 32); kk[2] = *(const bf16x8*)(kp_ + 256); kk[3] = *(const bf16x8*)(kp_ + 288); \
        const bf16_t* vp_ = Vp + (i) * 64 + (kp) * 32; _Pragma("unroll") for (int dt = 0; dt < 4; ++dt) vv[dt] = *(const bf16x8*)(vp_ + (size_t)dt * 16 * 2048); } while (0)
#define AT_COMP(kk, vv, i, kp, qf0, qf1, cc, ccs, oo, ll) do { \
        f32x4 sa = (f32x4){0.f, 0.f, 0.f, 0.f}, sb = (f32x4){0.f, 0.f, 0.f, 0.f}; \
        sa = __builtin_amdgcn_mfma_f32_16x16x32_bf16(kk[0], qf0, sa, 0, 0, 0); sa = __builtin_amdgcn_mfma_f32_16x16x32_bf16(kk[1], qf1, sa, 0, 0, 0); \
        sb = __builtin_amdgcn_mfma_f32_16x16x32_bf16(kk[2], qf0, sb, 0, 0, 0); sb = __builtin_amdgcn_mfma_f32_16x16x32_bf16(kk[3], qf1, sb, 0, 0, 0); \
        const int kc0 = 32 * (kp) + 8 * g; const int dr = rs + (i) - r + 7; \
        const LAS float* bp = b2 + (dr * 32 + 15 - (cc) + kc0); float pa[4], pb[4]; \
        _Pragma("unroll") for (int q = 0; q < 4; ++q) { const bool va = (unsigned)(kc0 + q - (ccs)) < 16u, vb = (unsigned)(kc0 + 4 + q - (ccs)) < 16u; \
            const float ea = __builtin_amdgcn_exp2f(sa[q] + bp[q]), eb = __builtin_amdgcn_exp2f(sb[q] + bp[4 + q]); pa[q] = va ? ea : 0.f; pb[q] = vb ? eb : 0.f; } \
        ll += ((pa[0] + pa[1]) + (pa[2] + pa[3])) + ((pb[0] + pb[1]) + (pb[2] + pb[3])); \
        u32x4 pw; pw.x = pkbf(pa[0], pa[1]); pw.y = pkbf(pa[2], pa[3]); pw.z = pkbf(pb[0], pb[1]); pw.w = pkbf(pb[2], pb[3]); const bf16x8 pf = __builtin_bit_cast(bf16x8, pw); \
        _Pragma("unroll") for (int dt = 0; dt < 4; ++dt) oo[dt] = __builtin_amdgcn_mfma_f32_16x16x32_bf16(vv[dt], pf, oo[dt], 0, 0, 0); } while (0)
    AT_LOAD(kA, vA, 0, 0);
    for (int i = 0; i < 8; ++i) {
        AT_LOAD(kB, vB, i, 1);
        AT_COMP(kA, vA, i, 0, q00, q01, c0, cs0, o0, l0);
        if (i < 7) AT_LOAD(kA, vA, i + 1, 0);
        AT_COMP(kB, vB, i, 1, q10, q11, c1, cs1, o1, l1);
    }
#undef AT_LOAD
#undef AT_COMP
    bf16_t* mixb = WSP(bf16_t, WS_MIX) + (size_t)(b * 2048 + 64 * r) * 1024 + 512 + h * 64 + 4 * g;
    if (t3 != 0) {
#pragma unroll
        for (int dt = 0; dt < 4; ++dt) o0[dt] += o1[dt];
        l0 += l1; l0 += __shfl_xor(l0, 16); l0 += __shfl_xor(l0, 32);
        const float inv = 1.0f / l0; bf16_t* op = mixb + (size_t)c0 * 1024;
#pragma unroll
        for (int dt = 0; dt < 4; ++dt) { u32x2 w; w.x = pkbf(o0[dt][0] * inv, o0[dt][1] * inv); w.y = pkbf(o0[dt][2] * inv, o0[dt][3] * inv); *(u32x2*)(op + 16 * dt) = w; }
    } else {
        l0 += __shfl_xor(l0, 16); l0 += __shfl_xor(l0, 32); l1 += __shfl_xor(l1, 16); l1 += __shfl_xor(l1, 32);
        const float i0 = 1.0f / l0, i1 = 1.0f / l1; bf16_t* op0 = mixb + (size_t)c0 * 1024; bf16_t* op1 = mixb + (size_t)c1 * 1024;
#pragma unroll
        for (int dt = 0; dt < 4; ++dt) { u32x2 w; w.x = pkbf(o0[dt][0] * i0, o0[dt][1] * i0); w.y = pkbf(o0[dt][2] * i0, o0[dt][3] * i0); *(u32x2*)(op0 + 16 * dt) = w;
            u32x2 w1; w1.x = pkbf(o1[dt][0] * i1, o1[dt][1] * i1); w1.y = pkbf(o1[dt][2] * i1, o1[dt][3] * i1); *(u32x2*)(op1 + 16 * dt) = w1; }
    }
}
__device__ __forceinline__ void pool_unit(Frame& F, int pm, int grp) {
    LAS bf16_t* Ut = (LAS bf16_t*)(F.lds + UT_OFF);
    const int tid = F.tid; const int tok0 = pm * 256, b = tok0 >> 11, t0 = tok0 & 2047;
    {   const bf16_t* Ub = WSP(const bf16_t, WS_U) + (size_t)b * 2048 * 512 + grp * 128;
        for (int i = tid; i < UT_ROWS * 16; i += 512) { const int rr = i >> 4, ch = i & 15; const int t = t0 - 8 + rr;
            u32x4 v = (u32x4){0u, 0u, 0u, 0u}; if (t >= 0 && t < S) v = *(const u32x4*)(Ub + (size_t)t * 512 + ch * 8);
            *(LAS u32x4*)(Ut + rr * UT_PITCH + ch * 8) = v; } }
    __syncthreads();
    {   const int lane = F.lane, g = lane >> 4, m = lane & 15, w = F.wave; const int hw = 1 << grp;
        const bf16_t* Wp = WSP(const bf16_t, WS_WPOOL) + (size_t)grp * 128 * 128;
        f32x4 acc[2][8];
#pragma unroll
        for (int mt = 0; mt < 2; ++mt)
#pragma unroll
            for (int nt = 0; nt < 8; ++nt) acc[mt][nt] = (f32x4){0.f, 0.f, 0.f, 0.f};
        float rc[2];
#pragma unroll
        for (int mt = 0; mt < 2; ++mt) { const int t = t0 + 32 * w + 16 * mt + m; const int lo = (t - hw) < 0 ? 0 : (t - hw), hi = (t + hw - 1) > (S - 1) ? (S - 1) : (t + hw - 1); rc[mt] = 1.0f / (float)(hi - lo + 1); }
        for (int ks = 0; ks < 4; ++ks) { bf16x8 af[2];
#pragma unroll
            for (int mt = 0; mt < 2; ++mt) { const LAS bf16_t* up = Ut + (32 * w + 16 * mt + m + 8) * UT_PITCH + 32 * ks + 8 * g;
                float sm[8];
#pragma unroll
                for (int j = 0; j < 8; ++j) sm[j] = 0.f;
                for (int q = -hw; q < hw; ++q) { const u32x4 v = *(const LAS u32x4*)(up + q * UT_PITCH);
                    sm[0] += bflo(v.x); sm[1] += bfhi(v.x); sm[2] += bflo(v.y); sm[3] += bfhi(v.y); sm[4] += bflo(v.z); sm[5] += bfhi(v.z); sm[6] += bflo(v.w); sm[7] += bfhi(v.w); }
                const u32x4 uc = *(const LAS u32x4*)up; const float r_ = rc[mt];
                u32x4 d; d.x = pkbf(sm[0] * r_ - bflo(uc.x), sm[1] * r_ - bfhi(uc.x)); d.y = pkbf(sm[2] * r_ - bflo(uc.y), sm[3] * r_ - bfhi(uc.y));
                d.z = pkbf(sm[4] * r_ - bflo(uc.z), sm[5] * r_ - bfhi(uc.z)); d.w = pkbf(sm[6] * r_ - bflo(uc.w), sm[7] * r_ - bfhi(uc.w));
                af[mt] = __builtin_bit_cast(bf16x8, d); }
#pragma unroll
            for (int nt = 0; nt < 8; ++nt) { const bf16x8 wf = *(const bf16x8*)(Wp + (size_t)(16 * nt + m) * 128 + 32 * ks + 8 * g);
#pragma unroll
                for (int mt = 0; mt < 2; ++mt) acc[mt][nt] = __builtin_amdgcn_mfma_f32_16x16x32_bf16(wf, af[mt], acc[mt][nt], 0, 0, 0); } }
        bf16_t* mix = WSP(bf16_t, WS_MIX);
#pragma unroll
        for (int mt = 0; mt < 2; ++mt)
#pragma unroll
            for (int nt = 0; nt < 8; ++nt) { u32x2 o; o.x = pkbf(acc[mt][nt][0], acc[mt][nt][1]); o.y = pkbf(acc[mt][nt][2], acc[mt][nt][3]);
                *(u32x2*)(mix + (size_t)(pm * 256 + 32 * w + 16 * mt + m) * 1024 + grp * 128 + 16 * nt + 4 * g) = o; }
    }
    __syncthreads();
}
__device__ __forceinline__ void p2_mixer(Frame& F) {
    LAS float* b2 = (LAS float*)(F.lds + B2_OFF);
    for (int i = F.tid; i < 8 * 15 * 32; i += 512) { const int dc = i & 31, hd = i >> 5; b2[i] = dc < 31 ? F_rpb[hd * 31 + dc] * LOG2E : 0.f; }
    __syncthreads();
    for (int u = F.vcu; u < 64 * 4; u += F.G) pool_unit(F, u >> 2, u & 3);
    const int gw = F.vcu * 8 + F.wave, NGW = F.G * 8;
    for (int wt = gw; wt < B * AH * ROWS * 3; wt += NGW) attn_task(F, wt / 96, (wt / 3) & 31, wt % 3);
}

__device__ __forceinline__ void p4_router(Frame& F) {
    LAS float* wt = (LAS float*)F.lds;
    for (int i = F.tid; i < D * NE; i += 512) wt[(i & 15) * D + (i >> 4)] = F_w_router[i];
    __syncthreads();
    const int gw = F.vcu * 8 + F.wave, NGW = F.G * 8, lane = F.lane;
    bf16_t* H2 = WSP(bf16_t, WS_H2); float* aff = WSP(float, WS_AFF);
    for (int row = 2 * gw; row < T; row += 2 * NGW) {
        const f32x4* gr = (const f32x4*)F_norm_ffn + lane;
        f32x4 v[2][4]; float ss[2];
#pragma unroll
        for (int rr = 0; rr < 2; ++rr) { const f32x4* xr = (const f32x4*)(F.out + (size_t)(row + rr) * D) + lane; float s_ = 0.f;
#pragma unroll
            for (int j = 0; j < 4; ++j) { v[rr][j] = xr[64 * j]; s_ += (v[rr][j].x * v[rr][j].x + v[rr][j].y * v[rr][j].y) + (v[rr][j].z * v[rr][j].z + v[rr][j].w * v[rr][j].w); }
            ss[rr] = s_; }
#pragma unroll
        for (int o = 1; o < 64; o <<= 1) { ss[0] += __shfl_xor(ss[0], o); ss[1] += __shfl_xor(ss[1], o); }
#pragma unroll
        for (int rr = 0; rr < 2; ++rr) { const float rstd = 1.0f / sqrtf(ss[rr] * (1.0f / D) + EPS); u32x2* o8 = (u32x2*)(H2 + (size_t)(row + rr) * D) + lane;
#pragma unroll
            for (int j = 0; j < 4; ++j) { v[rr][j] = v[rr][j] * rstd * gr[64 * j]; u32x2 o; o.x = pkbf(v[rr][j].x, v[rr][j].y); o.y = pkbf(v[rr][j].z, v[rr][j].w); o8[64 * j] = o; } }
        float a[32];
#pragma unroll
        for (int e = 0; e < 16; ++e) { float a0 = 0.f, a1 = 0.f;
#pragma unroll
            for (int j = 0; j < 4; ++j) { const f32x4 w4 = *(const LAS f32x4*)(wt + e * D + 256 * j + 4 * lane);
                a0 += (v[0][j].x * w4.x + v[0][j].y * w4.y) + (v[0][j].z * w4.z + v[0][j].w * w4.w); a1 += (v[1][j].x * w4.x + v[1][j].y * w4.y) + (v[1][j].z * w4.z + v[1][j].w * w4.w); }
            a[e] = a0; a[16 + e] = a1; if ((e & 3) == 3) asm volatile("" ::: "memory"); }
#define RS_STEP(n, M) do { const bool up = (lane & (M)) != 0; _Pragma("unroll") for (int j = 0; j < (n) / 2; ++j) { const float snd = up ? a[j] : a[j + (n) / 2]; const float kp_ = up ? a[j + (n) / 2] : a[j]; a[j] = kp_ + __shfl_xor(snd, (M)); } } while (0)
        RS_STEP(32, 32); RS_STEP(16, 16); RS_STEP(8, 8); RS_STEP(4, 4); RS_STEP(2, 2);
#undef RS_STEP
        float lg = a[0] + __shfl_xor(a[0], 1);
        float mx = lg;
#pragma unroll
        for (int o = 2; o < 32; o <<= 1) mx = fmaxf(mx, __shfl_xor(mx, o));
        const float ex = expf(lg - mx); float sum = ex;
#pragma unroll
        for (int o = 2; o < 32; o <<= 1) sum += __shfl_xor(sum, o);
        if ((lane & 1) == 0) { const int k = lane >> 1, rr = k >> 4, e = k & 15; const int rw = row + rr; aff[((size_t)(rw >> 11) * NE + e) * S + (rw & 2047)] = ex / sum; }
    }
}

__device__ __forceinline__ void p5_topk_gather(Frame& F) {
    LAS int* sidx = (LAS int*)F.lds;
    const int lane = F.lane; const float* aff = WSP(const float, WS_AFF); float* gates = WSP(float, WS_GATES); int* slot_of = WSP(int, WS_SLOT);
    const bf16_t* H2 = WSP(const bf16_t, WS_H2); bf16_t* XE = WSP(bf16_t, WS_XE);
    for (int task = F.vcu; task < B * NE * 2; task += F.G) {
        const int be = task >> 1, half = task & 1, b = be >> 4, e = be & 15;
        if (F.wave == 0) {
            unsigned v[32];
#pragma unroll
            for (int j = 0; j < 32; ++j) v[j] = __builtin_bit_cast(unsigned, aff[(size_t)be * S + 64 * j + lane]);
            unsigned Tt = 0u;
            for (int bit = 30; bit >= 0; --bit) { const unsigned cand = Tt | (1u << bit); int cnt = 0;
#pragma unroll
                for (int j = 0; j < 32; ++j) cnt += (v[j] >= cand) ? 1 : 0;
#pragma unroll
                for (int o = 1; o < 64; o <<= 1) cnt += __shfl_xor(cnt, o);
                if (cnt >= CAP) Tt = cand; }
            int ngt = 0;
#pragma unroll
            for (int j = 0; j < 32; ++j) ngt += (v[j] > Tt) ? 1 : 0;
#pragma unroll
            for (int o = 1; o < 64; o <<= 1) ngt += __shfl_xor(ngt, o);
            const int need = CAP - ngt; int eq_run = 0, sel_run = 0;
            const unsigned long long ltmask = (lane == 0) ? 0ull : (~0ull >> (64 - lane));
#pragma unroll
            for (int j = 0; j < 32; ++j) {
                const bool gt = v[j] > Tt, eq = v[j] == Tt;
                const unsigned long long em = __ballot(eq);
                const int eqb = eq_run + __popcll(em & ltmask);
                const bool sel = gt || (eq && eqb < need);
                eq_run += __popcll(em);
                const unsigned long long sm = __ballot(sel);
                const int slot = sel_run + __popcll(sm & ltmask);
                sel_run += __popcll(sm);
                const int tok = 64 * j + lane;
                if (sel) sidx[slot] = tok;
                if (half == 0) { if (sel) gates[be * CAP + slot] = __builtin_bit_cast(float, v[j]); slot_of[((size_t)b * S + tok) * NE + e] = sel ? slot : -1; }
            }
        }
        __syncthreads();
        for (int i = 0; i < 16; ++i) { const int slot = half * 128 + F.wave * 16 + i; const int tok = sidx[slot];
            const u32x4* src = (const u32x4*)(H2 + ((size_t)b * S + tok) * D) + lane; u32x4* dst = (u32x4*)(XE + ((size_t)be * CAP + slot) * D) + lane;
            const u32x4 a0 = src[0], a1 = src[64]; dst[0] = a0; dst[64] = a1; }
        __syncthreads();
    }
}

__device__ __forceinline__ void p8_combine(Frame& F) {
    const int gw = F.vcu * 8 + F.wave, NGW = F.G * 8, lane = F.lane;
    const bf16_t* YE = WSP(const bf16_t, WS_XE); const int* slot_of = WSP(const int, WS_SLOT); bf16_t* X2N = WSP(bf16_t, WS_H2);
    const float* esq = WSP(const float, WS_ESQ); float* rstde = WSP(float, WS_RSTDE);
    for (int row = gw; row < T; row += NGW) {
        f32x4* xr = (f32x4*)(F.out + (size_t)row * D) + lane; const f32x4* gr = (const f32x4*)F_norm_ple + lane;
        f32x4 v[4];
#pragma unroll
        for (int j = 0; j < 4; ++j) v[j] = xr[64 * j];
        const int b = row >> 11;
        const int myslot = (lane < 16) ? slot_of[(size_t)row * NE + lane] : -1;
        for (int e = 0; e < NE; ++e) { const int sl = __shfl(myslot, e);
            if (sl >= 0) { const u32x2* yr = (const u32x2*)(YE + ((size_t)(b * NE + e) * CAP + sl) * D) + lane;
#pragma unroll
                for (int j = 0; j < 4; ++j) { const u32x2 y = yr[64 * j]; v[j].x += bflo(y.x); v[j].y += bfhi(y.x); v[j].z += bflo(y.y); v[j].w += bfhi(y.y); } } }
        float s = 0.f;
#pragma unroll
        for (int j = 0; j < 4; ++j) { xr[64 * j] = v[j]; s += (v[j].x * v[j].x + v[j].y * v[j].y) + (v[j].z * v[j].z + v[j].w * v[j].w); }
        const float rstd = 1.0f / sqrtf(wave_sum(s) * (1.0f / D) + EPS);
        u32x2* o8 = (u32x2*)(X2N + (size_t)row * D) + lane;
#pragma unroll
        for (int j = 0; j < 4; ++j) { const f32x4 gg = gr[64 * j]; u32x2 o; o.x = pkbf(v[j].x * rstd * gg.x, v[j].y * rstd * gg.y); o.y = pkbf(v[j].z * rstd * gg.z, v[j].w * rstd * gg.w); o8[64 * j] = o; }
        float q = (lane < 16) ? esq[(size_t)row * 16 + lane] : 0.f; q = wave_sum(q);
        if (lane == 0) rstde[row] = 1.0f / sqrtf(q * (1.0f / D) + EPS);
    }
}

constexpr int N_PHASES = 10;
__global__ void __launch_bounds__(512, 2) mega_fwd(MArgs args) {
    extern __shared__ __attribute__((aligned(16))) unsigned char lds_raw[];
    Frame F;
    F.lds = (LAS unsigned char*)lds_raw; F.tid = threadIdx.x; F.lane = F.tid & 63; F.wave = __builtin_amdgcn_readfirstlane(F.tid >> 6);
    F.G = gridDim.x; { const int bx = blockIdx.x; F.vcu = (F.G % 8 == 0) ? (bx % 8) * (F.G / 8) + bx / 8 : bx; }
    F.out = args.out; F.ws = args.ws; F.a = &args;
    for (int u = F.tid; u < (LDS_BYTES - LDSCTL_OFF) / 4; u += 512) ((LAS unsigned*)(F.lds + LDSCTL_OFF))[u] = 0u;
    __syncthreads();
    const int lo = args.ph_lo, hi = args.ph_hi;
    if (hi - lo > 1) xcd_barrier_post(WSP(unsigned, WS_CTL) + CW_BAR);
#ifndef PH_ENABLE
#define PH_ENABLE 0x3ff
#endif
#define IN(k) (((PH_ENABLE >> (k)) & 1) && lo <= (k) && (k) < hi)
#ifndef DUP_MASK
#define DUP_MASK 0
#endif
#define GBAR() xcd_barrier(WSP(unsigned, WS_CTL) + CW_BAR, (volatile LAS unsigned*)(F.lds + MISC_OFF) + 8)
#define DUP(k) (((DUP_MASK >> (k)) & 1) ? 2 : 1)
#define SEAM(k) do { if (IN(k) && IN((k) + 1)) xcd_barrier(WSP(unsigned, WS_CTL) + CW_BAR, (volatile LAS unsigned*)(F.lds + MISC_OFF) + 8); } while (0)
    if (IN(0)) { for (int rep = 0; rep < DUP(0); ++rep) { if (rep) GBAR(); p0_prologue(F); } } SEAM(0);
    if (IN(1)) for (int rep = 0; rep < DUP(1); ++rep) { if (rep) GBAR();
#ifndef NO_P1A
        { pg8::Gemm g{WSP(const bf16_t, WS_XN), WSP(const bf16_t, WS_WIN), 1024}; pg8::StaticOrder So; So.init(T, 2048, F.G, (int)blockIdx.x);
          EpiQKV E{WSP(bf16_t, WS_U), WSP(bf16_t, WS_Q), WSP(bf16_t, WS_K), WSP(bf16_t, WS_VT), F_q_norm, F_k_norm};
          pg8::gemm_phase(F.lds, g, So, E); }
#endif
#ifndef NO_P1B
        { pg8::Gemm g{WSP(const bf16_t, WS_PB), WSP(const bf16_t, WS_WPP), 256}; pg8::StaticOrder So; So.init(T, 1024, F.G, (int)blockIdx.x);
          EpiE E{WSP(bf16_t, WS_EB), WSP(float, WS_ESQ)};
          pg8::gemm_phase(F.lds, g, So, E); }
#endif
    } SEAM(1);
    if (IN(2)) { for (int rep = 0; rep < DUP(2); ++rep) { if (rep) GBAR(); p2_mixer(F); } } SEAM(2);
    if (IN(3)) for (int rep = 0; rep < DUP(3); ++rep) { if (rep) GBAR(); pg8::Gemm g{WSP(const bf16_t, WS_MIX), WSP(const bf16_t, WS_WOUT), 1024}; pg8::StaticOrder So; So.init(T, 1024, F.G, (int)blockIdx.x);
        EpiRes E{F_x, F.out}; pg8::gemm_phase(F.lds, g, So, E); } SEAM(3);
    if (IN(4)) { for (int rep = 0; rep < DUP(4); ++rep) { if (rep) GBAR(); p4_router(F); } } SEAM(4);
    if (IN(5)) { for (int rep = 0; rep < DUP(5); ++rep) { if (rep) GBAR(); p5_topk_gather(F); } } SEAM(5);
    if (IN(6)) for (int rep = 0; rep < DUP(6); ++rep) { if (rep) GBAR(); pg8::Gemm g{WSP(const bf16_t, WS_XE), WSP(const bf16_t, WS_WGU), 1024}; OrderGU So{F.G, F.vcu};
        EpiGU E{WSP(bf16_t, WS_HH)}; pg8::gemm_phase(F.lds, g, So, E); } SEAM(6);
    if (IN(7)) for (int rep = 0; rep < DUP(7); ++rep) { if (rep) GBAR(); pg8::Gemm g{WSP(const bf16_t, WS_HH), WSP(const bf16_t, WS_WD), 2048}; OrderDown So{F.G, F.vcu};
        EpiDown E{WSP(bf16_t, WS_XE), WSP(const float, WS_GATES)}; pg8::gemm_phase(F.lds, g, So, E); } SEAM(7);
    if (IN(8)) { p8_combine(F); } SEAM(8);
    if (IN(9)) { pg8::Gemm g{WSP(const bf16_t, WS_H2), WSP(const bf16_t, WS_WPG), 1024}; pg8::StaticOrder So; So.init(T, 1024, F.G, (int)blockIdx.x);
        EpiFinal E{F.out, WSP(const bf16_t, WS_EB), WSP(const float, WS_RSTDE), F_norm_ple_post}; pg8::gemm_phase(F.lds, g, So, E); }
#undef IN
#undef SEAM
}
static inline dim3 g1(size_t n) { return dim3((unsigned)((n + 255) / 256)); }

#ifndef MODE
#define MODE 0
#endif

extern "C" void kernel_launch(void* const* d_in, const int* in_sizes, int n_in, void* d_out, int out_size, void* d_ws, size_t ws_size, hipStream_t stream) {
    const float* x = (const float*)d_in[0]; const float* p = (const float*)d_in[1]; const float* norm_mix = (const float*)d_in[2]; const float* w_in = (const float*)d_in[3];
    const float* w_pool = (const float*)d_in[4]; const float* pool_scale = (const float*)d_in[5]; const float* q_norm = (const float*)d_in[6]; const float* k_norm = (const float*)d_in[7];
    const float* rpb = (const float*)d_in[8]; const float* w_out = (const float*)d_in[9]; const float* norm_ffn = (const float*)d_in[10]; const float* w_router = (const float*)d_in[11];
    const float* w_gate = (const float*)d_in[12]; const float* w_up = (const float*)d_in[13]; const float* w_down = (const float*)d_in[14]; const float* norm_ple = (const float*)d_in[15];
    const float* w_ple_gate = (const float*)d_in[16]; const float* w_ple_proj = (const float*)d_in[17]; const float* norm_ple_post = (const float*)d_in[18];
    float* out = (float*)d_out; char* ws = (char*)d_ws;
    (void)in_sizes; (void)n_in; (void)out_size;
    static int grid = 0;
    if (grid == 0) {
        if (ws_size < (size_t)489 * MiB) { fprintf(stderr, "kernel_launch: workspace too small (%zu)\n", ws_size); grid = -1; return; }
        int dev = 0, cus = 0, per_cu = 0;
        if (hipGetDevice(&dev) != hipSuccess || hipDeviceGetAttribute(&cus, hipDeviceAttributeMultiprocessorCount, dev) != hipSuccess) { grid = -1; return; }
        if (hipFuncSetAttribute((const void*)mega_fwd, hipFuncAttributeMaxDynamicSharedMemorySize, LDS_BYTES) != hipSuccess) { fprintf(stderr, "kernel_launch: hipFuncSetAttribute failed\n"); grid = -1; return; }
        if (hipOccupancyMaxActiveBlocksPerMultiprocessor(&per_cu, (const void*)mega_fwd, 512, LDS_BYTES) != hipSuccess || per_cu < 1) { fprintf(stderr, "kernel_launch: occupancy query says %d blocks per CU\n", per_cu); grid = -1; (void)hipGetLastError(); return; }
        grid = cus;
    }
    if (grid < 0) return;
    (void)hipMemsetAsync((char*)d_ws + WS_CTL, 0, CTL_ZERO_BYTES, stream);
    MArgs a{};
    for (int i = 0; i < 19; ++i) a.in[i] = (const float*)d_in[i];
    a.out = out; a.ws = (unsigned char*)d_ws;
#if MODE == 0
    a.ph_lo = 0; a.ph_hi = N_PHASES;
    hipLaunchKernelGGL(mega_fwd, dim3(grid), dim3(512), LDS_BYTES, stream, a);
#else
    constexpr int KOPT = MODE - 100;
    for (int ph = 0; ph <= KOPT; ++ph) { a.ph_lo = ph; a.ph_hi = ph + 1; hipLaunchKernelGGL(mega_fwd, dim3(grid), dim3(512), LDS_BYTES, stream, a); }
    float* xn = (float*)(ws + 0 * MiB);
    float* z = (float*)(ws + 64 * MiB);
    float* dp = (float*)(ws + 192 * MiB);
    float* ye = (float*)(ws + 288 * MiB);
    float* ga = (float*)(ws + 416 * MiB); float* gb = (float*)(ws + 448 * MiB);
    float* mix = (float*)(ws + 416 * MiB);
    float* aff = (float*)(ws + 485 * MiB); int* idx = (int*)(ws + 486 * MiB); float* gates = (float*)(ws + 487 * MiB); int* slot_of = (int*)(ws + 488 * MiB);
    const unsigned short* mU = (const unsigned short*)(ws + WS_U); const unsigned short* mQ = (const unsigned short*)(ws + WS_Q); const unsigned short* mK = (const unsigned short*)(ws + WS_K); const unsigned short* mVT = (const unsigned short*)(ws + WS_VT);
    if (KOPT < 1) {
        nv::rmsnorm_rows<<<T, 256, 0, stream>>>(x, norm_mix, xn, D);
        nv::gemm_f32<<<dim3(2048 / 64, T / 64, 1), 256, 0, stream>>>(xn, w_in, z, D, D, 2048, 2048, 0, 0, 0);
    }
    if (KOPT < 2) {
        if (KOPT == 1) nv::bf16_to_f32<<<g1((size_t)T * PW), 256, 0, stream>>>(mU, z, PW, 2048, (size_t)T * PW);
        nv::pool_diff<<<g1((size_t)T * PW), 256, 0, stream>>>(z, dp);
        nv::gemm_f32<<<dim3(PG / 64, T / 64, 4), 256, 0, stream>>>(dp, w_pool, mix, PG, PW, PG, D, PG, (size_t)PG * PG, PG);
        nv::scale_cols<<<g1((size_t)T * PW), 256, 0, stream>>>(mix, D, PW, pool_scale, (size_t)T * PW);
        if (KOPT == 1) nv::natten_pre<<<T * AH, 128, 0, stream>>>(mQ, mK, mVT, rpb, mix);
        else nv::natten<<<T * AH, 128, 0, stream>>>(z, q_norm, k_norm, rpb, mix);
    }
    if (KOPT < 3) {
        if (KOPT == 2) nv::bf16_to_f32<<<g1((size_t)T * D), 256, 0, stream>>>((const unsigned short*)(ws + WS_MIX), mix, D, D, (size_t)T * D);
        nv::gemm_f32<<<dim3(D / 64, T / 64, 1), 256, 0, stream>>>(mix, w_out, xn, D, D, D, D, 0, 0, 0);
        nv::add_to<<<g1((size_t)T * D), 256, 0, stream>>>(out, x, xn, (size_t)T * D);
    }
    if (KOPT < 4) {
        nv::rmsnorm_rows<<<T, 256, 0, stream>>>(out, norm_ffn, xn, D);
        nv::router<<<T, 256, 0, stream>>>(xn, w_router, aff);
    } else { aff = (float*)(ws + WS_AFF); }
    if (KOPT < 5) {
        if (KOPT == 4) nv::bf16_to_f32<<<g1((size_t)T * D), 256, 0, stream>>>((const unsigned short*)(ws + WS_H2), xn, D, D, (size_t)T * D);
        nv::topk<<<B * NE, 1024, 0, stream>>>(aff, idx, gates, slot_of);
        nv::gather_rows<<<B * NE * CAP, 256, 0, stream>>>(xn, idx, z);
    } else { gates = (float*)(ws + WS_GATES); slot_of = (int*)(ws + WS_SLOT); }
    if (KOPT < 7) {
        float* xe = z;
        if (KOPT >= 5) nv::bf16_to_f32<<<g1((size_t)B * NE * CAP * D), 256, 0, stream>>>((const unsigned short*)(ws + WS_XE), xe, D, D, (size_t)B * NE * CAP * D);
        for (int b = 0; b < B; ++b) {
            const float* xeb = xe + (size_t)b * NE * CAP * D;
            nv::gemm_f32<<<dim3(DE / 64, CAP / 64, NE), 256, 0, stream>>>(xeb, w_gate, ga, D, D, DE, DE, (size_t)CAP * D, (size_t)D * DE, (size_t)CAP * DE);
            nv::gemm_f32<<<dim3(DE / 64, CAP / 64, NE), 256, 0, stream>>>(xeb, w_up, gb, D, D, DE, DE, (size_t)CAP * D, (size_t)D * DE, (size_t)CAP * DE);
            nv::silu_mul<<<g1((size_t)NE * CAP * DE), 256, 0, stream>>>(ga, gb, (size_t)NE * CAP * DE);
            nv::gemm_f32<<<dim3(D / 64, CAP / 64, NE), 256, 0, stream>>>(ga, w_down, ye + (size_t)b * NE * CAP * D, DE, DE, D, D, (size_t)CAP * DE, (size_t)DE * D, (size_t)CAP * D);
        }
    }
    if (KOPT < 8) {
        if (KOPT == 7) nv::combine_bf16<<<T, 256, 0, stream>>>(out, (const unsigned short*)(ws + WS_XE), slot_of);
        else nv::combine<<<T, 256, 0, stream>>>(out, ye, gates, slot_of);
    }
    if (KOPT < 9) {
        nv::rmsnorm_rows<<<T, 256, 0, stream>>>(out, norm_ple, xn, D);
        nv::gemm_f32<<<dim3(D / 64, T / 64, 1), 256, 0, stream>>>(xn, w_ple_gate, mix, D, D, D, D, 0, 0, 0);
        float* eraw = ye;
        nv::gemm_f32<<<dim3(D / 64, T / 64, 1), 256, 0, stream>>>(p, w_ple_proj, eraw, PD, PD, D, D, 0, 0, 0);
        nv::rmsnorm_rows<<<T, 256, 0, stream>>>(eraw, norm_ple_post, xn, D);
        nv::ple_final<<<g1((size_t)T * D), 256, 0, stream>>>(out, mix, xn, (size_t)T * D);
    }
#endif
}
```

```cpp
#include <hip/hip_runtime.h>
#include <cstdio>
#include <cstdint>

namespace cfg {
constexpr int D = 1024, B = 8, S = 2048, T = B * S;
constexpr int GW = 64, ROWS = S / GW;
constexpr int PW = 512, PG = 128, AH = 8, HD = 64, NE = 16, CAP = 256, DE = 2048, PD = 256;
constexpr float EPS = 1e-6f;
}
using namespace cfg;

namespace nv {
__global__ void __launch_bounds__(256) rmsnorm_rows(const float* __restrict__ x, const float* __restrict__ g, float* __restrict__ out, int ncols) {
    __shared__ float red[256];
    const size_t row = blockIdx.x; const float* xr = x + row * ncols; float s = 0.f;
    for (int c = threadIdx.x; c < ncols; c += 256) { const float v = xr[c]; s += v * v; }
    red[threadIdx.x] = s; __syncthreads();
    for (int o = 128; o > 0; o >>= 1) { if ((int)threadIdx.x < o) red[threadIdx.x] += red[threadIdx.x + o]; __syncthreads(); }
    const float rstd = 1.0f / sqrtf(red[0] / (float)ncols + EPS);
    for (int c = threadIdx.x; c < ncols; c += 256) out[row * ncols + c] = xr[c] * rstd * g[c];
}
__global__ void __launch_bounds__(256) gemm_f32(const float* __restrict__ A, const float* __restrict__ Bm, float* __restrict__ C, int K, int lda, int ldb, int ldc, size_t sA, size_t sB, size_t sC) {
    __shared__ float As[16][65]; __shared__ float Bs[16][64];
    const int z = blockIdx.z; A += z * sA; Bm += z * sB; C += z * sC;
    const int m0 = blockIdx.y * 64, n0 = blockIdx.x * 64, tx = threadIdx.x & 15, ty = threadIdx.x >> 4;
    float acc[4][4] = {};
    for (int k0 = 0; k0 < K; k0 += 16) {
        for (int i = threadIdx.x; i < 1024; i += 256) { const int r = i >> 4, c = i & 15; As[c][r] = A[(size_t)(m0 + r) * lda + k0 + c]; }
        for (int i = threadIdx.x; i < 1024; i += 256) { const int r = i >> 6, c = i & 63; Bs[r][c] = Bm[(size_t)(k0 + r) * ldb + n0 + c]; }
        __syncthreads();
#pragma unroll
        for (int k = 0; k < 16; ++k) { float a[4], b[4];
#pragma unroll
            for (int i = 0; i < 4; ++i) { a[i] = As[k][ty * 4 + i]; b[i] = Bs[k][tx * 4 + i]; }
#pragma unroll
            for (int i = 0; i < 4; ++i)
#pragma unroll
                for (int j = 0; j < 4; ++j) acc[i][j] += a[i] * b[j]; }
        __syncthreads();
    }
#pragma unroll
    for (int i = 0; i < 4; ++i)
#pragma unroll
        for (int j = 0; j < 4; ++j) C[(size_t)(m0 + ty * 4 + i) * ldc + n0 + tx * 4 + j] = acc[i][j];
}
__global__ void __launch_bounds__(256) pool_diff(const float* __restrict__ z, float* __restrict__ d) {
    const size_t i = (size_t)blockIdx.x * 256 + threadIdx.x; if (i >= (size_t)T * PW) return;
    const int c = (int)(i % PW); const int tok = (int)(i / PW), b = tok / S, t = tok % S; const int gi = c / PG; const int w = 2 << gi;
    int lo = t - w / 2; if (lo < 0) lo = 0; int hi = t + (w - w / 2) - 1; if (hi > S - 1) hi = S - 1;
    float s = 0.f; for (int q = lo; q <= hi; ++q) s += z[((size_t)b * S + q) * 2048 + c];
    d[i] = s / (float)(hi - lo + 1) - z[(size_t)tok * 2048 + c];
}
__global__ void __launch_bounds__(256) scale_cols(float* __restrict__ y, int ld, int ncols, const float* __restrict__ sc, size_t n) {
    const size_t i = (size_t)blockIdx.x * 256 + threadIdx.x; if (i >= n) return; const int c = (int)(i % ncols); const size_t r = i / ncols; y[r * ld + c] *= sc[c];
}
__global__ void __launch_bounds__(128) natten(const float* __restrict__ z, const float* __restrict__ qn, const float* __restrict__ kn, const float* __restrict__ rpb, float* __restrict__ mix) {
    __shared__ float qs[64]; __shared__ float ps[128]; __shared__ float red[128];
    const int tok = blockIdx.x >> 3, h = blockIdx.x & 7, b = tok / S, t = tok % S, r = t / GW, c = t % GW, j = threadIdx.x;
    int rs = r - 4; if (rs < 0) rs = 0; if (rs > ROWS - 8) rs = ROWS - 8;
    int cs = c - 8; if (cs < 0) cs = 0; if (cs > GW - 16) cs = GW - 16;
    if (j < 64) qs[j] = z[(size_t)tok * 2048 + 512 + h * 64 + j];
    __syncthreads();
    float qss = 0.f; for (int d = 0; d < 64; ++d) qss += qs[d] * qs[d];
    const float rq = 1.0f / sqrtf(qss / 64.f + EPS);
    const int i = j >> 4, jj = j & 15; const int kt = b * S + (rs + i) * GW + cs + jj;
    const float* kr = z + (size_t)kt * 2048 + 1024 + h * 64;
    float kss = 0.f, dot = 0.f;
    for (int d = 0; d < 64; ++d) { const float kv = kr[d]; kss += kv * kv; dot += (qs[d] * rq * qn[d] * 0.125f) * (kv * kn[d]); }
    const float rk = 1.0f / sqrtf(kss / 64.f + EPS);
    const int dr = rs + i - r + 7, dc = cs + jj - c + 15;
    const float sc = dot * rk + rpb[(h * 15 + dr) * 31 + dc];
    red[j] = sc; __syncthreads();
    for (int o = 64; o > 0; o >>= 1) { if (j < o) red[j] = fmaxf(red[j], red[j + o]); __syncthreads(); }
    const float mx = red[0]; __syncthreads();
    const float p = expf(sc - mx); ps[j] = p; red[j] = p; __syncthreads();
    for (int o = 64; o > 0; o >>= 1) { if (j < o) red[j] += red[j + o]; __syncthreads(); }
    const float inv = 1.0f / red[0];
    if (j < 64) { float o = 0.f;
        for (int q = 0; q < 128; ++q) { const int vt = b * S + (rs + (q >> 4)) * GW + cs + (q & 15); o += ps[q] * z[(size_t)vt * 2048 + 1536 + h * 64 + j]; }
        mix[(size_t)tok * 1024 + 512 + h * 64 + j] = o * inv; }
}
__global__ void __launch_bounds__(256) add_to(float* __restrict__ o, const float* __restrict__ a, const float* __restrict__ b, size_t n) {
    const size_t i = (size_t)blockIdx.x * 256 + threadIdx.x; if (i < n) o[i] = a[i] + b[i];
}
__global__ void __launch_bounds__(256) router(const float* __restrict__ h2, const float* __restrict__ wr, float* __restrict__ aff) {
    __shared__ float red[16][256];
    const int tok = blockIdx.x; float acc[16] = {};
    for (int d = threadIdx.x; d < D; d += 256) { const float v = h2[(size_t)tok * D + d];
#pragma unroll
        for (int e = 0; e < 16; ++e) acc[e] += v * wr[d * 16 + e]; }
#pragma unroll
    for (int e = 0; e < 16; ++e) red[e][threadIdx.x] = acc[e];
    __syncthreads();
    for (int o = 128; o > 0; o >>= 1) { if ((int)threadIdx.x < o) { for (int e = 0; e < 16; ++e) red[e][threadIdx.x] += red[e][threadIdx.x + o]; } __syncthreads(); }
    if (threadIdx.x < 16) { float mx = -1e30f; for (int e = 0; e < 16; ++e) mx = fmaxf(mx, red[e][0]); float sum = 0.f; for (int e = 0; e < 16; ++e) sum += expf(red[e][0] - mx);
        const int e = threadIdx.x, b = tok / S, s = tok % S; aff[((size_t)b * NE + e) * S + s] = expf(red[e][0] - mx) / sum; }
}
__global__ void __launch_bounds__(1024) topk(const float* __restrict__ aff, int* __restrict__ idx, float* __restrict__ gates, int* __restrict__ slot_of) {
    __shared__ float v[S];
    const int be = blockIdx.x, b = be / NE, e = be % NE;
    for (int i = threadIdx.x; i < S; i += 1024) v[i] = aff[(size_t)be * S + i];
    __syncthreads();
    for (int i = threadIdx.x; i < S; i += 1024) { const float vi = v[i]; int rank = 0;
        for (int q = 0; q < S; ++q) { const float vq = v[q]; rank += (vq > vi || (vq == vi && q < i)) ? 1 : 0; }
        if (rank < CAP) { idx[be * CAP + rank] = i; gates[be * CAP + rank] = vi; }
        slot_of[((size_t)b * S + i) * NE + e] = rank < CAP ? rank : -1; }
}
__global__ void __launch_bounds__(256) gather_rows(const float* __restrict__ h2, const int* __restrict__ idx, float* __restrict__ xe) {
    const int slot = blockIdx.x; const int be = slot / CAP, b = be / NE; const int tok = b * S + idx[slot];
    for (int c = threadIdx.x; c < D; c += 256) xe[(size_t)slot * D + c] = h2[(size_t)tok * D + c];
}
__global__ void __launch_bounds__(256) silu_mul(float* __restrict__ a, const float* __restrict__ bb, size_t n) {
    const size_t i = (size_t)blockIdx.x * 256 + threadIdx.x; if (i < n) { const float x = a[i]; a[i] = x / (1.0f + expf(-x)) * bb[i]; }
}
__global__ void __launch_bounds__(256) combine(float* __restrict__ x, const float* __restrict__ ye, const float* __restrict__ gates, const int* __restrict__ slot_of) {
    const int tok = blockIdx.x, b = tok / S;
    for (int c = threadIdx.x; c < D; c += 256) { float acc = x[(size_t)tok * D + c];
        for (int e = 0; e < NE; ++e) { const int sl = slot_of[(size_t)tok * NE + e]; if (sl >= 0) { const int slot = (b * NE + e) * CAP + sl; acc += ye[(size_t)slot * D + c] * gates[slot]; } }
        x[(size_t)tok * D + c] = acc; }
}
__global__ void __launch_bounds__(256) ple_final(float* __restrict__ x, const float* __restrict__ glog, const float* __restrict__ en, size_t n) {
    const size_t i = (size_t)blockIdx.x * 256 + threadIdx.x; if (i < n) { const float g = 1.0f / (1.0f + expf(-glog[i])); x[i] = x[i] + g * en[i]; }
}
}

#define MODE 0
#define GAS __attribute__((address_space(1)))
#define LAS __attribute__((address_space(3)))
typedef unsigned short bf16_t;
typedef short bf16x8 __attribute__((ext_vector_type(8)));
typedef float f32x4 __attribute__((ext_vector_type(4)));
typedef float f32x2 __attribute__((ext_vector_type(2)));
typedef unsigned u32x4 __attribute__((ext_vector_type(4)));
typedef unsigned u32x2 __attribute__((ext_vector_type(2)));
typedef __bf16 bf16x2_t __attribute__((ext_vector_type(2)));

__device__ __forceinline__ unsigned pkbf(float lo, float hi) { f32x2 v = {lo, hi}; bf16x2_t b = __builtin_convertvector(v, bf16x2_t); return __builtin_bit_cast(unsigned, b); }
__device__ __forceinline__ float bf2f(unsigned short u) { return __builtin_bit_cast(float, (unsigned)u << 16); }
__device__ __forceinline__ float bflo(unsigned u) { return __builtin_bit_cast(float, u << 16); }
__device__ __forceinline__ float bfhi(unsigned u) { return __builtin_bit_cast(float, u & 0xffff0000u); }
__device__ __forceinline__ float wave_sum(float v) {
#pragma unroll
    for (int o = 1; o < 64; o <<= 1) v += __shfl_xor(v, o);
    return v;
}
constexpr float LOG2E = 1.4426950408889634f;

namespace pg8 {
constexpr int BM = 256, BK = 64, HALF = 128, HTB = HALF * BK * 2, STAGE_BYTES = 8 * HTB;
__host__ __device__ __forceinline__ int lds_byte(int r, int c) { const int st = (r >> 4) * 2 + (c >> 5), rr = r & 15, cc = c & 31, ob = rr * 64 + cc * 2; return st * 1024 + (ob ^ (((ob >> 9) & 1) << 5)); }
__host__ __device__ __forceinline__ void stage_rc(int b, int& R, int& C) { const int st = b / 1024, sb = b % 1024, swz = sb ^ (((sb >> 9) & 1) << 5); R = (st >> 1) * 16 + swz / 64; C = (st & 1) * 32 + (swz % 64) / 2; }
__host__ __device__ __forceinline__ int perm32(int rho) { const int n = rho >> 4, i = rho & 15; return 8 * (i >> 2) + 4 * n + (i & 3); }

struct Unit { int arow, brow, pm, pn, grp; };
struct Gemm { const bf16_t* A; const bf16_t* Bt; int K; };

struct StaticOrder {
    int nM, nN, nwg, G, c;
    __device__ void init(int M, int N, int G_, int c_) { nM = M / BM; nN = N / BM; nwg = nM * nN; G = G_; c = c_; }
    __device__ bool next(int i, Unit& u) const {
        const long L = (long)i * G + c; if (L >= nwg) return false;
        int wgid = (int)L; { const int q = nwg / 8, r = nwg % 8, xcd = wgid % 8, off = wgid / 8; wgid = (xcd < r ? xcd * (q + 1) : r * (q + 1) + (xcd - r) * q) + off; }
        const int nig = 8 * nN, gid = wgid / nig, fm = gid * 8, gsz = (nM - fm) < 8 ? (nM - fm) : 8;
        u.pm = fm + ((wgid % nig) % gsz); u.pn = (wgid % nig) / gsz; u.arow = u.pm * BM; u.brow = u.pn * BM; u.grp = 0; return true;
    }
};

template <class Epi, class Sched>
__device__ __forceinline__ void gemm_phase(LAS unsigned char* lds, const Gemm g, const Sched& S, const Epi& E) {
    const int tid = threadIdx.x, wid = __builtin_amdgcn_readfirstlane(tid >> 6), lane = tid & 63, wr = wid >> 2, wc = wid & 3, fr = lane & 15, fq = lane >> 4;
    int K = g.K; asm volatile("" : "+s"(K));
    const int nt = K / BK;
    unsigned voffA[2], voffB[2];
#pragma unroll
    for (int i = 0; i < 2; ++i) { int R, C; stage_rc(tid * 16 + i * 8192, R, C); const int Rb = 64 * (R >> 5) + perm32(R & 31);
        voffA[i] = (unsigned)(R * K + C) * 2u; voffB[i] = (unsigned)(Rb * K + C) * 2u; }
    const unsigned kstep = (unsigned)(BK * 2);
    const unsigned hstep = (unsigned)HALF * K * 2;
    const unsigned hstepB = (unsigned)32 * K * 2;
    const unsigned rstep = (unsigned)K * 2;
    const unsigned ldsw = (unsigned)wid * 1024u;
    const int aoff = lds_byte(wr * 64 + fr, fq * 8), boff = lds_byte(wc * 32 + fr, fq * 8);
#define PG8_SA(b, h) (((b) * 2 + (h)) * HTB)
#define PG8_SB(b, h) ((4 + (b) * 2 + (h)) * HTB)
#define PG8_STAGE(bufoff, gbase, voff) do { _Pragma("unroll") for (int _i = 0; _i < 2; ++_i) \
        __builtin_amdgcn_global_load_lds((const unsigned*)((const char*)(gbase) + (voff)[_i]), (LAS unsigned*)(lds + (bufoff) + ldsw + _i * 8192), 16, 0, 0); } while (0)
#define PG8_LDA(dst, b, h) do { _Pragma("unroll") for (int m = 0; m < 4; ++m) _Pragma("unroll") for (int k = 0; k < 2; ++k) dst[m][k] = *(const LAS bf16x8*)(lds + PG8_SA(b, h) + aoff + m * 2048 + k * 1024); } while (0)
#define PG8_LDB(dst, b, h) do { _Pragma("unroll") for (int n = 0; n < 2; ++n) _Pragma("unroll") for (int k = 0; k < 2; ++k) dst[n][k] = *(const LAS bf16x8*)(lds + PG8_SB(b, h) + boff + n * 2048 + k * 1024); } while (0)
#define PG8_MMA(ai, bj, At, Bt) do { __builtin_amdgcn_s_setprio(1); _Pragma("unroll") for (int m = 0; m < 4; ++m) _Pragma("unroll") for (int n = 0; n < 2; ++n) _Pragma("unroll") for (int k = 0; k < 2; ++k) \
        acc[ai][bj][m][n] = __builtin_amdgcn_mfma_f32_16x16x32_bf16(Bt[n][k], At[m][k], acc[ai][bj][m][n], 0, 0, 0); __builtin_amdgcn_s_setprio(0); } while (0)
#define PG8_WAIT_V(n) asm volatile("s_waitcnt vmcnt(" #n ")" ::: "memory")
#define PG8_WAIT_L(n) asm volatile("s_waitcnt lgkmcnt(" #n ")" ::: "memory")
#define PG8_BAR __builtin_amdgcn_s_barrier()
#define PG8_SCHED __builtin_amdgcn_sched_barrier(0)
    Unit cur, nxt; int ui = 0;
    if (!S.next(0, cur)) return;
    f32x4 acc[2][2][4][2];
#pragma unroll
    for (int a = 0; a < 2; ++a)
#pragma unroll
        for (int b = 0; b < 2; ++b)
#pragma unroll
            for (int m = 0; m < 4; ++m)
#pragma unroll
                for (int n = 0; n < 2; ++n) acc[a][b][m][n] = (f32x4){0.f, 0.f, 0.f, 0.f};
    bf16x8 At[4][2], B0[2][2], B1[2][2];
    const char* cA = (const char*)g.A + (size_t)cur.arow * rstep; const char* cB = (const char*)g.Bt + (size_t)cur.brow * rstep;
    PG8_STAGE(PG8_SB(0, 0), cB, voffB); PG8_STAGE(PG8_SB(0, 1), cB + hstepB, voffB); PG8_STAGE(PG8_SA(0, 0), cA, voffA); PG8_STAGE(PG8_SA(0, 1), cA + hstep, voffA);
    if (wr == 1) PG8_BAR;
    PG8_WAIT_V(2); PG8_BAR;
    PG8_STAGE(PG8_SB(1, 0), cB + kstep, voffB); PG8_STAGE(PG8_SA(1, 0), cA + kstep, voffA); PG8_STAGE(PG8_SB(1, 1), cB + hstepB + kstep, voffB);
    PG8_WAIT_V(6); PG8_BAR;
    for (;;) {
        const bool has_next = S.next(ui + 1, nxt);
        const char* nA = has_next ? (const char*)g.A + (size_t)nxt.arow * rstep : cA; const char* nB = has_next ? (const char*)g.Bt + (size_t)nxt.brow * rstep : cB;
        for (int t = 0; t < nt; t += 2) {
            const bool last = (t == nt - 2);
            const char* a1 = cA + (unsigned)(t + 1) * kstep;
            const char* a2 = last ? nA : cA + (unsigned)(t + 2) * kstep; const char* b2 = last ? nB : cB + (unsigned)(t + 2) * kstep;
            const char* a3 = a2 + kstep; const char* b3 = b2 + kstep;
            PG8_LDB(B0, 0, 0); PG8_LDB(B1, 0, 1); PG8_SCHED; PG8_LDA(At, 0, 0); PG8_STAGE(PG8_SA(1, 1), a1 + hstep, voffA);
            PG8_WAIT_V(8); PG8_WAIT_L(0); PG8_BAR; PG8_MMA(0, 0, At, B0); PG8_MMA(0, 1, At, B1); PG8_BAR; PG8_SCHED;
            PG8_LDA(At, 0, 1); PG8_STAGE(PG8_SB(0, 0), b2, voffB); PG8_STAGE(PG8_SB(0, 1), b2 + hstepB, voffB); PG8_STAGE(PG8_SA(0, 0), a2, voffA);
            PG8_WAIT_V(8); PG8_WAIT_L(0); PG8_BAR; PG8_MMA(1, 0, At, B0); PG8_MMA(1, 1, At, B1); PG8_BAR; PG8_SCHED;
            PG8_LDB(B0, 1, 0); PG8_LDB(B1, 1, 1); PG8_SCHED; PG8_LDA(At, 1, 0); PG8_STAGE(PG8_SA(0, 1), a2 + hstep, voffA);
            PG8_WAIT_V(8); PG8_WAIT_L(0); PG8_BAR; PG8_MMA(0, 0, At, B0); PG8_MMA(0, 1, At, B1); PG8_BAR; PG8_SCHED;
            PG8_LDA(At, 1, 1); PG8_STAGE(PG8_SB(1, 0), b3, voffB); PG8_STAGE(PG8_SB(1, 1), b3 + hstepB, voffB); PG8_STAGE(PG8_SA(1, 0), a3, voffA);
            PG8_WAIT_V(8); PG8_WAIT_L(0); PG8_BAR; PG8_MMA(1, 0, At, B0); PG8_MMA(1, 1, At, B1); PG8_BAR; PG8_SCHED;
        }
        if (wr == 0) PG8_BAR;
        E(acc, cur, wr, wc, fr, fq);
        if (!has_next) break;
#pragma unroll
        for (int a = 0; a < 2; ++a)
#pragma unroll
            for (int b = 0; b < 2; ++b)
#pragma unroll
                for (int m = 0; m < 4; ++m)
#pragma unroll
                    for (int n = 0; n < 2; ++n) acc[a][b][m][n] = (f32x4){0.f, 0.f, 0.f, 0.f};
        cur = nxt; cA = nA; cB = nB; ++ui;
        if (wr == 1) PG8_BAR;
    }
    PG8_WAIT_V(0);
    PG8_BAR;
#undef PG8_SA
#undef PG8_SB
#undef PG8_STAGE
#undef PG8_LDA
#undef PG8_LDB
#undef PG8_MMA
#undef PG8_WAIT_V
#undef PG8_WAIT_L
#undef PG8_BAR
#undef PG8_SCHED
}
}

constexpr size_t MiB = (size_t)1 << 20;
constexpr size_t WS_CTL = 0, CTL_ZERO_BYTES = 64 * 1024;
constexpr size_t WS_WIN = 4 * MiB, WS_WOUT = 8 * MiB, WS_WPG = 10 * MiB, WS_WPP = 12 * MiB, WS_WPOOL = 12 * MiB + 512 * 1024;
constexpr size_t WS_WGU = 16 * MiB, WS_WD = 144 * MiB;
constexpr size_t WS_HH = 208 * MiB;
constexpr size_t WS_U = 208 * MiB, WS_Q = 224 * MiB, WS_K = 240 * MiB, WS_VT = 256 * MiB, WS_MIX = 272 * MiB, WS_XN = 304 * MiB;
constexpr size_t WS_PB = 336 * MiB, WS_EB = 344 * MiB, WS_H2 = 376 * MiB  , WS_XE = 408 * MiB  ;
constexpr size_t WS_AFF = 480 * MiB, WS_GATES = 481 * MiB, WS_SLOT = 482 * MiB, WS_ESQ = 483 * MiB, WS_RSTDE = 484 * MiB;
constexpr size_t WS_MEGA_END = 485 * MiB;
constexpr int CW_BAR = 1024;

constexpr int RING_BYTES = 131072, LDSCTL_OFF = RING_BYTES, MISC_OFF = LDSCTL_OFF + 320, LDS_BYTES = 147456;

#define XB_TMO      128
#define XB_XCNT(j)  (256  + 64 * (j))
#define XB_XSUB(j)  (1280 + 64 * (j))
#define XB_XGEN(j)  (2304 + 64 * (j))
#define XB_TOP      3328
#define XB_TOPGEN   3392
#define XCD_BAR_WORDS 3456
#define XB_SPIN_CAP (1u << 18)
__device__ __forceinline__ unsigned xb_ld(unsigned* p)              { return __hip_atomic_load(p, __ATOMIC_RELAXED, __HIP_MEMORY_SCOPE_AGENT); }
__device__ __forceinline__ unsigned xb_add(unsigned* p, unsigned v) { return __hip_atomic_fetch_add(p, v, __ATOMIC_RELAXED, __HIP_MEMORY_SCOPE_AGENT); }
__device__ __forceinline__ unsigned xb_xcc_id() { return (unsigned)__builtin_amdgcn_s_getreg((3 << 11) | 20) & 0xFu; }
#define XB_SPIN(cond, bar) do { unsigned _sp = 0; while (cond) { __builtin_amdgcn_s_sleep(1); \
    if ((++_sp & 255u) == 0u) { if (xb_ld(&(bar)[XB_TMO])) break; if (_sp > XB_SPIN_CAP) { atomicAdd(&(bar)[XB_TMO], 1u); break; } } } } while (0)
__device__ __forceinline__ void xcd_barrier_post(unsigned* bar) { if (threadIdx.x == 0) (void)xb_add(&bar[XB_XCNT(xb_xcc_id())], 1u); }
__device__ __forceinline__ void xcd_barrier_complete(unsigned* bar, unsigned x, unsigned& nloc, unsigned& nx) {
    const unsigned G = gridDim.x * gridDim.y * gridDim.z;
    unsigned sum, cnt, mine, sp = 0u;
    for (;;) {
        sum = 0u; cnt = 0u; mine = 0u;
#pragma unroll
        for (unsigned j = 0; j < 16; ++j) { const unsigned c = xb_ld(&bar[XB_XCNT(j)]); sum += c; cnt += (c > 0u) ? 1u : 0u; mine = (j == x) ? c : mine; }
        if (sum == G) break;
        __builtin_amdgcn_s_sleep(1);
        if ((++sp & 255u) == 0u) { if (xb_ld(&bar[XB_TMO])) break; if (sp > XB_SPIN_CAP) { atomicAdd(&bar[XB_TMO], 1u); break; } }
    }
    nloc = mine > 0u ? mine : 1u; nx = cnt > 0u ? cnt : 1u;
}
__device__ __forceinline__ void xcd_barrier(unsigned* bar, volatile LAS unsigned* st) {
    asm volatile("s_waitcnt vmcnt(0)" ::: "memory");
    __syncthreads();
    if (threadIdx.x == 0) {
        const unsigned x = xb_xcc_id();
        __builtin_amdgcn_s_waitcnt(0);
        unsigned nloc = st[0], nx = st[1];
        if (nloc == 0u) { xcd_barrier_complete(bar, x, nloc, nx); st[0] = nloc; st[1] = nx; }
        const unsigned old = xb_add(&bar[XB_XSUB(x)], 1u);
        const unsigned gen = old / nloc;
        if (old + 1u == (gen + 1u) * nloc) {
            __builtin_amdgcn_fence(__ATOMIC_RELEASE, "agent");
            asm volatile("s_waitcnt vmcnt(0)" ::: "memory");
            const unsigned og = xb_add(&bar[XB_TOP], 1u);
            const unsigned tg = og / nx;
            if (og + 1u == (tg + 1u) * nx) xb_add(&bar[XB_TOPGEN], 1u);
            else XB_SPIN(xb_ld(&bar[XB_TOPGEN]) == tg, bar);
            __builtin_amdgcn_fence(__ATOMIC_ACQUIRE, "agent");
            xb_add(&bar[XB_XGEN(x)], 1u);
            asm volatile("s_waitcnt vmcnt(0)" ::: "memory");
        } else {
            XB_SPIN(xb_ld(&bar[XB_XGEN(x)]) == gen, bar);
            __builtin_amdgcn_fence(__ATOMIC_ACQUIRE, "agent");
            asm volatile("s_waitcnt vmcnt(0)" ::: "memory");
        }
    }
    __syncthreads();
}

struct MArgs { const float* in[19]; float* out; unsigned char* ws; int ph_lo, ph_hi; };
struct Frame {
    LAS unsigned char* lds; int tid, lane, wave, vcu, G;
    float* out; unsigned char* ws; const MArgs* a;
};
#define F_x (F.a->in[0])
#define F_p (F.a->in[1])
#define F_norm_mix (F.a->in[2])
#define F_w_in (F.a->in[3])
#define F_w_pool (F.a->in[4])
#define F_pool_scale (F.a->in[5])
#define F_q_norm (F.a->in[6])
#define F_k_norm (F.a->in[7])
#define F_rpb (F.a->in[8])
#define F_w_out (F.a->in[9])
#define F_norm_ffn (F.a->in[10])
#define F_w_router (F.a->in[11])
#define F_w_gate (F.a->in[12])
#define F_w_up (F.a->in[13])
#define F_w_down (F.a->in[14])
#define F_norm_ple (F.a->in[15])
#define F_w_ple_gate (F.a->in[16])
#define F_w_ple_proj (F.a->in[17])
#define F_norm_ple_post (F.a->in[18])
#define WSP(T, off) ((T*)(F.ws + (off)))

__device__ __forceinline__ void tr_item(const float* W, int K, int N, bf16_t* WT, int kb, int nb, int dst_row0, LAS float* scr, int lane) {
    const int k0 = 64 * kb, n0 = 32 * nb;
#pragma unroll 8
    for (int i = 0; i < 32; ++i) { const int kk = 2 * i + (lane >> 5); scr[kk * 33 + (lane & 31)] = W[(size_t)(k0 + kk) * N + n0 + (lane & 31)]; }
    asm volatile("s_waitcnt lgkmcnt(0)" ::: "memory");
    const int c = lane & 7;
#pragma unroll
    for (int j = 0; j < 4; ++j) { const int n = (lane >> 3) + 8 * j; const LAS float* s = scr + (8 * c) * 33 + n;
        u32x4 o; o.x = pkbf(s[0 * 33], s[1 * 33]); o.y = pkbf(s[2 * 33], s[3 * 33]); o.z = pkbf(s[4 * 33], s[5 * 33]); o.w = pkbf(s[6 * 33], s[7 * 33]);
        *(u32x4*)(WT + (size_t)(dst_row0 + n) * K + k0 + 8 * c) = o; }
    asm volatile("s_waitcnt lgkmcnt(0)" ::: "memory");
}
__device__ __forceinline__ void rms_row_to_bf16(const float* xrow, const float* g, bf16_t* orow, int lane) {
    const f32x4* xr = (const f32x4*)xrow + lane; const f32x4* gr = (const f32x4*)g + lane;
    f32x4 v[4]; float s = 0.f;
#pragma unroll
    for (int j = 0; j < 4; ++j) { v[j] = xr[64 * j]; s += (v[j].x * v[j].x + v[j].y * v[j].y) + (v[j].z * v[j].z + v[j].w * v[j].w); }
    const float rstd = 1.0f / sqrtf(wave_sum(s) * (1.0f / D) + EPS);
    u32x2* o8 = (u32x2*)orow + lane;
#pragma unroll
    for (int j = 0; j < 4; ++j) { const f32x4 gg = gr[64 * j]; u32x2 o; o.x = pkbf(v[j].x * rstd * gg.x, v[j].y * rstd * gg.y); o.y = pkbf(v[j].z * rstd * gg.z, v[j].w * rstd * gg.w); o8[64 * j] = o; }
}
__device__ __forceinline__ void p0_prologue(Frame& F) {
    LAS float* scr = (LAS float*)(F.lds + F.wave * 16384);
    const int gw = F.vcu * 8 + F.wave, NGW = F.G * 8;
    constexpr int I_IN = 16 * 64, I_OUT = 16 * 32, I_PG = 16 * 32, I_PP = 4 * 32, I_E = 1024;
    constexpr int NSMALL = I_IN + I_OUT + I_PG + I_PP, NITEMS = NSMALL + 3 * 16 * I_E;
    bf16_t* Win_t = WSP(bf16_t, WS_WIN); bf16_t* Wout_t = WSP(bf16_t, WS_WOUT); bf16_t* Wpg_t = WSP(bf16_t, WS_WPG); bf16_t* Wpp_t = WSP(bf16_t, WS_WPP);
    bf16_t* Wgu_t = WSP(bf16_t, WS_WGU); bf16_t* Wd_t = WSP(bf16_t, WS_WD);
    for (int it = gw; it < NITEMS; it += NGW) {
        int r = it;
        if (r < I_IN) { tr_item(F_w_in, 1024, 2048, Win_t, r / 64, r % 64, 32 * (r % 64), scr, F.lane); continue; } r -= I_IN;
        if (r < I_OUT) { tr_item(F_w_out, 1024, 1024, Wout_t, r / 32, r % 32, 32 * (r % 32), scr, F.lane); continue; } r -= I_OUT;
        if (r < I_PG) { tr_item(F_w_ple_gate, 1024, 1024, Wpg_t, r / 32, r % 32, 32 * (r % 32), scr, F.lane); continue; } r -= I_PG;
        if (r < I_PP) { tr_item(F_w_ple_proj, 256, 1024, Wpp_t, r / 32, r % 32, 32 * (r % 32), scr, F.lane); continue; } r -= I_PP;
        const int mat = r / (16 * I_E), e = (r / I_E) % 16, q = r % I_E;
        if (mat < 2) {
            const int kb = q / 64, nb = q % 64, n0 = 32 * nb;
            tr_item((mat == 0 ? F_w_gate : F_w_up) + (size_t)e * 1024 * 2048, 1024, 2048, Wgu_t, kb, nb, e * 4096 + (n0 >> 7) * 256 + ((n0 >> 5) & 3) * 64 + 32 * mat, scr, F.lane);
        } else {
            const int kb = q / 32, nb = q % 32;
            tr_item(F_w_down + (size_t)e * 2048 * 1024, 2048, 1024, Wd_t, kb, nb, e * 1024 + 32 * nb, scr, F.lane);
        }
    }
    bf16_t* XN = WSP(bf16_t, WS_XN);
    for (int m = gw; m < T; m += NGW) rms_row_to_bf16(F_x + (size_t)m * D, F_norm_mix, XN + (size_t)m * D, F.lane);
    { const int gt = F.vcu * 512 + F.tid, NT_ = F.G * 512; const f32x4* p4 = (const f32x4*)F_p; u32x2* o = WSP(u32x2, WS_PB);
      for (int i = gt; i < T * PD / 4; i += NT_) { const f32x4 v = p4[i]; u32x2 w; w.x = pkbf(v.x, v.y); w.y = pkbf(v.z, v.w); o[i] = w; }
      bf16_t* Wp = WSP(bf16_t, WS_WPOOL);
      for (int i = gt; i < 4 * 128 * 128; i += NT_) { const int gg = i >> 14, n = (i >> 7) & 127, k = i & 127; const float v = F_w_pool[(gg * 128 + k) * 128 + n] * F_pool_scale[gg * 128 + n]; Wp[i] = (bf16_t)(pkbf(v, 0.f) & 0xffffu); }
    }
}

typedef f32x4 AccT[2][2][4][2];
struct EpiQKV {
    bf16_t *U, *Q, *Kk, *VT; const float *qn, *kn;
    __device__ __forceinline__ void operator()(const AccT& acc, const pg8::Unit& u, int wr, int wc, int fr_, int fq_) const {
        int fr = fr_, fq = fq_; asm volatile("" : "+v"(fr), "+v"(fq));
        const int type = u.pn >> 1; const int row0 = u.pm * 256 + wr * 64 + fr;
        if (type == 0) {
#pragma unroll
            for (int ai = 0; ai < 2; ++ai)
#pragma unroll
                for (int m = 0; m < 4; ++m) { const int row = row0 + ai * 128 + m * 16; bf16_t* rp = U + (size_t)row * 512 + (u.pn & 1) * 256 + wc * 64 + 8 * fq;
#pragma unroll
                    for (int bj = 0; bj < 2; ++bj) { const f32x4 v0 = acc[ai][bj][m][0], v1 = acc[ai][bj][m][1]; u32x4 w; w.x = pkbf(v0[0], v0[1]); w.y = pkbf(v0[2], v0[3]); w.z = pkbf(v1[0], v1[1]); w.w = pkbf(v1[2], v1[3]); *(u32x4*)(rp + bj * 32) = w; } asm volatile("" ::: "memory"); }
        } else if (type == 3) {
            const int hh = (u.pn & 1) * 4 + wc;
#pragma unroll
            for (int ai = 0; ai < 2; ++ai)
#pragma unroll
                for (int m = 0; m < 4; ++m) { const int row = row0 + ai * 128 + m * 16; const int b = row >> 11, s = row & 2047; bf16_t* bp = VT + ((size_t)((b * 8 + hh) * 32 + (s >> 6)) * 64) * 64 + (s & 63);
#pragma unroll
                    for (int bj = 0; bj < 2; ++bj)
#pragma unroll
                        for (int n = 0; n < 2; ++n)
#pragma unroll
                            for (int i = 0; i < 4; ++i) { const int d = 32 * bj + 8 * fq + 4 * n + i; bp[d * 64] = (bf16_t)(pkbf(acc[ai][bj][m][n][i], 0.f) & 0xffffu); }
                    asm volatile("" ::: "memory"); }
        } else {
            const int hh = (u.pn & 1) * 4 + wc; const float* gn = (type == 1) ? qn : kn; const float sc = (type == 1) ? 0.125f * LOG2E : 1.0f; bf16_t* dst = (type == 1) ? Q : Kk;
            f32x4 gv[2][2];
#pragma unroll
            for (int bj = 0; bj < 2; ++bj)
#pragma unroll
                for (int n = 0; n < 2; ++n) gv[bj][n] = *(const f32x4*)(gn + 32 * bj + 8 * fq + 4 * n) * sc;
#pragma unroll
            for (int ai = 0; ai < 2; ++ai)
#pragma unroll
                for (int m = 0; m < 4; ++m) { const int row = row0 + ai * 128 + m * 16; const int b = row >> 11, s = row & 2047;
                    float ss = 0.f;
#pragma unroll
                    for (int bj = 0; bj < 2; ++bj)
#pragma unroll
                        for (int n = 0; n < 2; ++n) { const f32x4 v = acc[ai][bj][m][n]; ss += (v[0] * v[0] + v[1] * v[1]) + (v[2] * v[2] + v[3] * v[3]); }
                    ss += __shfl_xor(ss, 16); ss += __shfl_xor(ss, 32);
                    const float rstd = 1.0f / sqrtf(ss * (1.0f / 64.0f) + EPS);
                    bf16_t* rp = dst + ((size_t)(b * 8 + hh) * 2048 + s) * 64 + 8 * fq;
#pragma unroll
                    for (int bj = 0; bj < 2; ++bj) { const f32x4 v0 = acc[ai][bj][m][0] * gv[bj][0] * rstd, v1 = acc[ai][bj][m][1] * gv[bj][1] * rstd; u32x4 w; w.x = pkbf(v0[0], v0[1]); w.y = pkbf(v0[2], v0[3]); w.z = pkbf(v1[0], v1[1]); w.w = pkbf(v1[2], v1[3]); *(u32x4*)(rp + bj * 32) = w; } asm volatile("" ::: "memory"); }
        }
    }
};
struct EpiE {
    bf16_t* EB; float* esq;
    __device__ __forceinline__ void operator()(const AccT& acc, const pg8::Unit& u, int wr, int wc, int fr_, int fq_) const {
        int fr = fr_, fq = fq_; asm volatile("" : "+v"(fr), "+v"(fq));
        const int row0 = u.pm * 256 + wr * 64 + fr;
#pragma unroll
        for (int ai = 0; ai < 2; ++ai)
#pragma unroll
            for (int m = 0; m < 4; ++m) { const int row = row0 + ai * 128 + m * 16; bf16_t* rp = EB + (size_t)row * 1024 + u.pn * 256 + wc * 64 + 8 * fq; float ss = 0.f;
#pragma unroll
                for (int bj = 0; bj < 2; ++bj) { const f32x4 v0 = acc[ai][bj][m][0], v1 = acc[ai][bj][m][1];
                    ss += (v0[0] * v0[0] + v0[1] * v0[1]) + (v0[2] * v0[2] + v0[3] * v0[3]) + (v1[0] * v1[0] + v1[1] * v1[1]) + (v1[2] * v1[2] + v1[3] * v1[3]);
                    u32x4 w; w.x = pkbf(v0[0], v0[1]); w.y = pkbf(v0[2], v0[3]); w.z = pkbf(v1[0], v1[1]); w.w = pkbf(v1[2], v1[3]); *(u32x4*)(rp + bj * 32) = w; }
                ss += __shfl_xor(ss, 16); ss += __shfl_xor(ss, 32);
                if (fq == 0) esq[(size_t)row * 16 + u.pn * 4 + wc] = ss; asm volatile("" ::: "memory"); }
    }
};
struct EpiRes {
    const float* x; float* out;
    __device__ __forceinline__ void operator()(const AccT& acc, const pg8::Unit& u, int wr, int wc, int fr_, int fq_) const {
        int fr = fr_, fq = fq_; asm volatile("" : "+v"(fr), "+v"(fq));
        const int row0 = u.pm * 256 + wr * 64 + fr; const int col0 = u.pn * 256 + wc * 64 + 8 * fq;
#pragma unroll
        for (int ai = 0; ai < 2; ++ai)
#pragma unroll
            for (int m = 0; m < 4; ++m) { const size_t off = (size_t)(row0 + ai * 128 + m * 16) * 1024 + col0;
#pragma unroll
                for (int bj = 0; bj < 2; ++bj)
#pragma unroll
                    for (int n = 0; n < 2; ++n) { const f32x4 xv = *(const f32x4*)(x + off + bj * 32 + n * 4); *(f32x4*)(out + off + bj * 32 + n * 4) = xv + acc[ai][bj][m][n]; }
                if (m & 1) asm volatile("" ::: "memory"); }
    }
};
struct EpiGU {
    bf16_t* HH;
    __device__ __forceinline__ void operator()(const AccT& acc, const pg8::Unit& u, int wr, int wc, int fr_, int fq_) const {
        int fr = fr_, fq = fq_; asm volatile("" : "+v"(fr), "+v"(fq));
        const int row0 = u.arow + wr * 64 + fr; const int col0 = u.pn * 128 + wc * 32 + 8 * fq;
#pragma unroll
        for (int ai = 0; ai < 2; ++ai)
#pragma unroll
            for (int m = 0; m < 4; ++m) { float h[8];
#pragma unroll
                for (int n = 0; n < 2; ++n)
#pragma unroll
                    for (int i = 0; i < 4; ++i) { const float a = acc[ai][0][m][n][i], b = acc[ai][1][m][n][i]; h[4 * n + i] = a * __builtin_amdgcn_rcpf(1.0f + __builtin_amdgcn_exp2f(-LOG2E * a)) * b; }
                u32x4 w; w.x = pkbf(h[0], h[1]); w.y = pkbf(h[2], h[3]); w.z = pkbf(h[4], h[5]); w.w = pkbf(h[6], h[7]);
                *(u32x4*)(HH + (size_t)(row0 + ai * 128 + m * 16) * 2048 + col0) = w; }
    }
};
struct EpiDown {
    bf16_t* YE; const float* gates;
    __device__ __forceinline__ void operator()(const AccT& acc, const pg8::Unit& u, int wr, int wc, int fr_, int fq_) const {
        int fr = fr_, fq = fq_; asm volatile("" : "+v"(fr), "+v"(fq));
        const int row0 = u.arow + wr * 64 + fr; const int col0 = u.pn * 256 + wc * 64 + 8 * fq;
#pragma unroll
        for (int ai = 0; ai < 2; ++ai)
#pragma unroll
            for (int m = 0; m < 4; ++m) { const int row = row0 + ai * 128 + m * 16; const float gt = gates[row]; bf16_t* rp = YE + (size_t)row * 1024 + col0;
#pragma unroll
                for (int bj = 0; bj < 2; ++bj) { const f32x4 v0 = acc[ai][bj][m][0] * gt, v1 = acc[ai][bj][m][1] * gt; u32x4 w; w.x = pkbf(v0[0], v0[1]); w.y = pkbf(v0[2], v0[3]); w.z = pkbf(v1[0], v1[1]); w.w = pkbf(v1[2], v1[3]); *(u32x4*)(rp + bj * 32) = w; } }
    }
};
struct EpiFinal {
    float* out; const bf16_t* EB; const float* rstde; const float* gpost;
    __device__ __forceinline__ void operator()(const AccT& acc, const pg8::Unit& u, int wr, int wc, int fr_, int fq_) const {
        int fr = fr_, fq = fq_; asm volatile("" : "+v"(fr), "+v"(fq));
        const int row0 = u.pm * 256 + wr * 64 + fr; const int col0 = u.pn * 256 + wc * 64 + 8 * fq;
        f32x4 gp[2][2];
#pragma unroll
        for (int bj = 0; bj < 2; ++bj)
#pragma unroll
            for (int n = 0; n < 2; ++n) gp[bj][n] = *(const f32x4*)(gpost + col0 + bj * 32 + n * 4);
#pragma unroll
        for (int ai = 0; ai < 2; ++ai)
#pragma unroll
            for (int m = 0; m < 4; ++m) { const int row = row0 + ai * 128 + m * 16; const size_t off = (size_t)row * 1024 + col0; const float re = rstde[row];
#pragma unroll
                for (int bj = 0; bj < 2; ++bj) { const u32x4 ev = *(const u32x4*)(EB + off + bj * 32);
                    const f32x4 e0 = (f32x4){bflo(ev.x), bfhi(ev.x), bflo(ev.y), bfhi(ev.y)} * gp[bj][0] * re, e1 = (f32x4){bflo(ev.z), bfhi(ev.z), bflo(ev.w), bfhi(ev.w)} * gp[bj][1] * re;
                    const f32x4 a0 = acc[ai][bj][m][0], a1 = acc[ai][bj][m][1]; f32x4 g0, g1;
#pragma unroll
                    for (int i = 0; i < 4; ++i) { g0[i] = __builtin_amdgcn_rcpf(1.0f + __builtin_amdgcn_exp2f(-LOG2E * a0[i])); g1[i] = __builtin_amdgcn_rcpf(1.0f + __builtin_amdgcn_exp2f(-LOG2E * a1[i])); }
                    const f32x4 x0 = *(const f32x4*)(out + off + bj * 32), x1 = *(const f32x4*)(out + off + bj * 32 + 4);
                    *(f32x4*)(out + off + bj * 32) = x0 + g0 * e0; *(f32x4*)(out + off + bj * 32 + 4) = x1 + g1 * e1; }
                asm volatile("" ::: "memory"); }
    }
};
struct OrderGU {
    int G, vcu;
    __device__ bool next(int i, pg8::Unit& u) const {
        int e, b, nt;
        if (G == 256) { if (i >= 8) return false; const int x = vcu >> 5, cu = vcu & 31; e = 2 * x + (i >> 2); b = cu & 7; nt = 4 * (i & 3) + (cu >> 3); }
        else { const int L = i * G + vcu; if (L >= 2048) return false; e = L >> 7; b = L & 7; nt = (L >> 3) & 15; }
        u.arow = (b * 16 + e) * 256; u.brow = e * 4096 + nt * 256; u.pm = b; u.pn = nt; u.grp = e; return true;
    }
};
struct OrderDown {
    int G, vcu;
    __device__ bool next(int i, pg8::Unit& u) const {
        int e, b, nt;
        if (G == 256) { if (i >= 2) return false; const int x = vcu >> 5, cu = vcu & 31; e = 2 * x + i; b = cu & 7; nt = cu >> 3; }
        else { const int L = i * G + vcu; if (L >= 512) return false; e = L >> 5; b = L & 7; nt = (L >> 3) & 3; }
        u.arow = (b * 16 + e) * 256; u.brow = e * 1024 + nt * 256; u.pm = b; u.pn = nt; u.grp = e; return true;
    }
};

constexpr int B2_OFF = 1024;
constexpr int UT_OFF = 32768, UT_PITCH = 136, UT_ROWS = 272;
__device__ __forceinline__ void attn_task(Frame& F, int bh, int r, int t3) {
    const int lane = F.lane, g = lane >> 4, m = lane & 15; const int b = bh >> 3, h = bh & 7;
    int rs = r - 4; rs = rs < 0 ? 0 : (rs > ROWS - 8 ? ROWS - 8 : rs);
    const int qb0 = (t3 == 0) ? 0 : t3, qb1 = (t3 == 0) ? 3 : t3;
    const int c0 = 16 * qb0 + m, c1 = 16 * qb1 + m;
    int cs0 = c0 - 8; cs0 = cs0 < 0 ? 0 : (cs0 > GW - 16 ? GW - 16 : cs0);
    int cs1 = c1 - 8; cs1 = cs1 < 0 ? 0 : (cs1 > GW - 16 ? GW - 16 : cs1);
    const bf16_t* Qb = WSP(const bf16_t, WS_Q); const bf16_t* Kb = WSP(const bf16_t, WS_K); const bf16_t* Vb = WSP(const bf16_t, WS_VT);
    const bf16_t* Qp0 = Qb + ((size_t)(bh * 2048 + 64 * r + c0) * 64 + 8 * g); const bf16_t* Qp1 = Qb + ((size_t)(bh * 2048 + 64 * r + c1) * 64 + 8 * g);
    const bf16x8 q00 = *(const bf16x8*)Qp0, q01 = *(const bf16x8*)(Qp0 + 32), q10 = *(const bf16x8*)Qp1, q11 = *(const bf16x8*)(Qp1 + 32);
    f32x4 o0[4], o1[4];
#pragma unroll
    for (int dt = 0; dt < 4; ++dt) { o0[dt] = (f32x4){0.f, 0.f, 0.f, 0.f}; o1[dt] = (f32x4){0.f, 0.f, 0.f, 0.f}; }
    float l0 = 0.f, l1 = 0.f;
    const int rowa = 8 * (m >> 2) + (m & 3);
    const LAS float* b2 = (const LAS float*)(F.lds + B2_OFF) + h * 15 * 32;
    const bf16_t* Kp = Kb + ((size_t)(bh * 2048 + 64 * rs + rowa) * 64 + 8 * g);
    const bf16_t* Vp = Vb + ((size_t)((bh * 32 + rs) * 64 + m) * 64 + 8 * g);
    bf16x8 kA[4], vA[4], kB[4], vB[4];
#define AT_LOAD(kk, vv, i, kp) do { const bf16_t* kp_ = Kp + (i) * 4096 + (kp) * 2048; kk[0] = *(const bf16x8*)kp_; kk[1] = *(const bf16x8*)(kp_ + 32); kk[2] = *(const bf16x8*)(kp_ + 256); kk[3] = *(const bf16x8*)(kp_ + 288); \
        const bf16_t* vp_ = Vp + (i) * 4096 + (kp) * 32; _Pragma("unroll") for (int dt = 0; dt < 4; ++dt) vv[dt] = *(const bf16x8*)(vp_ + dt * 1024); } while (0)
#define AT_COMP(kk, vv, i, kp, qf0, qf1, cc, ccs, oo, ll) do { \
        f32x4 sa = (f32x4){0.f, 0.f, 0.f, 0.f}, sb = (f32x4){0.f, 0.f, 0.f, 0.f}; \
        sa = __builtin_amdgcn_mfma_f32_16x16x32_bf16(kk[0], qf0, sa, 0, 0, 0); sa = __builtin_amdgcn_mfma_f32_16x16x32_bf16(kk[1], qf1, sa, 0, 0, 0); \
        sb = __builtin_amdgcn_mfma_f32_16x16x32_bf16(kk[2], qf0, sb, 0, 0, 0); sb = __builtin_amdgcn_mfma_f32_16x16x32_bf16(kk[3], qf1, sb, 0, 0, 0); \
        const int kc0 = 32 * (kp) + 8 * g; const int dr = rs + (i) - r + 7; \
        const LAS float* bp = b2 + (dr * 32 + 15 - (cc) + kc0); float pa[4], pb[4]; \
        _Pragma("unroll") for (int q = 0; q < 4; ++q) { const bool va = (unsigned)(kc0 + q - (ccs)) < 16u, vb = (unsigned)(kc0 + 4 + q - (ccs)) < 16u; \
            const float ea = __builtin_amdgcn_exp2f(sa[q] + bp[q]), eb = __builtin_amdgcn_exp2f(sb[q] + bp[4 + q]); pa[q] = va ? ea : 0.f; pb[q] = vb ? eb : 0.f; } \
        ll += ((pa[0] + pa[1]) + (pa[2] + pa[3])) + ((pb[0] + pb[1]) + (pb[2] + pb[3])); \
        u32x4 pw; pw.x = pkbf(pa[0], pa[1]); pw.y = pkbf(pa[2], pa[3]); pw.z = pkbf(pb[0], pb[1]); pw.w = pkbf(pb[2], pb[3]); const bf16x8 pf = __builtin_bit_cast(bf16x8, pw); \
        _Pragma("unroll") for (int dt = 0; dt < 4; ++dt) oo[dt] = __builtin_amdgcn_mfma_f32_16x16x32_bf16(vv[dt], pf, oo[dt], 0, 0, 0); } while (0)
    AT_LOAD(kA, vA, 0, 0);
    for (int i = 0; i < 8; ++i) {
        AT_LOAD(kB, vB, i, 1);
        AT_COMP(kA, vA, i, 0, q00, q01, c0, cs0, o0, l0);
        if (i < 7) AT_LOAD(kA, vA, i + 1, 0);
        AT_COMP(kB, vB, i, 1, q10, q11, c1, cs1, o1, l1);
    }
#undef AT_LOAD
#undef AT_COMP
    bf16_t* mixb = WSP(bf16_t, WS_MIX) + (size_t)(b * 2048 + 64 * r) * 1024 + 512 + h * 64 + 4 * g;
    if (t3 != 0) {
#pragma unroll
        for (int dt = 0; dt < 4; ++dt) o0[dt] += o1[dt];
        l0 += l1; l0 += __shfl_xor(l0, 16); l0 += __shfl_xor(l0, 32);
        const float inv = 1.0f / l0; bf16_t* op = mixb + (size_t)c0 * 1024;
#pragma unroll
        for (int dt = 0; dt < 4; ++dt) { u32x2 w; w.x = pkbf(o0[dt][0] * inv, o0[dt][1] * inv); w.y = pkbf(o0[dt][2] * inv, o0[dt][3] * inv); *(u32x2*)(op + 16 * dt) = w; }
    } else {
        l0 += __shfl_xor(l0, 16); l0 += __shfl_xor(l0, 32); l1 += __shfl_xor(l1, 16); l1 += __shfl_xor(l1, 32);
        const float i0 = 1.0f / l0, i1 = 1.0f / l1; bf16_t* op0 = mixb + (size_t)c0 * 1024; bf16_t* op1 = mixb + (size_t)c1 * 1024;
#pragma unroll
        for (int dt = 0; dt < 4; ++dt) { u32x2 w; w.x = pkbf(o0[dt][0] * i0, o0[dt][1] * i0); w.y = pkbf(o0[dt][2] * i0, o0[dt][3] * i0); *(u32x2*)(op0 + 16 * dt) = w;
            u32x2 w1; w1.x = pkbf(o1[dt][0] * i1, o1[dt][1] * i1); w1.y = pkbf(o1[dt][2] * i1, o1[dt][3] * i1); *(u32x2*)(op1 + 16 * dt) = w1; }
    }
}
__device__ __forceinline__ void pool_unit(Frame& F, int pm, int grp) {
    LAS bf16_t* Ut = (LAS bf16_t*)(F.lds + UT_OFF);
    const int tid = F.tid; const int tok0 = pm * 256, b = tok0 >> 11, t0 = tok0 & 2047;
    {   const bf16_t* Ub = WSP(const bf16_t, WS_U) + (size_t)b * 2048 * 512 + grp * 128;
        for (int i = tid; i < UT_ROWS * 16; i += 512) { const int rr = i >> 4, ch = i & 15; const int t = t0 - 8 + rr;
            u32x4 v = (u32x4){0u, 0u, 0u, 0u}; if (t >= 0 && t < S) v = *(const u32x4*)(Ub + (size_t)t * 512 + ch * 8);
            *(LAS u32x4*)(Ut + rr * UT_PITCH + ch * 8) = v; } }
    __syncthreads();
    {   const int lane = F.lane, g = lane >> 4, m = lane & 15, w = F.wave; const int hw = 1 << grp;
        const bf16_t* Wp = WSP(const bf16_t, WS_WPOOL) + (size_t)grp * 128 * 128;
        f32x4 acc[2][8];
#pragma unroll
        for (int mt = 0; mt < 2; ++mt)
#pragma unroll
            for (int nt = 0; nt < 8; ++nt) acc[mt][nt] = (f32x4){0.f, 0.f, 0.f, 0.f};
        float rc[2];
#pragma unroll
        for (int mt = 0; mt < 2; ++mt) { const int t = t0 + 32 * w + 16 * mt + m; const int lo = (t - hw) < 0 ? 0 : (t - hw), hi = (t + hw - 1) > (S - 1) ? (S - 1) : (t + hw - 1); rc[mt] = 1.0f / (float)(hi - lo + 1); }
        for (int ks = 0; ks < 4; ++ks) { bf16x8 af[2];
#pragma unroll
            for (int mt = 0; mt < 2; ++mt) { const LAS bf16_t* up = Ut + (32 * w + 16 * mt + m + 8) * UT_PITCH + 32 * ks + 8 * g;
                float sm[8];
#pragma unroll
                for (int j = 0; j < 8; ++j) sm[j] = 0.f;
                for (int q = -hw; q < hw; ++q) { const u32x4 v = *(const LAS u32x4*)(up + q * UT_PITCH);
                    sm[0] += bflo(v.x); sm[1] += bfhi(v.x); sm[2] += bflo(v.y); sm[3] += bfhi(v.y); sm[4] += bflo(v.z); sm[5] += bfhi(v.z); sm[6] += bflo(v.w); sm[7] += bfhi(v.w); }
                const u32x4 uc = *(const LAS u32x4*)up; const float r_ = rc[mt];
                u32x4 d; d.x = pkbf(sm[0] * r_ - bflo(uc.x), sm[1] * r_ - bfhi(uc.x)); d.y = pkbf(sm[2] * r_ - bflo(uc.y), sm[3] * r_ - bfhi(uc.y));
                d.z = pkbf(sm[4] * r_ - bflo(uc.z), sm[5] * r_ - bfhi(uc.z)); d.w = pkbf(sm[6] * r_ - bflo(uc.w), sm[7] * r_ - bfhi(uc.w));
                af[mt] = __builtin_bit_cast(bf16x8, d); }
#pragma unroll
            for (int nt = 0; nt < 8; ++nt) { const bf16x8 wf = *(const bf16x8*)(Wp + (size_t)(16 * nt + m) * 128 + 32 * ks + 8 * g);
#pragma unroll
                for (int mt = 0; mt < 2; ++mt) acc[mt][nt] = __builtin_amdgcn_mfma_f32_16x16x32_bf16(wf, af[mt], acc[mt][nt], 0, 0, 0); } }
        bf16_t* mix = WSP(bf16_t, WS_MIX);
#pragma unroll
        for (int mt = 0; mt < 2; ++mt)
#pragma unroll
            for (int nt = 0; nt < 8; ++nt) { u32x2 o; o.x = pkbf(acc[mt][nt][0], acc[mt][nt][1]); o.y = pkbf(acc[mt][nt][2], acc[mt][nt][3]);
                *(u32x2*)(mix + (size_t)(pm * 256 + 32 * w + 16 * mt + m) * 1024 + grp * 128 + 16 * nt + 4 * g) = o; }
    }
    __syncthreads();
}
__device__ __forceinline__ void p2_mixer(Frame& F) {
    LAS float* b2 = (LAS float*)(F.lds + B2_OFF);
    for (int i = F.tid; i < 8 * 15 * 32; i += 512) { const int dc = i & 31, hd = i >> 5; b2[i] = dc < 31 ? F_rpb[hd * 31 + dc] * LOG2E : 0.f; }
    __syncthreads();
    for (int u = F.vcu; u < 64 * 4; u += F.G) pool_unit(F, u >> 2, u & 3);
    const int gw = F.vcu * 8 + F.wave, NGW = F.G * 8;
    for (int wt = gw; wt < B * AH * ROWS * 3; wt += NGW) attn_task(F, wt / 96, (wt / 3) & 31, wt % 3);
}

__device__ __forceinline__ void p4_router(Frame& F) {
    LAS float* wt = (LAS float*)F.lds;
    for (int i = F.tid; i < D * NE; i += 512) wt[(i & 15) * D + (i >> 4)] = F_w_router[i];
    __syncthreads();
    const int gw = F.vcu * 8 + F.wave, NGW = F.G * 8, lane = F.lane;
    bf16_t* H2 = WSP(bf16_t, WS_H2); float* aff = WSP(float, WS_AFF);
    for (int row = 2 * gw; row < T; row += 2 * NGW) {
        const f32x4* gr = (const f32x4*)F_norm_ffn + lane;
        f32x4 v[2][4]; float ss[2];
#pragma unroll
        for (int rr = 0; rr < 2; ++rr) { const f32x4* xr = (const f32x4*)(F.out + (size_t)(row + rr) * D) + lane; float s_ = 0.f;
#pragma unroll
            for (int j = 0; j < 4; ++j) { v[rr][j] = xr[64 * j]; s_ += (v[rr][j].x * v[rr][j].x + v[rr][j].y * v[rr][j].y) + (v[rr][j].z * v[rr][j].z + v[rr][j].w * v[rr][j].w); }
            ss[rr] = s_; }
#pragma unroll
        for (int o = 1; o < 64; o <<= 1) { ss[0] += __shfl_xor(ss[0], o); ss[1] += __shfl_xor(ss[1], o); }
#pragma unroll
        for (int rr = 0; rr < 2; ++rr) { const float rstd = 1.0f / sqrtf(ss[rr] * (1.0f / D) + EPS); u32x2* o8 = (u32x2*)(H2 + (size_t)(row + rr) * D) + lane;
#pragma unroll
            for (int j = 0; j < 4; ++j) { v[rr][j] = v[rr][j] * rstd * gr[64 * j]; u32x2 o; o.x = pkbf(v[rr][j].x, v[rr][j].y); o.y = pkbf(v[rr][j].z, v[rr][j].w); o8[64 * j] = o; } }
        float a[32];
#pragma unroll
        for (int e = 0; e < 16; ++e) { float a0 = 0.f, a1 = 0.f;
#pragma unroll
            for (int j = 0; j < 4; ++j) { const f32x4 w4 = *(const LAS f32x4*)(wt + e * D + 256 * j + 4 * lane);
                a0 += (v[0][j].x * w4.x + v[0][j].y * w4.y) + (v[0][j].z * w4.z + v[0][j].w * w4.w); a1 += (v[1][j].x * w4.x + v[1][j].y * w4.y) + (v[1][j].z * w4.z + v[1][j].w * w4.w); }
            a[e] = a0; a[16 + e] = a1; if ((e & 3) == 3) asm volatile("" ::: "memory"); }
#define RS_STEP(n, M) do { const bool up = (lane & (M)) != 0; _Pragma("unroll") for (int j = 0; j < (n) / 2; ++j) { const float snd = up ? a[j] : a[j + (n) / 2]; const float kp_ = up ? a[j + (n) / 2] : a[j]; a[j] = kp_ + __shfl_xor(snd, (M)); } } while (0)
        RS_STEP(32, 32); RS_STEP(16, 16); RS_STEP(8, 8); RS_STEP(4, 4); RS_STEP(2, 2);
#undef RS_STEP
        float lg = a[0] + __shfl_xor(a[0], 1);
        float mx = lg;
#pragma unroll
        for (int o = 2; o < 32; o <<= 1) mx = fmaxf(mx, __shfl_xor(mx, o));
        const float ex = expf(lg - mx); float sum = ex;
#pragma unroll
        for (int o = 2; o < 32; o <<= 1) sum += __shfl_xor(sum, o);
        if ((lane & 1) == 0) { const int k = lane >> 1, rr = k >> 4, e = k & 15; const int rw = row + rr; aff[((size_t)(rw >> 11) * NE + e) * S + (rw & 2047)] = ex / sum; }
    }
}

__device__ __forceinline__ void p5_topk_gather(Frame& F) {
    LAS int* sidx = (LAS int*)F.lds;
    const int lane = F.lane; const float* aff = WSP(const float, WS_AFF); float* gates = WSP(float, WS_GATES); int* slot_of = WSP(int, WS_SLOT);
    const bf16_t* H2 = WSP(const bf16_t, WS_H2); bf16_t* XE = WSP(bf16_t, WS_XE);
    for (int task = F.vcu; task < B * NE * 2; task += F.G) {
        const int be = task >> 1, half = task & 1, b = be >> 4, e = be & 15;
        if (F.wave == 0) {
            unsigned v[32];
#pragma unroll
            for (int j = 0; j < 32; ++j) v[j] = __builtin_bit_cast(unsigned, aff[(size_t)be * S + 64 * j + lane]);
            unsigned Tt = 0u;
            for (int bit = 30; bit >= 0; --bit) { const unsigned cand = Tt | (1u << bit); int cnt = 0;
#pragma unroll
                for (int j = 0; j < 32; ++j) cnt += (v[j] >= cand) ? 1 : 0;
#pragma unroll
                for (int o = 1; o < 64; o <<= 1) cnt += __shfl_xor(cnt, o);
                if (cnt >= CAP) Tt = cand; }
            int ngt = 0;
#pragma unroll
            for (int j = 0; j < 32; ++j) ngt += (v[j] > Tt) ? 1 : 0;
#pragma unroll
            for (int o = 1; o < 64; o <<= 1) ngt += __shfl_xor(ngt, o);
            const int need = CAP - ngt; int eq_run = 0, sel_run = 0;
            const unsigned long long ltmask = (lane == 0) ? 0ull : (~0ull >> (64 - lane));
#pragma unroll
            for (int j = 0; j < 32; ++j) {
                const bool gt = v[j] > Tt, eq = v[j] == Tt;
                const unsigned long long em = __ballot(eq);
                const int eqb = eq_run + __popcll(em & ltmask);
                const bool sel = gt || (eq && eqb < need);
                eq_run += __popcll(em);
                const unsigned long long sm = __ballot(sel);
                const int slot = sel_run + __popcll(sm & ltmask);
                sel_run += __popcll(sm);
                const int tok = 64 * j + lane;
                if (sel) sidx[slot] = tok;
                if (half == 0) { if (sel) gates[be * CAP + slot] = __builtin_bit_cast(float, v[j]); slot_of[((size_t)b * S + tok) * NE + e] = sel ? slot : -1; }
            }
        }
        __syncthreads();
        for (int i = 0; i < 16; ++i) { const int slot = half * 128 + F.wave * 16 + i; const int tok = sidx[slot];
            const u32x4* src = (const u32x4*)(H2 + ((size_t)b * S + tok) * D) + lane; u32x4* dst = (u32x4*)(XE + ((size_t)be * CAP + slot) * D) + lane;
            const u32x4 a0 = src[0], a1 = src[64]; dst[0] = a0; dst[64] = a1; }
        __syncthreads();
    }
}

__device__ __forceinline__ void p8_combine(Frame& F) {
    const int gw = F.vcu * 8 + F.wave, NGW = F.G * 8, lane = F.lane;
    const bf16_t* YE = WSP(const bf16_t, WS_XE); const int* slot_of = WSP(const int, WS_SLOT); bf16_t* X2N = WSP(bf16_t, WS_H2);
    const float* esq = WSP(const float, WS_ESQ); float* rstde = WSP(float, WS_RSTDE);
    for (int row = gw; row < T; row += NGW) {
        f32x4* xr = (f32x4*)(F.out + (size_t)row * D) + lane; const f32x4* gr = (const f32x4*)F_norm_ple + lane;
        f32x4 v[4];
#pragma unroll
        for (int j = 0; j < 4; ++j) v[j] = xr[64 * j];
        const int b = row >> 11;
        const int myslot = (lane < 16) ? slot_of[(size_t)row * NE + lane] : -1;
        for (int e = 0; e < NE; ++e) { const int sl = __shfl(myslot, e);
            if (sl >= 0) { const u32x2* yr = (const u32x2*)(YE + ((size_t)(b * NE + e) * CAP + sl) * D) + lane;
#pragma unroll
                for (int j = 0; j < 4; ++j) { const u32x2 y = yr[64 * j]; v[j].x += bflo(y.x); v[j].y += bfhi(y.x); v[j].z += bflo(y.y); v[j].w += bfhi(y.y); } } }
        float s = 0.f;
#pragma unroll
        for (int j = 0; j < 4; ++j) { xr[64 * j] = v[j]; s += (v[j].x * v[j].x + v[j].y * v[j].y) + (v[j].z * v[j].z + v[j].w * v[j].w); }
        const float rstd = 1.0f / sqrtf(wave_sum(s) * (1.0f / D) + EPS);
        u32x2* o8 = (u32x2*)(X2N + (size_t)row * D) + lane;
#pragma unroll
        for (int j = 0; j < 4; ++j) { const f32x4 gg = gr[64 * j]; u32x2 o; o.x = pkbf(v[j].x * rstd * gg.x, v[j].y * rstd * gg.y); o.y = pkbf(v[j].z * rstd * gg.z, v[j].w * rstd * gg.w); o8[64 * j] = o; }
        float q = (lane < 16) ? esq[(size_t)row * 16 + lane] : 0.f; q = wave_sum(q);
        if (lane == 0) rstde[row] = 1.0f / sqrtf(q * (1.0f / D) + EPS);
    }
}

constexpr int N_PHASES = 10;
__global__ void __launch_bounds__(512, 2) mega_fwd(MArgs args) {
    extern __shared__ __attribute__((aligned(16))) unsigned char lds_raw[];
    Frame F;
    F.lds = (LAS unsigned char*)lds_raw; F.tid = threadIdx.x; F.lane = F.tid & 63; F.wave = __builtin_amdgcn_readfirstlane(F.tid >> 6);
    F.G = gridDim.x; { const int bx = blockIdx.x; F.vcu = (F.G % 8 == 0) ? (bx % 8) * (F.G / 8) + bx / 8 : bx; }
    F.out = args.out; F.ws = args.ws; F.a = &args;
    for (int u = F.tid; u < (LDS_BYTES - LDSCTL_OFF) / 4; u += 512) ((LAS unsigned*)(F.lds + LDSCTL_OFF))[u] = 0u;
    __syncthreads();
    const int lo = args.ph_lo, hi = args.ph_hi;
    if (hi - lo > 1) xcd_barrier_post(WSP(unsigned, WS_CTL) + CW_BAR);
#ifndef PH_ENABLE
#define PH_ENABLE 0x3ff
#endif
#define IN(k) (((PH_ENABLE >> (k)) & 1) && lo <= (k) && (k) < hi)
#ifndef DUP_MASK
#define DUP_MASK 0
#endif
#define GBAR() xcd_barrier(WSP(unsigned, WS_CTL) + CW_BAR, (volatile LAS unsigned*)(F.lds + MISC_OFF) + 8)
#define DUP(k) (((DUP_MASK >> (k)) & 1) ? 2 : 1)
#define SEAM(k) do { if (IN(k) && IN((k) + 1)) xcd_barrier(WSP(unsigned, WS_CTL) + CW_BAR, (volatile LAS unsigned*)(F.lds + MISC_OFF) + 8); } while (0)
    if (IN(0)) { for (int rep = 0; rep < DUP(0); ++rep) { if (rep) GBAR(); p0_prologue(F); } } SEAM(0);
    if (IN(1)) for (int rep = 0; rep < DUP(1); ++rep) { if (rep) GBAR();
#ifndef NO_P1A
        { pg8::Gemm g{WSP(const bf16_t, WS_XN), WSP(const bf16_t, WS_WIN), 1024}; pg8::StaticOrder So; So.init(T, 2048, F.G, (int)blockIdx.x);
          EpiQKV E{WSP(bf16_t, WS_U), WSP(bf16_t, WS_Q), WSP(bf16_t, WS_K), WSP(bf16_t, WS_VT), F_q_norm, F_k_norm};
          pg8::gemm_phase(F.lds, g, So, E); }
#endif
#ifndef NO_P1B
        { pg8::Gemm g{WSP(const bf16_t, WS_PB), WSP(const bf16_t, WS_WPP), 256}; pg8::StaticOrder So; So.init(T, 1024, F.G, (int)blockIdx.x);
          EpiE E{WSP(bf16_t, WS_EB), WSP(float, WS_ESQ)};
          pg8::gemm_phase(F.lds, g, So, E); }
#endif
    } SEAM(1);
    if (IN(2)) { for (int rep = 0; rep < DUP(2); ++rep) { if (rep) GBAR(); p2_mixer(F); } } SEAM(2);
    if (IN(3)) for (int rep = 0; rep < DUP(3); ++rep) { if (rep) GBAR(); pg8::Gemm g{WSP(const bf16_t, WS_MIX), WSP(const bf16_t, WS_WOUT), 1024}; pg8::StaticOrder So; So.init(T, 1024, F.G, (int)blockIdx.x);
        EpiRes E{F_x, F.out}; pg8::gemm_phase(F.lds, g, So, E); } SEAM(3);
    if (IN(4)) { for (int rep = 0; rep < DUP(4); ++rep) { if (rep) GBAR(); p4_router(F); } } SEAM(4);
    if (IN(5)) { for (int rep = 0; rep < DUP(5); ++rep) { if (rep) GBAR(); p5_topk_gather(F); } } SEAM(5);
    if (IN(6)) for (int rep = 0; rep < DUP(6); ++rep) { if (rep) GBAR(); pg8::Gemm g{WSP(const bf16_t, WS_XE), WSP(const bf16_t, WS_WGU), 1024}; OrderGU So{F.G, F.vcu};
        EpiGU E{WSP(bf16_t, WS_HH)}; pg8::gemm_phase(F.lds, g, So, E); } SEAM(6);
    if (IN(7)) for (int rep = 0; rep < DUP(7); ++rep) { if (rep) GBAR(); pg8::Gemm g{WSP(const bf16_t, WS_HH), WSP(const bf16_t, WS_WD), 2048}; OrderDown So{F.G, F.vcu};
        EpiDown E{WSP(bf16_t, WS_XE), WSP(const float, WS_GATES)}; pg8::gemm_phase(F.lds, g, So, E); } SEAM(7);
    if (IN(8)) { p8_combine(F); } SEAM(8);
    if (IN(9)) { pg8::Gemm g{WSP(const bf16_t, WS_H2), WSP(const bf16_t, WS_WPG), 1024}; pg8::StaticOrder So; So.init(T, 1024, F.G, (int)blockIdx.x);
        EpiFinal E{F.out, WSP(const bf16_t, WS_EB), WSP(const float, WS_RSTDE), F_norm_ple_post}; pg8::gemm_phase(F.lds, g, So, E); }
#undef IN
#undef SEAM
}
static inline dim3 g1(size_t n) { return dim3((unsigned)((n + 255) / 256)); }

#ifndef MODE
#define MODE 0
#endif

extern "C" void kernel_launch(void* const* d_in, const int* in_sizes, int n_in, void* d_out, int out_size, void* d_ws, size_t ws_size, hipStream_t stream) {
    const float* x = (const float*)d_in[0]; const float* p = (const float*)d_in[1]; const float* norm_mix = (const float*)d_in[2]; const float* w_in = (const float*)d_in[3];
    const float* w_pool = (const float*)d_in[4]; const float* pool_scale = (const float*)d_in[5]; const float* q_norm = (const float*)d_in[6]; const float* k_norm = (const float*)d_in[7];
    const float* rpb = (const float*)d_in[8]; const float* w_out = (const float*)d_in[9]; const float* norm_ffn = (const float*)d_in[10]; const float* w_router = (const float*)d_in[11];
    const float* w_gate = (const float*)d_in[12]; const float* w_up = (const float*)d_in[13]; const float* w_down = (const float*)d_in[14]; const float* norm_ple = (const float*)d_in[15];
    const float* w_ple_gate = (const float*)d_in[16]; const float* w_ple_proj = (const float*)d_in[17]; const float* norm_ple_post = (const float*)d_in[18];
    float* out = (float*)d_out; char* ws = (char*)d_ws;
    (void)in_sizes; (void)n_in; (void)out_size;
    static int grid = 0;
    if (grid == 0) {
        if (ws_size < (size_t)489 * MiB) { fprintf(stderr, "kernel_launch: workspace too small (%zu)\n", ws_size); grid = -1; return; }
        int dev = 0, cus = 0, per_cu = 0;
        if (hipGetDevice(&dev) != hipSuccess || hipDeviceGetAttribute(&cus, hipDeviceAttributeMultiprocessorCount, dev) != hipSuccess) { grid = -1; return; }
        if (hipFuncSetAttribute((const void*)mega_fwd, hipFuncAttributeMaxDynamicSharedMemorySize, LDS_BYTES) != hipSuccess) { fprintf(stderr, "kernel_launch: hipFuncSetAttribute failed\n"); grid = -1; return; }
        if (hipOccupancyMaxActiveBlocksPerMultiprocessor(&per_cu, (const void*)mega_fwd, 512, LDS_BYTES) != hipSuccess || per_cu < 1) { fprintf(stderr, "kernel_launch: occupancy query says %d blocks per CU\n", per_cu); grid = -1; (void)hipGetLastError(); return; }
        grid = cus;
    }
    if (grid < 0) return;
    (void)hipMemsetAsync((char*)d_ws + WS_CTL, 0, CTL_ZERO_BYTES, stream);
    MArgs a{};
    for (int i = 0; i < 19; ++i) a.in[i] = (const float*)d_in[i];
    a.out = out; a.ws = (unsigned char*)d_ws;
#if MODE == 0
    a.ph_lo = 0; a.ph_hi = N_PHASES;
    hipLaunchKernelGGL(mega_fwd, dim3(grid), dim3(512), LDS_BYTES, stream, a);
#else
    constexpr int KOPT = MODE - 100;
    for (int ph = 0; ph <= KOPT; ++ph) { a.ph_lo = ph; a.ph_hi = ph + 1; hipLaunchKernelGGL(mega_fwd, dim3(grid), dim3(512), LDS_BYTES, stream, a); }
    float* xn = (float*)(ws + 0 * MiB);
    float* z = (float*)(ws + 64 * MiB);
    float* dp = (float*)(ws + 192 * MiB);
    float* ye = (float*)(ws + 288 * MiB);
    float* ga = (float*)(ws + 416 * MiB); float* gb = (float*)(ws + 448 * MiB);
    float* mix = (float*)(ws + 416 * MiB);
    float* aff = (float*)(ws + 485 * MiB); int* idx = (int*)(ws + 486 * MiB); float* gates = (float*)(ws + 487 * MiB); int* slot_of = (int*)(ws + 488 * MiB);
    const unsigned short* mU = (const unsigned short*)(ws + WS_U); const unsigned short* mQ = (const unsigned short*)(ws + WS_Q); const unsigned short* mK = (const unsigned short*)(ws + WS_K); const unsigned short* mVT = (const unsigned short*)(ws + WS_VT);
    if (KOPT < 1) {
        nv::rmsnorm_rows<<<T, 256, 0, stream>>>(x, norm_mix, xn, D);
        nv::gemm_f32<<<dim3(2048 / 64, T / 64, 1), 256, 0, stream>>>(xn, w_in, z, D, D, 2048, 2048, 0, 0, 0);
    }
    if (KOPT < 2) {
        if (KOPT == 1) nv::bf16_to_f32<<<g1((size_t)T * PW), 256, 0, stream>>>(mU, z, PW, 2048, (size_t)T * PW);
        nv::pool_diff<<<g1((size_t)T * PW), 256, 0, stream>>>(z, dp);
        nv::gemm_f32<<<dim3(PG / 64, T / 64, 4), 256, 0, stream>>>(dp, w_pool, mix, PG, PW, PG, D, PG, (size_t)PG * PG, PG);
        nv::scale_cols<<<g1((size_t)T * PW), 256, 0, stream>>>(mix, D, PW, pool_scale, (size_t)T * PW);
        if (KOPT == 1) nv::natten_pre<<<T * AH, 128, 0, stream>>>(mQ, mK, mVT, rpb, mix);
        else nv::natten<<<T * AH, 128, 0, stream>>>(z, q_norm, k_norm, rpb, mix);
    }
    if (KOPT < 3) {
        if (KOPT == 2) nv::bf16_to_f32<<<g1((size_t)T * D), 256, 0, stream>>>((const unsigned short*)(ws + WS_MIX), mix, D, D, (size_t)T * D);
        nv::gemm_f32<<<dim3(D / 64, T / 64, 1), 256, 0, stream>>>(mix, w_out, xn, D, D, D, D, 0, 0, 0);
        nv::add_to<<<g1((size_t)T * D), 256, 0, stream>>>(out, x, xn, (size_t)T * D);
    }
    if (KOPT < 4) {
        nv::rmsnorm_rows<<<T, 256, 0, stream>>>(out, norm_ffn, xn, D);
        nv::router<<<T, 256, 0, stream>>>(xn, w_router, aff);
    } else { aff = (float*)(ws + WS_AFF); }
    if (KOPT < 5) {
        if (KOPT == 4) nv::bf16_to_f32<<<g1((size_t)T * D), 256, 0, stream>>>((const unsigned short*)(ws + WS_H2), xn, D, D, (size_t)T * D);
        nv::topk<<<B * NE, 1024, 0, stream>>>(aff, idx, gates, slot_of);
        nv::gather_rows<<<B * NE * CAP, 256, 0, stream>>>(xn, idx, z);
    } else { gates = (float*)(ws + WS_GATES); slot_of = (int*)(ws + WS_SLOT); }
    if (KOPT < 7) {
        float* xe = z;
        if (KOPT >= 5) nv::bf16_to_f32<<<g1((size_t)B * NE * CAP * D), 256, 0, stream>>>((const unsigned short*)(ws + WS_XE), xe, D, D, (size_t)B * NE * CAP * D);
        for (int b = 0; b < B; ++b) {
            const float* xeb = xe + (size_t)b * NE * CAP * D;
            nv::gemm_f32<<<dim3(DE / 64, CAP / 64, NE), 256, 0, stream>>>(xeb, w_gate, ga, D, D, DE, DE, (size_t)CAP * D, (size_t)D * DE, (size_t)CAP * DE);
            nv::gemm_f32<<<dim3(DE / 64, CAP / 64, NE), 256, 0, stream>>>(xeb, w_up, gb, D, D, DE, DE, (size_t)CAP * D, (size_t)D * DE, (size_t)CAP * DE);
            nv::silu_mul<<<g1((size_t)NE * CAP * DE), 256, 0, stream>>>(ga, gb, (size_t)NE * CAP * DE);
            nv::gemm_f32<<<dim3(D / 64, CAP / 64, NE), 256, 0, stream>>>(ga, w_down, ye + (size_t)b * NE * CAP * D, DE, DE, D, D, (size_t)CAP * DE, (size_t)DE * D, (size_t)CAP * D);
        }
    }
    if (KOPT < 8) {
        if (KOPT == 7) nv::combine_bf16<<<T, 256, 0, stream>>>(out, (const unsigned short*)(ws + WS_XE), slot_of);
        else nv::combine<<<T, 256, 0, stream>>>(out, ye, gates, slot_of);
    }
    if (KOPT < 9) {
        nv::rmsnorm_rows<<<T, 256, 0, stream>>>(out, norm_ple, xn, D);
        nv::gemm_f32<<<dim3(D / 64, T / 64, 1), 256, 0, stream>>>(xn, w_ple_gate, mix, D, D, D, D, 0, 0, 0);
        float* eraw = ye;
        nv::gemm_f32<<<dim3(D / 64, T / 64, 1), 256, 0, stream>>>(p, w_ple_proj, eraw, PD, PD, D, D, 0, 0, 0);
        nv::rmsnorm_rows<<<T, 256, 0, stream>>>(eraw, norm_ple_post, xn, D);
        nv::ple_final<<<g1((size_t)T * D), 256, 0, stream>>>(out, mix, xn, (size_t)T * D);
    }
#endif
}
```

```cpp
#include <hip/hip_runtime.h>
#include <cstdio>
#include <cstdint>

namespace cfg {
constexpr int D = 1024, B = 8, S = 2048, T = B * S;
constexpr int GW = 64, ROWS = S / GW;
constexpr int PW = 512, PG = 128, AH = 8, HD = 64, NE = 16, CAP = 256, DE = 2048, PD = 256;
constexpr float EPS = 1e-6f;
}
using namespace cfg;

namespace nv {
__global__ void __launch_bounds__(256) rmsnorm_rows(const float* __restrict__ x, const float* __restrict__ g, float* __restrict__ out, int ncols) {
    __shared__ float red[256];
    const size_t row = blockIdx.x; const float* xr = x + row * ncols; float s = 0.f;
    for (int c = threadIdx.x; c < ncols; c += 256) { const float v = xr[c]; s += v * v; }
    red[threadIdx.x] = s; __syncthreads();
    for (int o = 128; o > 0; o >>= 1) { if ((int)threadIdx.x < o) red[threadIdx.x] += red[threadIdx.x + o]; __syncthreads(); }
    const float rstd = 1.0f / sqrtf(red[0] / (float)ncols + EPS);
    for (int c = threadIdx.x; c < ncols; c += 256) out[row * ncols + c] = xr[c] * rstd * g[c];
}
__global__ void __launch_bounds__(256) gemm_f32(const float* __restrict__ A, const float* __restrict__ Bm, float* __restrict__ C, int K, int lda, int ldb, int ldc, size_t sA, size_t sB, size_t sC) {
    __shared__ float As[16][65]; __shared__ float Bs[16][64];
    const int z = blockIdx.z; A += z * sA; Bm += z * sB; C += z * sC;
    const int m0 = blockIdx.y * 64, n0 = blockIdx.x * 64, tx = threadIdx.x & 15, ty = threadIdx.x >> 4;
    float acc[4][4] = {};
    for (int k0 = 0; k0 < K; k0 += 16) {
        for (int i = threadIdx.x; i < 1024; i += 256) { const int r = i >> 4, c = i & 15; As[c][r] = A[(size_t)(m0 + r) * lda + k0 + c]; }
        for (int i = threadIdx.x; i < 1024; i += 256) { const int r = i >> 6, c = i & 63; Bs[r][c] = Bm[(size_t)(k0 + r) * ldb + n0 + c]; }
        __syncthreads();
#pragma unroll
        for (int k = 0; k < 16; ++k) { float a[4], b[4];
#pragma unroll
            for (int i = 0; i < 4; ++i) { a[i] = As[k][ty * 4 + i]; b[i] = Bs[k][tx * 4 + i]; }
#pragma unroll
            for (int i = 0; i < 4; ++i)
#pragma unroll
                for (int j = 0; j < 4; ++j) acc[i][j] += a[i] * b[j]; }
        __syncthreads();
    }
#pragma unroll
    for (int i = 0; i < 4; ++i)
#pragma unroll
        for (int j = 0; j < 4; ++j) C[(size_t)(m0 + ty * 4 + i) * ldc + n0 + tx * 4 + j] = acc[i][j];
}
__global__ void __launch_bounds__(256) pool_diff(const float* __restrict__ z, float* __restrict__ d) {
    const size_t i = (size_t)blockIdx.x * 256 + threadIdx.x; if (i >= (size_t)T * PW) return;
    const int c = (int)(i % PW); const int tok = (int)(i / PW), b = tok / S, t = tok % S; const int gi = c / PG; const int w = 2 << gi;
    int lo = t - w / 2; if (lo < 0) lo = 0; int hi = t + (w - w / 2) - 1; if (hi > S - 1) hi = S - 1;
    float s = 0.f; for (int q = lo; q <= hi; ++q) s += z[((size_t)b * S + q) * 2048 + c];
    d[i] = s / (float)(hi - lo + 1) - z[(size_t)tok * 2048 + c];
}
__global__ void __launch_bounds__(256) scale_cols(float* __restrict__ y, int ld, int ncols, const float* __restrict__ sc, size_t n) {
    const size_t i = (size_t)blockIdx.x * 256 + threadIdx.x; if (i >= n) return; const int c = (int)(i % ncols); const size_t r = i / ncols; y[r * ld + c] *= sc[c];
}
__global__ void __launch_bounds__(128) natten(const float* __restrict__ z, const float* __restrict__ qn, const float* __restrict__ kn, const float* __restrict__ rpb, float* __restrict__ mix) {
    __shared__ float qs[64]; __shared__ float ps[128]; __shared__ float red[128];
    const int tok = blockIdx.x >> 3, h = blockIdx.x & 7, b = tok / S, t = tok % S, r = t / GW, c = t % GW, j = threadIdx.x;
    int rs = r - 4; if (rs < 0) rs = 0; if (rs > ROWS - 8) rs = ROWS - 8;
    int cs = c - 8; if (cs < 0) cs = 0; if (cs > GW - 16) cs = GW - 16;
    if (j < 64) qs[j] = z[(size_t)tok * 2048 + 512 + h * 64 + j];
    __syncthreads();
    float qss = 0.f; for (int d = 0; d < 64; ++d) qss += qs[d] * qs[d];
    const float rq = 1.0f / sqrtf(qss / 64.f + EPS);
    const int i = j >> 4, jj = j & 15; const int kt = b * S + (rs + i) * GW + cs + jj;
    const float* kr = z + (size_t)kt * 2048 + 1024 + h * 64;
    float kss = 0.f, dot = 0.f;
    for (int d = 0; d < 64; ++d) { const float kv = kr[d]; kss += kv * kv; dot += (qs[d] * rq * qn[d] * 0.125f) * (kv * kn[d]); }
    const float rk = 1.0f / sqrtf(kss / 64.f + EPS);
    const int dr = rs + i - r + 7, dc = cs + jj - c + 15;
    const float sc = dot * rk + rpb[(h * 15 + dr) * 31 + dc];
    red[j] = sc; __syncthreads();
    for (int o = 64; o > 0; o >>= 1) { if (j < o) red[j] = fmaxf(red[j], red[j + o]); __syncthreads(); }
    const float mx = red[0]; __syncthreads();
    const float p = expf(sc - mx); ps[j] = p; red[j] = p; __syncthreads();
    for (int o = 64; o > 0; o >>= 1) { if (j < o) red[j] += red[j + o]; __syncthreads(); }
    const float inv = 1.0f / red[0];
    if (j < 64) { float o = 0.f;
        for (int q = 0; q < 128; ++q) { const int vt = b * S + (rs + (q >> 4)) * GW + cs + (q & 15); o += ps[q] * z[(size_t)vt * 2048 + 1536 + h * 64 + j]; }
        mix[(size_t)tok * 1024 + 512 + h * 64 + j] = o * inv; }
}
__global__ void __launch_bounds__(256) add_to(float* __restrict__ o, const float* __restrict__ a, const float* __restrict__ b, size_t n) {
    const size_t i = (size_t)blockIdx.x * 256 + threadIdx.x; if (i < n) o[i] = a[i] + b[i];
}
__global__ void __launch_bounds__(256) router(const float* __restrict__ h2, const float* __restrict__ wr, float* __restrict__ aff) {
    __shared__ float red[16][256];
    const int tok = blockIdx.x; float acc[16] = {};
    for (int d = threadIdx.x; d < D; d += 256) { const float v = h2[(size_t)tok * D + d];
#pragma unroll
        for (int e = 0; e < 16; ++e) acc[e] += v * wr[d * 16 + e]; }
#pragma unroll
    for (int e = 0; e < 16; ++e) red[e][threadIdx.x] = acc[e];
    __syncthreads();
    for (int o = 128; o > 0; o >>= 1) { if ((int)threadIdx.x < o) { for (int e = 0; e < 16; ++e) red[e][threadIdx.x] += red[e][threadIdx.x + o]; } __syncthreads(); }
    if (threadIdx.x < 16) { float mx = -1e30f; for (int e = 0; e < 16; ++e) mx = fmaxf(mx, red[e][0]); float sum = 0.f; for (int e = 0; e < 16; ++e) sum += expf(red[e][0] - mx);
        const int e = threadIdx.x, b = tok / S, s = tok % S; aff[((size_t)b * NE + e) * S + s] = expf(red[e][0] - mx) / sum; }
}
__global__ void __launch_bounds__(1024) topk(const float* __restrict__ aff, int* __restrict__ idx, float* __restrict__ gates, int* __restrict__ slot_of) {
    __shared__ float v[S];
    const int be = blockIdx.x, b = be / NE, e = be % NE;
    for (int i = threadIdx.x; i < S; i += 1024) v[i] = aff[(size_t)be * S + i];
    __syncthreads();
    for (int i = threadIdx.x; i < S; i += 1024) { const float vi = v[i]; int rank = 0;
        for (int q = 0; q < S; ++q) { const float vq = v[q]; rank += (vq > vi || (vq == vi && q < i)) ? 1 : 0; }
        if (rank < CAP) { idx[be * CAP + rank] = i; gates[be * CAP + rank] = vi; }
        slot_of[((size_t)b * S + i) * NE + e] = rank < CAP ? rank : -1; }
}
__global__ void __launch_bounds__(256) gather_rows(const float* __restrict__ h2, const int* __restrict__ idx, float* __restrict__ xe) {
    const int slot = blockIdx.x; const int be = slot / CAP, b = be / NE; const int tok = b * S + idx[slot];
    for (int c = threadIdx.x; c < D; c += 256) xe[(size_t)slot * D + c] = h2[(size_t)tok * D + c];
}
__global__ void __launch_bounds__(256) silu_mul(float* __restrict__ a, const float* __restrict__ bb, size_t n) {
    const size_t i = (size_t)blockIdx.x * 256 + threadIdx.x; if (i < n) { const float x = a[i]; a[i] = x / (1.0f + expf(-x)) * bb[i]; }
}
__global__ void __launch_bounds__(256) combine(float* __restrict__ x, const float* __restrict__ ye, const float* __restrict__ gates, const int* __restrict__ slot_of) {
    const int tok = blockIdx.x, b = tok / S;
    for (int c = threadIdx.x; c < D; c += 256) { float acc = x[(size_t)tok * D + c];
        for (int e = 0; e < NE; ++e) { const int sl = slot_of[(size_t)tok * NE + e]; if (sl >= 0) { const int slot = (b * NE + e) * CAP + sl; acc += ye[(size_t)slot * D + c] * gates[slot]; } }
        x[(size_t)tok * D + c] = acc; }
}
__global__ void __launch_bounds__(256) ple_final(float* __restrict__ x, const float* __restrict__ glog, const float* __restrict__ en, size_t n) {
    const size_t i = (size_t)blockIdx.x * 256 + threadIdx.x; if (i < n) { const float g = 1.0f / (1.0f + expf(-glog[i])); x[i] = x[i] + g * en[i]; }
}
}

#define MODE 0
#define GAS __attribute__((address_space(1)))
#define LAS __attribute__((address_space(3)))
typedef unsigned short bf16_t;
typedef short bf16x8 __attribute__((ext_vector_type(8)));
typedef float f32x4 __attribute__((ext_vector_type(4)));
typedef float f32x2 __attribute__((ext_vector_type(2)));
typedef unsigned u32x4 __attribute__((ext_vector_type(4)));
typedef unsigned u32x2 __attribute__((ext_vector_type(2)));
typedef __bf16 bf16x2_t __attribute__((ext_vector_type(2)));

__device__ __forceinline__ unsigned pkbf(float lo, float hi) { f32x2 v = {lo, hi}; bf16x2_t b = __builtin_convertvector(v, bf16x2_t); return __builtin_bit_cast(unsigned, b); }
__device__ __forceinline__ float bf2f(unsigned short u) { return __builtin_bit_cast(float, (unsigned)u << 16); }
__device__ __forceinline__ float bflo(unsigned u) { return __builtin_bit_cast(float, u << 16); }
__device__ __forceinline__ float bfhi(unsigned u) { return __builtin_bit_cast(float, u & 0xffff0000u); }
__device__ __forceinline__ float wave_sum(float v) {
#pragma unroll
    for (int o = 1; o < 64; o <<= 1) v += __shfl_xor(v, o);
    return v;
}
constexpr float LOG2E = 1.4426950408889634f;

namespace pg8 {
constexpr int BM = 256, BK = 64, HALF = 128, HTB = HALF * BK * 2, STAGE_BYTES = 8 * HTB;
__host__ __device__ __forceinline__ int lds_byte(int r, int c) { const int st = (r >> 4) * 2 + (c >> 5), rr = r & 15, cc = c & 31, ob = rr * 64 + cc * 2; return st * 1024 + (ob ^ (((ob >> 9) & 1) << 5)); }
__host__ __device__ __forceinline__ void stage_rc(int b, int& R, int& C) { const int st = b / 1024, sb = b % 1024, swz = sb ^ (((sb >> 9) & 1) << 5); R = (st >> 1) * 16 + swz / 64; C = (st & 1) * 32 + (swz % 64) / 2; }
__host__ __device__ __forceinline__ int perm32(int rho) { const int n = rho >> 4, i = rho & 15; return 8 * (i >> 2) + 4 * n + (i & 3); }

struct Unit { int arow, brow, pm, pn, grp; };
struct Gemm { const bf16_t* A; const bf16_t* Bt; int K; };

struct StaticOrder {
    int nM, nN, nwg, G, c;
    __device__ void init(int M, int N, int G_, int c_) { nM = M / BM; nN = N / BM; nwg = nM * nN; G = G_; c = c_; }
    __device__ bool next(int i, Unit& u) const {
        const long L = (long)i * G + c; if (L >= nwg) return false;
        int wgid = (int)L; { const int q = nwg / 8, r = nwg % 8, xcd = wgid % 8, off = wgid / 8; wgid = (xcd < r ? xcd * (q + 1) : r * (q + 1) + (xcd - r) * q) + off; }
        const int nig = 8 * nN, gid = wgid / nig, fm = gid * 8, gsz = (nM - fm) < 8 ? (nM - fm) : 8;
        u.pm = fm + ((wgid % nig) % gsz); u.pn = (wgid % nig) / gsz; u.arow = u.pm * BM; u.brow = u.pn * BM; u.grp = 0; return true;
    }
};

template <class Epi, class Sched>
__device__ __forceinline__ void gemm_phase(LAS unsigned char* lds, const Gemm g, const Sched& S, const Epi& E) {
    const int tid = threadIdx.x, wid = __builtin_amdgcn_readfirstlane(tid >> 6), lane = tid & 63, wr = wid >> 2, wc = wid & 3, fr = lane & 15, fq = lane >> 4;
    int K = g.K; asm volatile("" : "+s"(K));
    const int nt = K / BK;
    unsigned voffA[2], voffB[2];
#pragma unroll
    for (int i = 0; i < 2; ++i) { int R, C; stage_rc(tid * 16 + i * 8192, R, C); const int Rb = 64 * (R >> 5) + perm32(R & 31);
        voffA[i] = (unsigned)(R * K + C) * 2u; voffB[i] = (unsigned)(Rb * K + C) * 2u; }
    const unsigned kstep = (unsigned)(BK * 2);
    const unsigned hstep = (unsigned)HALF * K * 2;
    const unsigned hstepB = (unsigned)32 * K * 2;
    const unsigned rstep = (unsigned)K * 2;
    const unsigned ldsw = (unsigned)wid * 1024u;
    const int aoff = lds_byte(wr * 64 + fr, fq * 8), boff = lds_byte(wc * 32 + fr, fq * 8);
#define PG8_SA(b, h) (((b) * 2 + (h)) * HTB)
#define PG8_SB(b, h) ((4 + (b) * 2 + (h)) * HTB)
#define PG8_STAGE(bufoff, gbase, voff) do { _Pragma("unroll") for (int _i = 0; _i < 2; ++_i) \
        __builtin_amdgcn_global_load_lds((const unsigned*)((const char*)(gbase) + (voff)[_i]), (LAS unsigned*)(lds + (bufoff) + ldsw + _i * 8192), 16, 0, 0); } while (0)
#define PG8_LDA(dst, b, h) do { _Pragma("unroll") for (int m = 0; m < 4; ++m) _Pragma("unroll") for (int k = 0; k < 2; ++k) dst[m][k] = *(const LAS bf16x8*)(lds + PG8_SA(b, h) + aoff + m * 2048 + k * 1024); } while (0)
#define PG8_LDB(dst, b, h) do { _Pragma("unroll") for (int n = 0; n < 2; ++n) _Pragma("unroll") for (int k = 0; k < 2; ++k) dst[n][k] = *(const LAS bf16x8*)(lds + PG8_SB(b, h) + boff + n * 2048 + k * 1024); } while (0)
#define PG8_MMA(ai, bj, At, Bt) do { __builtin_amdgcn_s_setprio(1); _Pragma("unroll") for (int m = 0; m < 4; ++m) _Pragma("unroll") for (int n = 0; n < 2; ++n) _Pragma("unroll") for (int k = 0; k < 2; ++k) \
        acc[ai][bj][m][n] = __builtin_amdgcn_mfma_f32_16x16x32_bf16(Bt[n][k], At[m][k], acc[ai][bj][m][n], 0, 0, 0); __builtin_amdgcn_s_setprio(0); } while (0)
#define PG8_WAIT_V(n) asm volatile("s_waitcnt vmcnt(" #n ")" ::: "memory")
#define PG8_WAIT_L(n) asm volatile("s_waitcnt lgkmcnt(" #n ")" ::: "memory")
#define PG8_BAR __builtin_amdgcn_s_barrier()
#define PG8_SCHED __builtin_amdgcn_sched_barrier(0)
    Unit cur, nxt; int ui = 0;
    if (!S.next(0, cur)) return;
    f32x4 acc[2][2][4][2];
#pragma unroll
    for (int a = 0; a < 2; ++a)
#pragma unroll
        for (int b = 0; b < 2; ++b)
#pragma unroll
            for (int m = 0; m < 4; ++m)
#pragma unroll
                for (int n = 0; n < 2; ++n) acc[a][b][m][n] = (f32x4){0.f, 0.f, 0.f, 0.f};
    bf16x8 At[4][2], B0[2][2], B1[2][2];
    const char* cA = (const char*)g.A + (size_t)cur.arow * rstep; const char* cB = (const char*)g.Bt + (size_t)cur.brow * rstep;
    PG8_STAGE(PG8_SB(0, 0), cB, voffB); PG8_STAGE(PG8_SB(0, 1), cB + hstepB, voffB); PG8_STAGE(PG8_SA(0, 0), cA, voffA); PG8_STAGE(PG8_SA(0, 1), cA + hstep, voffA);
    if (wr == 1) PG8_BAR;
    PG8_WAIT_V(2); PG8_BAR;
    PG8_STAGE(PG8_SB(1, 0), cB + kstep, voffB); PG8_STAGE(PG8_SA(1, 0), cA + kstep, voffA); PG8_STAGE(PG8_SB(1, 1), cB + hstepB + kstep, voffB);
    PG8_WAIT_V(6); PG8_BAR;
    for (;;) {
        const bool has_next = S.next(ui + 1, nxt);
        const char* nA = has_next ? (const char*)g.A + (size_t)nxt.arow * rstep : cA; const char* nB = has_next ? (const char*)g.Bt + (size_t)nxt.brow * rstep : cB;
        for (int t = 0; t < nt; t += 2) {
            const bool last = (t == nt - 2);
            const char* a1 = cA + (unsigned)(t + 1) * kstep;
            const char* a2 = last ? nA : cA + (unsigned)(t + 2) * kstep; const char* b2 = last ? nB : cB + (unsigned)(t + 2) * kstep;
            const char* a3 = a2 + kstep; const char* b3 = b2 + kstep;
            PG8_LDB(B0, 0, 0); PG8_LDB(B1, 0, 1); PG8_SCHED; PG8_LDA(At, 0, 0); PG8_STAGE(PG8_SA(1, 1), a1 + hstep, voffA);
            PG8_WAIT_V(8); PG8_WAIT_L(0); PG8_BAR; PG8_MMA(0, 0, At, B0); PG8_MMA(0, 1, At, B1); PG8_BAR; PG8_SCHED;
            PG8_LDA(At, 0, 1); PG8_STAGE(PG8_SB(0, 0), b2, voffB); PG8_STAGE(PG8_SB(0, 1), b2 + hstepB, voffB); PG8_STAGE(PG8_SA(0, 0), a2, voffA);
            PG8_WAIT_V(8); PG8_WAIT_L(0); PG8_BAR; PG8_MMA(1, 0, At, B0); PG8_MMA(1, 1, At, B1); PG8_BAR; PG8_SCHED;
            PG8_LDB(B0, 1, 0); PG8_LDB(B1, 1, 1); PG8_SCHED; PG8_LDA(At, 1, 0); PG8_STAGE(PG8_SA(0, 1), a2 + hstep, voffA);
            PG8_WAIT_V(8); PG8_WAIT_L(0); PG8_BAR; PG8_MMA(0, 0, At, B0); PG8_MMA(0, 1, At, B1); PG8_BAR; PG8_SCHED;
            PG8_LDA(At, 1, 1); PG8_STAGE(PG8_SB(1, 0), b3, voffB); PG8_STAGE(PG8_SB(1, 1), b3 + hstepB, voffB); PG8_STAGE(PG8_SA(1, 0), a3, voffA);
            PG8_WAIT_V(8); PG8_WAIT_L(0); PG8_BAR; PG8_MMA(1, 0, At, B0); PG8_MMA(1, 1, At, B1); PG8_BAR; PG8_SCHED;
        }
        if (wr == 0) PG8_BAR;
        E(acc, cur, wr, wc, fr, fq);
        if (!has_next) break;
#pragma unroll
        for (int a = 0; a < 2; ++a)
#pragma unroll
            for (int b = 0; b < 2; ++b)
#pragma unroll
                for (int m = 0; m < 4; ++m)
#pragma unroll
                    for (int n = 0; n < 2; ++n) acc[a][b][m][n] = (f32x4){0.f, 0.f, 0.f, 0.f};
        cur = nxt; cA = nA; cB = nB; ++ui;
        if (wr == 1) PG8_BAR;
    }
    PG8_WAIT_V(0);
    PG8_BAR;
#undef PG8_SA
#undef PG8_SB
#undef PG8_STAGE
#undef PG8_LDA
#undef PG8_LDB
#undef PG8_MMA
#undef PG8_WAIT_V
#undef PG8_WAIT_L
#undef PG8_BAR
#undef PG8_SCHED
}
}

constexpr size_t MiB = (size_t)1 << 20;
constexpr size_t WS_CTL = 0, CTL_ZERO_BYTES = 64 * 1024;
constexpr size_t WS_WIN = 4 * MiB, WS_WOUT = 8 * MiB, WS_WPG = 10 * MiB, WS_WPP = 12 * MiB, WS_WPOOL = 12 * MiB + 512 * 1024;
constexpr size_t WS_WGU = 16 * MiB, WS_WD = 144 * MiB;
constexpr size_t WS_HH = 208 * MiB;
constexpr size_t WS_U = 208 * MiB, WS_Q = 224 * MiB, WS_K = 240 * MiB, WS_VT = 256 * MiB, WS_MIX = 272 * MiB, WS_XN = 304 * MiB;
constexpr size_t WS_PB = 336 * MiB, WS_EB = 344 * MiB, WS_H2 = 376 * MiB  , WS_XE = 408 * MiB  ;
constexpr size_t WS_AFF = 480 * MiB, WS_GATES = 481 * MiB, WS_SLOT = 482 * MiB, WS_ESQ = 483 * MiB, WS_RSTDE = 484 * MiB;
constexpr size_t WS_MEGA_END = 485 * MiB;
constexpr int CW_BAR = 1024;

constexpr int RING_BYTES = 131072, LDS_BYTES = 163840, LDSCTL_OFF = LDS_BYTES - 512, MISC_OFF = LDSCTL_OFF + 320;

#define XB_TMO      128
#define XB_XCNT(j)  (256  + 64 * (j))
#define XB_XSUB(j)  (1280 + 64 * (j))
#define XB_XGEN(j)  (2304 + 64 * (j))
#define XB_TOP      3328
#define XB_TOPGEN   3392
#define XCD_BAR_WORDS 3456
#define XB_SPIN_CAP (1u << 18)
__device__ __forceinline__ unsigned xb_ld(unsigned* p)              { return __hip_atomic_load(p, __ATOMIC_RELAXED, __HIP_MEMORY_SCOPE_AGENT); }
__device__ __forceinline__ unsigned xb_add(unsigned* p, unsigned v) { return __hip_atomic_fetch_add(p, v, __ATOMIC_RELAXED, __HIP_MEMORY_SCOPE_AGENT); }
__device__ __forceinline__ unsigned xb_xcc_id() { return (unsigned)__builtin_amdgcn_s_getreg((3 << 11) | 20) & 0xFu; }
#define XB_SPIN(cond, bar) do { unsigned _sp = 0; while (cond) { __builtin_amdgcn_s_sleep(1); \
    if ((++_sp & 255u) == 0u) { if (xb_ld(&(bar)[XB_TMO])) break; if (_sp > XB_SPIN_CAP) { atomicAdd(&(bar)[XB_TMO], 1u); break; } } } } while (0)
__device__ __forceinline__ void xcd_barrier_post(unsigned* bar) { if (threadIdx.x == 0) (void)xb_add(&bar[XB_XCNT(xb_xcc_id())], 1u); }
__device__ __forceinline__ void xcd_barrier_complete(unsigned* bar, unsigned x, unsigned& nloc, unsigned& nx) {
    const unsigned G = gridDim.x * gridDim.y * gridDim.z;
    unsigned sum, cnt, mine, sp = 0u;
    for (;;) {
        sum = 0u; cnt = 0u; mine = 0u;
#pragma unroll
        for (unsigned j = 0; j < 16; ++j) { const unsigned c = xb_ld(&bar[XB_XCNT(j)]); sum += c; cnt += (c > 0u) ? 1u : 0u; mine = (j == x) ? c : mine; }
        if (sum == G) break;
        __builtin_amdgcn_s_sleep(1);
        if ((++sp & 255u) == 0u) { if (xb_ld(&bar[XB_TMO])) break; if (sp > XB_SPIN_CAP) { atomicAdd(&bar[XB_TMO], 1u); break; } }
    }
    nloc = mine > 0u ? mine : 1u; nx = cnt > 0u ? cnt : 1u;
}
__device__ __forceinline__ void xcd_barrier(unsigned* bar, volatile LAS unsigned* st) {
    asm volatile("s_waitcnt vmcnt(0)" ::: "memory");
    __syncthreads();
    if (threadIdx.x == 0) {
        const unsigned x = xb_xcc_id();
        __builtin_amdgcn_s_waitcnt(0);
        unsigned nloc = st[0], nx = st[1];
        if (nloc == 0u) { xcd_barrier_complete(bar, x, nloc, nx); st[0] = nloc; st[1] = nx; }
        const unsigned old = xb_add(&bar[XB_XSUB(x)], 1u);
        const unsigned gen = old / nloc;
        if (old + 1u == (gen + 1u) * nloc) {
            __builtin_amdgcn_fence(__ATOMIC_RELEASE, "agent");
            asm volatile("s_waitcnt vmcnt(0)" ::: "memory");
            const unsigned og = xb_add(&bar[XB_TOP], 1u);
            const unsigned tg = og / nx;
            if (og + 1u == (tg + 1u) * nx) xb_add(&bar[XB_TOPGEN], 1u);
            else XB_SPIN(xb_ld(&bar[XB_TOPGEN]) == tg, bar);
            __builtin_amdgcn_fence(__ATOMIC_ACQUIRE, "agent");
            xb_add(&bar[XB_XGEN(x)], 1u);
            asm volatile("s_waitcnt vmcnt(0)" ::: "memory");
        } else {
            XB_SPIN(xb_ld(&bar[XB_XGEN(x)]) == gen, bar);
            __builtin_amdgcn_fence(__ATOMIC_ACQUIRE, "agent");
            asm volatile("s_waitcnt vmcnt(0)" ::: "memory");
        }
    }
    __syncthreads();
}

struct MArgs { const float* in[19]; float* out; unsigned char* ws; int ph_lo, ph_hi; };
struct Frame {
    LAS unsigned char* lds; int tid, lane, wave, vcu, G;
    float* out; unsigned char* ws; const MArgs* a;
};
#define F_x (F.a->in[0])
#define F_p (F.a->in[1])
#define F_norm_mix (F.a->in[2])
#define F_w_in (F.a->in[3])
#define F_w_pool (F.a->in[4])
#define F_pool_scale (F.a->in[5])
#define F_q_norm (F.a->in[6])
#define F_k_norm (F.a->in[7])
#define F_rpb (F.a->in[8])
#define F_w_out (F.a->in[9])
#define F_norm_ffn (F.a->in[10])
#define F_w_router (F.a->in[11])
#define F_w_gate (F.a->in[12])
#define F_w_up (F.a->in[13])
#define F_w_down (F.a->in[14])
#define F_norm_ple (F.a->in[15])
#define F_w_ple_gate (F.a->in[16])
#define F_w_ple_proj (F.a->in[17])
#define F_norm_ple_post (F.a->in[18])
#define WSP(T, off) ((T*)(F.ws + (off)))

__device__ __forceinline__ void tr_item(const float* W, int K, int N, bf16_t* WT, int kb, int nb, int dst_row0, LAS float* scr, int lane) {
    const int k0 = 64 * kb, n0 = 32 * nb;
#pragma unroll 8
    for (int i = 0; i < 32; ++i) { const int kk = 2 * i + (lane >> 5); scr[kk * 33 + (lane & 31)] = W[(size_t)(k0 + kk) * N + n0 + (lane & 31)]; }
    asm volatile("s_waitcnt lgkmcnt(0)" ::: "memory");
    const int c = lane & 7;
#pragma unroll
    for (int j = 0; j < 4; ++j) { const int n = (lane >> 3) + 8 * j; const LAS float* s = scr + (8 * c) * 33 + n;
        u32x4 o; o.x = pkbf(s[0 * 33], s[1 * 33]); o.y = pkbf(s[2 * 33], s[3 * 33]); o.z = pkbf(s[4 * 33], s[5 * 33]); o.w = pkbf(s[6 * 33], s[7 * 33]);
        *(u32x4*)(WT + (size_t)(dst_row0 + n) * K + k0 + 8 * c) = o; }
    asm volatile("s_waitcnt lgkmcnt(0)" ::: "memory");
}
__device__ __forceinline__ void rms_row_to_bf16(const float* xrow, const float* g, bf16_t* orow, int lane) {
    const f32x4* xr = (const f32x4*)xrow + lane; const f32x4* gr = (const f32x4*)g + lane;
    f32x4 v[4]; float s = 0.f;
#pragma unroll
    for (int j = 0; j < 4; ++j) { v[j] = xr[64 * j]; s += (v[j].x * v[j].x + v[j].y * v[j].y) + (v[j].z * v[j].z + v[j].w * v[j].w); }
    const float rstd = 1.0f / sqrtf(wave_sum(s) * (1.0f / D) + EPS);
    u32x2* o8 = (u32x2*)orow + lane;
#pragma unroll
    for (int j = 0; j < 4; ++j) { const f32x4 gg = gr[64 * j]; u32x2 o; o.x = pkbf(v[j].x * rstd * gg.x, v[j].y * rstd * gg.y); o.y = pkbf(v[j].z * rstd * gg.z, v[j].w * rstd * gg.w); o8[64 * j] = o; }
}
__device__ __forceinline__ void p0_prologue(Frame& F) {
    LAS float* scr = (LAS float*)(F.lds + F.wave * 16384);
    const int gw = F.vcu * 8 + F.wave, NGW = F.G * 8;
    constexpr int I_IN = 16 * 64, I_OUT = 16 * 32, I_PG = 16 * 32, I_PP = 4 * 32, I_E = 1024;
    constexpr int NSMALL = I_IN + I_OUT + I_PG + I_PP, NITEMS = NSMALL + 3 * 16 * I_E;
    bf16_t* Win_t = WSP(bf16_t, WS_WIN); bf16_t* Wout_t = WSP(bf16_t, WS_WOUT); bf16_t* Wpg_t = WSP(bf16_t, WS_WPG); bf16_t* Wpp_t = WSP(bf16_t, WS_WPP);
    bf16_t* Wgu_t = WSP(bf16_t, WS_WGU); bf16_t* Wd_t = WSP(bf16_t, WS_WD);
    for (int it = gw; it < NITEMS; it += NGW) {
        int r = it;
        if (r < I_IN) { tr_item(F_w_in, 1024, 2048, Win_t, r / 64, r % 64, 32 * (r % 64), scr, F.lane); continue; } r -= I_IN;
        if (r < I_OUT) { tr_item(F_w_out, 1024, 1024, Wout_t, r / 32, r % 32, 32 * (r % 32), scr, F.lane); continue; } r -= I_OUT;
        if (r < I_PG) { tr_item(F_w_ple_gate, 1024, 1024, Wpg_t, r / 32, r % 32, 32 * (r % 32), scr, F.lane); continue; } r -= I_PG;
        if (r < I_PP) { tr_item(F_w_ple_proj, 256, 1024, Wpp_t, r / 32, r % 32, 32 * (r % 32), scr, F.lane); continue; } r -= I_PP;
        const int mat = r / (16 * I_E), e = (r / I_E) % 16, q = r % I_E;
        if (mat < 2) {
            const int kb = q / 64, nb = q % 64, n0 = 32 * nb;
            tr_item((mat == 0 ? F_w_gate : F_w_up) + (size_t)e * 1024 * 2048, 1024, 2048, Wgu_t, kb, nb, e * 4096 + (n0 >> 7) * 256 + ((n0 >> 5) & 3) * 64 + 32 * mat, scr, F.lane);
        } else {
            const int kb = q / 32, nb = q % 32;
            tr_item(F_w_down + (size_t)e * 2048 * 1024, 2048, 1024, Wd_t, kb, nb, e * 1024 + 32 * nb, scr, F.lane);
        }
    }
    bf16_t* XN = WSP(bf16_t, WS_XN);
    for (int m = gw; m < T; m += NGW) rms_row_to_bf16(F_x + (size_t)m * D, F_norm_mix, XN + (size_t)m * D, F.lane);
    { const int gt = F.vcu * 512 + F.tid, NT_ = F.G * 512; const f32x4* p4 = (const f32x4*)F_p; u32x2* o = WSP(u32x2, WS_PB);
      for (int i = gt; i < T * PD / 4; i += NT_) { const f32x4 v = p4[i]; u32x2 w; w.x = pkbf(v.x, v.y); w.y = pkbf(v.z, v.w); o[i] = w; }
      bf16_t* Wp = WSP(bf16_t, WS_WPOOL);
      for (int i = gt; i < 4 * 128 * 128; i += NT_) { const int gg = i >> 14, n = (i >> 7) & 127, k = i & 127; const float v = F_w_pool[(gg * 128 + k) * 128 + n] * F_pool_scale[gg * 128 + n]; Wp[i] = (bf16_t)(pkbf(v, 0.f) & 0xffffu); }
    }
}

typedef f32x4 AccT[2][2][4][2];
struct EpiQKV {
    bf16_t *U, *Q, *Kk, *VT; const float *qn, *kn;
    __device__ __forceinline__ void operator()(const AccT& acc, const pg8::Unit& u, int wr, int wc, int fr_, int fq_) const {
        int fr = fr_, fq = fq_; asm volatile("" : "+v"(fr), "+v"(fq));
        const int type = u.pn >> 1; const int row0 = u.pm * 256 + wr * 64 + fr;
        if (type == 0) {
#pragma unroll
            for (int ai = 0; ai < 2; ++ai)
#pragma unroll
                for (int m = 0; m < 4; ++m) { const int row = row0 + ai * 128 + m * 16; bf16_t* rp = U + (size_t)row * 512 + (u.pn & 1) * 256 + wc * 64 + 8 * fq;
#pragma unroll
                    for (int bj = 0; bj < 2; ++bj) { const f32x4 v0 = acc[ai][bj][m][0], v1 = acc[ai][bj][m][1]; u32x4 w; w.x = pkbf(v0[0], v0[1]); w.y = pkbf(v0[2], v0[3]); w.z = pkbf(v1[0], v1[1]); w.w = pkbf(v1[2], v1[3]); *(u32x4*)(rp + bj * 32) = w; } asm volatile("" ::: "memory"); }
        } else if (type == 3) {
            const int hh = (u.pn & 1) * 4 + wc;
#pragma unroll
            for (int ai = 0; ai < 2; ++ai)
#pragma unroll
                for (int m = 0; m < 4; ++m) { const int row = row0 + ai * 128 + m * 16; const int b = row >> 11, s = row & 2047; bf16_t* bp = VT + ((size_t)((b * 8 + hh) * 32 + (s >> 6)) * 64) * 64 + (s & 63);
#pragma unroll
                    for (int bj = 0; bj < 2; ++bj)
#pragma unroll
                        for (int n = 0; n < 2; ++n)
#pragma unroll
                            for (int i = 0; i < 4; ++i) { const int d = 32 * bj + 8 * fq + 4 * n + i; bp[d * 64] = (bf16_t)(pkbf(acc[ai][bj][m][n][i], 0.f) & 0xffffu); }
                    asm volatile("" ::: "memory"); }
        } else {
            const int hh = (u.pn & 1) * 4 + wc; const float* gn = (type == 1) ? qn : kn; const float sc = (type == 1) ? 0.125f * LOG2E : 1.0f; bf16_t* dst = (type == 1) ? Q : Kk;
            f32x4 gv[2][2];
#pragma unroll
            for (int bj = 0; bj < 2; ++bj)
#pragma unroll
                for (int n = 0; n < 2; ++n) gv[bj][n] = *(const f32x4*)(gn + 32 * bj + 8 * fq + 4 * n) * sc;
#pragma unroll
            for (int ai = 0; ai < 2; ++ai)
#pragma unroll
                for (int m = 0; m < 4; ++m) { const int row = row0 + ai * 128 + m * 16; const int b = row >> 11, s = row & 2047;
                    float ss = 0.f;
#pragma unroll
                    for (int bj = 0; bj < 2; ++bj)
#pragma unroll
                        for (int n = 0; n < 2; ++n) { const f32x4 v = acc[ai][bj][m][n]; ss += (v[0] * v[0] + v[1] * v[1]) + (v[2] * v[2] + v[3] * v[3]); }
                    ss += __shfl_xor(ss, 16); ss += __shfl_xor(ss, 32);
                    const float rstd = 1.0f / sqrtf(ss * (1.0f / 64.0f) + EPS);
                    bf16_t* rp = dst + ((size_t)(b * 8 + hh) * 2048 + s) * 64 + 8 * fq;
#pragma unroll
                    for (int bj = 0; bj < 2; ++bj) { const f32x4 v0 = acc[ai][bj][m][0] * gv[bj][0] * rstd, v1 = acc[ai][bj][m][1] * gv[bj][1] * rstd; u32x4 w; w.x = pkbf(v0[0], v0[1]); w.y = pkbf(v0[2], v0[3]); w.z = pkbf(v1[0], v1[1]); w.w = pkbf(v1[2], v1[3]); *(u32x4*)(rp + bj * 32) = w; } asm volatile("" ::: "memory"); }
        }
    }
};
struct EpiE {
    bf16_t* EB; float* esq;
    __device__ __forceinline__ void operator()(const AccT& acc, const pg8::Unit& u, int wr, int wc, int fr_, int fq_) const {
        int fr = fr_, fq = fq_; asm volatile("" : "+v"(fr), "+v"(fq));
        const int row0 = u.pm * 256 + wr * 64 + fr;
#pragma unroll
        for (int ai = 0; ai < 2; ++ai)
#pragma unroll
            for (int m = 0; m < 4; ++m) { const int row = row0 + ai * 128 + m * 16; bf16_t* rp = EB + (size_t)row * 1024 + u.pn * 256 + wc * 64 + 8 * fq; float ss = 0.f;
#pragma unroll
                for (int bj = 0; bj < 2; ++bj) { const f32x4 v0 = acc[ai][bj][m][0], v1 = acc[ai][bj][m][1];
                    ss += (v0[0] * v0[0] + v0[1] * v0[1]) + (v0[2] * v0[2] + v0[3] * v0[3]) + (v1[0] * v1[0] + v1[1] * v1[1]) + (v1[2] * v1[2] + v1[3] * v1[3]);
                    u32x4 w; w.x = pkbf(v0[0], v0[1]); w.y = pkbf(v0[2], v0[3]); w.z = pkbf(v1[0], v1[1]); w.w = pkbf(v1[2], v1[3]); *(u32x4*)(rp + bj * 32) = w; }
                ss += __shfl_xor(ss, 16); ss += __shfl_xor(ss, 32);
                if (fq == 0) esq[(size_t)row * 16 + u.pn * 4 + wc] = ss; asm volatile("" ::: "memory"); }
    }
};
struct EpiRes {
    const float* x; float* out;
    __device__ __forceinline__ void operator()(const AccT& acc, const pg8::Unit& u, int wr, int wc, int fr_, int fq_) const {
        int fr = fr_, fq = fq_; asm volatile("" : "+v"(fr), "+v"(fq));
        const int row0 = u.pm * 256 + wr * 64 + fr; const int col0 = u.pn * 256 + wc * 64 + 8 * fq;
#pragma unroll
        for (int ai = 0; ai < 2; ++ai)
#pragma unroll
            for (int m = 0; m < 4; ++m) { const size_t off = (size_t)(row0 + ai * 128 + m * 16) * 1024 + col0;
#pragma unroll
                for (int bj = 0; bj < 2; ++bj)
#pragma unroll
                    for (int n = 0; n < 2; ++n) { const f32x4 xv = *(const f32x4*)(x + off + bj * 32 + n * 4); *(f32x4*)(out + off + bj * 32 + n * 4) = xv + acc[ai][bj][m][n]; }
                if (m & 1) asm volatile("" ::: "memory"); }
    }
};
struct EpiGU {
    bf16_t* HH;
    __device__ __forceinline__ void operator()(const AccT& acc, const pg8::Unit& u, int wr, int wc, int fr_, int fq_) const {
        int fr = fr_, fq = fq_; asm volatile("" : "+v"(fr), "+v"(fq));
        const int row0 = u.arow + wr * 64 + fr; const int col0 = u.pn * 128 + wc * 32 + 8 * fq;
#pragma unroll
        for (int ai = 0; ai < 2; ++ai)
#pragma unroll
            for (int m = 0; m < 4; ++m) { float h[8];
#pragma unroll
                for (int n = 0; n < 2; ++n)
#pragma unroll
                    for (int i = 0; i < 4; ++i) { const float a = acc[ai][0][m][n][i], b = acc[ai][1][m][n][i]; h[4 * n + i] = a * __builtin_amdgcn_rcpf(1.0f + __builtin_amdgcn_exp2f(-LOG2E * a)) * b; }
                u32x4 w; w.x = pkbf(h[0], h[1]); w.y = pkbf(h[2], h[3]); w.z = pkbf(h[4], h[5]); w.w = pkbf(h[6], h[7]);
                *(u32x4*)(HH + (size_t)(row0 + ai * 128 + m * 16) * 2048 + col0) = w; }
    }
};
struct EpiDown {
    bf16_t* YE; const float* gates;
    __device__ __forceinline__ void operator()(const AccT& acc, const pg8::Unit& u, int wr, int wc, int fr_, int fq_) const {
        int fr = fr_, fq = fq_; asm volatile("" : "+v"(fr), "+v"(fq));
        const int row0 = u.arow + wr * 64 + fr; const int col0 = u.pn * 256 + wc * 64 + 8 * fq;
#pragma unroll
        for (int ai = 0; ai < 2; ++ai)
#pragma unroll
            for (int m = 0; m < 4; ++m) { const int row = row0 + ai * 128 + m * 16; const float gt = gates[row]; bf16_t* rp = YE + (size_t)row * 1024 + col0;
#pragma unroll
                for (int bj = 0; bj < 2; ++bj) { const f32x4 v0 = acc[ai][bj][m][0] * gt, v1 = acc[ai][bj][m][1] * gt; u32x4 w; w.x = pkbf(v0[0], v0[1]); w.y = pkbf(v0[2], v0[3]); w.z = pkbf(v1[0], v1[1]); w.w = pkbf(v1[2], v1[3]); *(u32x4*)(rp + bj * 32) = w; } }
    }
};
struct EpiFinal {
    float* out; const bf16_t* EB; const float* rstde; const float* gpost;
    __device__ __forceinline__ void operator()(const AccT& acc, const pg8::Unit& u, int wr, int wc, int fr_, int fq_) const {
        int fr = fr_, fq = fq_; asm volatile("" : "+v"(fr), "+v"(fq));
        const int row0 = u.pm * 256 + wr * 64 + fr; const int col0 = u.pn * 256 + wc * 64 + 8 * fq;
        f32x4 gp[2][2];
#pragma unroll
        for (int bj = 0; bj < 2; ++bj)
#pragma unroll
            for (int n = 0; n < 2; ++n) gp[bj][n] = *(const f32x4*)(gpost + col0 + bj * 32 + n * 4);
#pragma unroll
        for (int ai = 0; ai < 2; ++ai)
#pragma unroll
            for (int m = 0; m < 4; ++m) { const int row = row0 + ai * 128 + m * 16; const size_t off = (size_t)row * 1024 + col0; const float re = rstde[row];
#pragma unroll
                for (int bj = 0; bj < 2; ++bj) { const u32x4 ev = *(const u32x4*)(EB + off + bj * 32);
                    const f32x4 e0 = (f32x4){bflo(ev.x), bfhi(ev.x), bflo(ev.y), bfhi(ev.y)} * gp[bj][0] * re, e1 = (f32x4){bflo(ev.z), bfhi(ev.z), bflo(ev.w), bfhi(ev.w)} * gp[bj][1] * re;
                    const f32x4 a0 = acc[ai][bj][m][0], a1 = acc[ai][bj][m][1]; f32x4 g0, g1;
#pragma unroll
                    for (int i = 0; i < 4; ++i) { g0[i] = __builtin_amdgcn_rcpf(1.0f + __builtin_amdgcn_exp2f(-LOG2E * a0[i])); g1[i] = __builtin_amdgcn_rcpf(1.0f + __builtin_amdgcn_exp2f(-LOG2E * a1[i])); }
                    const f32x4 x0 = *(const f32x4*)(out + off + bj * 32), x1 = *(const f32x4*)(out + off + bj * 32 + 4);
                    *(f32x4*)(out + off + bj * 32) = x0 + g0 * e0; *(f32x4*)(out + off + bj * 32 + 4) = x1 + g1 * e1; }
                asm volatile("" ::: "memory"); }
    }
};
struct OrderGU {
    int G, vcu;
    __device__ bool next(int i, pg8::Unit& u) const {
        int e, b, nt;
        if (G == 256) { if (i >= 8) return false; const int x = vcu >> 5, cu = vcu & 31; e = 2 * x + (i >> 2); b = cu & 7; nt = 4 * (i & 3) + (cu >> 3); }
        else { const int L = i * G + vcu; if (L >= 2048) return false; e = L >> 7; b = L & 7; nt = (L >> 3) & 15; }
        u.arow = (b * 16 + e) * 256; u.brow = e * 4096 + nt * 256; u.pm = b; u.pn = nt; u.grp = e; return true;
    }
};
struct OrderDown {
    int G, vcu;
    __device__ bool next(int i, pg8::Unit& u) const {
        int e, b, nt;
        if (G == 256) { if (i >= 2) return false; const int x = vcu >> 5, cu = vcu & 31; e = 2 * x + i; b = cu & 7; nt = cu >> 3; }
        else { const int L = i * G + vcu; if (L >= 512) return false; e = L >> 5; b = L & 7; nt = (L >> 3) & 3; }
        u.arow = (b * 16 + e) * 256; u.brow = e * 1024 + nt * 256; u.pm = b; u.pn = nt; u.grp = e; return true;
    }
};

constexpr int UT_OFF = 32768, UT_PITCH = 136, UT_ROWS = 272;
constexpr int AT_KOFF = 0, AT_VOFF = 9 * 8192, AT_B2OFF = 18 * 8192, AT_SCR = AT_B2OFF + 2048;
static_assert(AT_SCR + 2 * 17 * 64 * 4 <= LDSCTL_OFF, "attention LDS map");
__device__ __forceinline__ int at_fk(int row) { return ((row >> 1) & 1) | (((row >> 3) & 3) << 1); }
__device__ __forceinline__ int at_fv(int row) { return (row >> 1) & 7; }
__device__ __forceinline__ void attn_block(Frame& F, int bh, int r0) {
    const int tid = F.tid, lane = F.lane, g = lane >> 4, m = lane & 15, w = F.wave; const int b = bh >> 3, h = bh & 7;
    const int qb = (w == 0) ? 0 : (w <= 2) ? 1 : (w <= 4) ? 2 : 3; const int kp = (w == 0) ? 0 : (w == 5) ? 1 : ((w - 1) & 1); const bool active = w < 6;
    LAS float* b2 = (LAS float*)(F.lds + AT_B2OFF);
    for (int i = tid; i < 15 * 32; i += 512) { const int dc = i & 31; b2[i] = dc < 31 ? F_rpb[(h * 15 + (i >> 5)) * 31 + dc] * LOG2E : 0.f; }
    const int lrow = tid >> 3, lpos = tid & 7;
    const char* ksrc = (const char*)WSP(const bf16_t, WS_K) + ((size_t)bh * 2048 * 64 + (size_t)lrow * 64) * 2 + ((lpos ^ at_fk(lrow)) * 16);
    const char* vsrc = (const char*)WSP(const bf16_t, WS_VT) + ((size_t)bh * 32 * 4096 + (size_t)lrow * 64) * 2 + ((lpos ^ at_fv(lrow)) * 16);
#define AT_DMA(k) do { const int sl_ = (k) % 9; \
        __builtin_amdgcn_global_load_lds((const unsigned*)(ksrc + (size_t)(k) * 8192), (LAS unsigned*)(F.lds + AT_KOFF + sl_ * 8192 + w * 1024), 16, 0, 0); \
        __builtin_amdgcn_global_load_lds((const unsigned*)(vsrc + (size_t)(k) * 8192), (LAS unsigned*)(F.lds + AT_VOFF + sl_ * 8192 + w * 1024), 16, 0, 0); } while (0)
    int rs0 = r0 - 4; rs0 = rs0 < 0 ? 0 : (rs0 > ROWS - 8 ? ROWS - 8 : rs0);
    for (int k = rs0; k < rs0 + 8; ++k) AT_DMA(k);
    const int c = 16 * qb + m; int cs = c - 8; cs = cs < 0 ? 0 : (cs > GW - 16 ? GW - 16 : cs);
    const bf16_t* Qp = WSP(const bf16_t, WS_Q) + ((size_t)(bh * 2048 + 64 * r0 + c) * 64 + 8 * g);
    bf16x8 qn0 = *(const bf16x8*)Qp, qn1 = *(const bf16x8*)(Qp + 32);
    const int rowA = 32 * kp + 8 * (m >> 2) + (m & 3);
    const int kofs0 = rowA * 128 + ((g ^ at_fk(rowA)) * 16), kofs1 = rowA * 128 + (((4 + g) ^ at_fk(rowA)) * 16);
    const int vofs = m * 128 + (((4 * kp + g) ^ at_fv(m)) * 16);
    const int kc0 = 32 * kp + 8 * g;
    bf16_t* mixb = WSP(bf16_t, WS_MIX) + (size_t)(b * 2048) * 1024 + 512 + h * 64 + 4 * g + (size_t)c * 1024;
    LAS float* scr = (LAS float*)(F.lds + AT_SCR) + ((w - 1) >> 1) * (17 * 64) + lane;
    asm volatile("s_waitcnt vmcnt(0) lgkmcnt(0)" ::: "memory"); __syncthreads();
    for (int rr = 0; rr < 8; ++rr) {
        const int r = r0 + rr; int rs = r - 4; rs = rs < 0 ? 0 : (rs > ROWS - 8 ? ROWS - 8 : rs);
        int rsn = r - 3; rsn = rsn < 0 ? 0 : (rsn > ROWS - 8 ? ROWS - 8 : rsn);
        if (rr < 7 && rsn != rs) AT_DMA(rs + 8);
        f32x4 o[4]; float l = 0.f;
#pragma unroll
        for (int dt = 0; dt < 4; ++dt) o[dt] = (f32x4){0.f, 0.f, 0.f, 0.f};
        const bf16x8 q0 = qn0, q1 = qn1;
        if (active && rr < 7) { qn0 = *(const bf16x8*)(Qp + (size_t)(rr + 1) * 4096); qn1 = *(const bf16x8*)(Qp + (size_t)(rr + 1) * 4096 + 32); }
        for (int i = 0; i < 8; ++i) {
            if (i == 4) { asm volatile("s_waitcnt lgkmcnt(0)" ::: "memory"); __builtin_amdgcn_s_barrier(); asm volatile("" ::: "memory"); }
            if (active) {
                const int sl = (rs + i) % 9; const LAS unsigned char* kb_ = F.lds + AT_KOFF + sl * 8192; const LAS unsigned char* vb_ = F.lds + AT_VOFF + sl * 8192 + vofs;
                const bf16x8 ka0 = *(const LAS bf16x8*)(kb_ + kofs0), ka1 = *(const LAS bf16x8*)(kb_ + kofs1), kb0 = *(const LAS bf16x8*)(kb_ + kofs0 + 512), kb1 = *(const LAS bf16x8*)(kb_ + kofs1 + 512);
                bf16x8 vf[4];
#pragma unroll
                for (int dt = 0; dt < 4; ++dt) vf[dt] = *(const LAS bf16x8*)(vb_ + dt * 2048);
                f32x4 sa = (f32x4){0.f, 0.f, 0.f, 0.f}, sb = (f32x4){0.f, 0.f, 0.f, 0.f};
                sa = __builtin_amdgcn_mfma_f32_16x16x32_bf16(ka0, q0, sa, 0, 0, 0); sa = __builtin_amdgcn_mfma_f32_16x16x32_bf16(ka1, q1, sa, 0, 0, 0);
                sb = __builtin_amdgcn_mfma_f32_16x16x32_bf16(kb0, q0, sb, 0, 0, 0); sb = __builtin_amdgcn_mfma_f32_16x16x32_bf16(kb1, q1, sb, 0, 0, 0);
                const int dr = rs + i - r + 7; const LAS float* bp = b2 + (dr * 32 + 15 - c + kc0);
                float pa[4], pb[4];
#pragma unroll
                for (int q = 0; q < 4; ++q) { const bool va = (unsigned)(kc0 + q - cs) < 16u, vb = (unsigned)(kc0 + 4 + q - cs) < 16u;
                    const float ea = __builtin_amdgcn_exp2f(sa[q] + bp[q]), eb = __builtin_amdgcn_exp2f(sb[q] + bp[4 + q]); pa[q] = va ? ea : 0.f; pb[q] = vb ? eb : 0.f; }
                l += ((pa[0] + pa[1]) + (pa[2] + pa[3])) + ((pb[0] + pb[1]) + (pb[2] + pb[3]));
                u32x4 pw; pw.x = pkbf(pa[0], pa[1]); pw.y = pkbf(pa[2], pa[3]); pw.z = pkbf(pb[0], pb[1]); pw.w = pkbf(pb[2], pb[3]); const bf16x8 pf = __builtin_bit_cast(bf16x8, pw);
#pragma unroll
                for (int dt = 0; dt < 4; ++dt) o[dt] = __builtin_amdgcn_mfma_f32_16x16x32_bf16(vf[dt], pf, o[dt], 0, 0, 0);
            }
        }
        l += __shfl_xor(l, 16); l += __shfl_xor(l, 32);
        if (w == 2 || w == 4) {
#pragma unroll
            for (int dt = 0; dt < 4; ++dt)
#pragma unroll
                for (int q = 0; q < 4; ++q) scr[(dt * 4 + q) * 64] = o[dt][q];
            scr[16 * 64] = l;
        }
        asm volatile("s_waitcnt vmcnt(0) lgkmcnt(0)" ::: "memory"); __syncthreads();
        if (w == 1 || w == 3) {
#pragma unroll
            for (int dt = 0; dt < 4; ++dt)
#pragma unroll
                for (int q = 0; q < 4; ++q) o[dt][q] += scr[(dt * 4 + q) * 64];
            l += scr[16 * 64];
        }
        if (w == 0 || w == 1 || w == 3 || w == 5) { const float inv = 1.0f / l; bf16_t* op = mixb + (size_t)(64 * r) * 1024;
#pragma unroll
            for (int dt = 0; dt < 4; ++dt) { u32x2 ww; ww.x = pkbf(o[dt][0] * inv, o[dt][1] * inv); ww.y = pkbf(o[dt][2] * inv, o[dt][3] * inv); *(u32x2*)(op + 16 * dt) = ww; } }
    }
#undef AT_DMA
    asm volatile("s_waitcnt lgkmcnt(0)" ::: "memory"); __syncthreads();
}
__device__ __forceinline__ void pool_unit(Frame& F, int pm, int grp) {
    LAS bf16_t* Ut = (LAS bf16_t*)(F.lds + UT_OFF);
    const int tid = F.tid; const int tok0 = pm * 256, b = tok0 >> 11, t0 = tok0 & 2047;
    {   const bf16_t* Ub = WSP(const bf16_t, WS_U) + (size_t)b * 2048 * 512 + grp * 128;
        for (int i = tid; i < UT_ROWS * 16; i += 512) { const int rr = i >> 4, ch = i & 15; const int t = t0 - 8 + rr;
            u32x4 v = (u32x4){0u, 0u, 0u, 0u}; if (t >= 0 && t < S) v = *(const u32x4*)(Ub + (size_t)t * 512 + ch * 8);
            *(LAS u32x4*)(Ut + rr * UT_PITCH + ch * 8) = v; } }
    __syncthreads();
    {   const int lane = F.lane, g = lane >> 4, m = lane & 15, w = F.wave; const int hw = 1 << grp;
        const bf16_t* Wp = WSP(const bf16_t, WS_WPOOL) + (size_t)grp * 128 * 128;
        f32x4 acc[2][8];
#pragma unroll
        for (int mt = 0; mt < 2; ++mt)
#pragma unroll
            for (int nt = 0; nt < 8; ++nt) acc[mt][nt] = (f32x4){0.f, 0.f, 0.f, 0.f};
        float rc[2];
#pragma unroll
        for (int mt = 0; mt < 2; ++mt) { const int t = t0 + 32 * w + 16 * mt + m; const int lo = (t - hw) < 0 ? 0 : (t - hw), hi = (t + hw - 1) > (S - 1) ? (S - 1) : (t + hw - 1); rc[mt] = 1.0f / (float)(hi - lo + 1); }
        for (int ks = 0; ks < 4; ++ks) { bf16x8 af[2];
#pragma unroll
            for (int mt = 0; mt < 2; ++mt) { const LAS bf16_t* up = Ut + (32 * w + 16 * mt + m + 8) * UT_PITCH + 32 * ks + 8 * g;
                float sm[8];
#pragma unroll
                for (int j = 0; j < 8; ++j) sm[j] = 0.f;
                for (int q = -hw; q < hw; ++q) { const u32x4 v = *(const LAS u32x4*)(up + q * UT_PITCH);
                    sm[0] += bflo(v.x); sm[1] += bfhi(v.x); sm[2] += bflo(v.y); sm[3] += bfhi(v.y); sm[4] += bflo(v.z); sm[5] += bfhi(v.z); sm[6] += bflo(v.w); sm[7] += bfhi(v.w); }
                const u32x4 uc = *(const LAS u32x4*)up; const float r_ = rc[mt];
                u32x4 d; d.x = pkbf(sm[0] * r_ - bflo(uc.x), sm[1] * r_ - bfhi(uc.x)); d.y = pkbf(sm[2] * r_ - bflo(uc.y), sm[3] * r_ - bfhi(uc.y));
                d.z = pkbf(sm[4] * r_ - bflo(uc.z), sm[5] * r_ - bfhi(uc.z)); d.w = pkbf(sm[6] * r_ - bflo(uc.w), sm[7] * r_ - bfhi(uc.w));
                af[mt] = __builtin_bit_cast(bf16x8, d); }
#pragma unroll
            for (int nt = 0; nt < 8; ++nt) { const bf16x8 wf = *(const bf16x8*)(Wp + (size_t)(16 * nt + m) * 128 + 32 * ks + 8 * g);
#pragma unroll
                for (int mt = 0; mt < 2; ++mt) acc[mt][nt] = __builtin_amdgcn_mfma_f32_16x16x32_bf16(wf, af[mt], acc[mt][nt], 0, 0, 0); } }
        bf16_t* mix = WSP(bf16_t, WS_MIX);
#pragma unroll
        for (int mt = 0; mt < 2; ++mt)
#pragma unroll
            for (int nt = 0; nt < 8; ++nt) { u32x2 o; o.x = pkbf(acc[mt][nt][0], acc[mt][nt][1]); o.y = pkbf(acc[mt][nt][2], acc[mt][nt][3]);
                *(u32x2*)(mix + (size_t)(pm * 256 + 32 * w + 16 * mt + m) * 1024 + grp * 128 + 16 * nt + 4 * g) = o; }
    }
    __syncthreads();
}
__device__ __forceinline__ void p2_mixer(Frame& F) {
    for (int u = F.vcu; u < 64 * 4; u += F.G) pool_unit(F, u >> 2, u & 3);
    for (int t = F.vcu; t < B * AH * 4; t += F.G) attn_block(F, t >> 2, (t & 3) * 8);
}

__device__ __forceinline__ void p4_router(Frame& F) {
    LAS float* wt = (LAS float*)F.lds;
    for (int i = F.tid; i < D * NE; i += 512) wt[(i & 15) * D + (i >> 4)] = F_w_router[i];
    __syncthreads();
    const int gw = F.vcu * 8 + F.wave, NGW = F.G * 8, lane = F.lane;
    bf16_t* H2 = WSP(bf16_t, WS_H2); float* aff = WSP(float, WS_AFF);
    for (int row = 2 * gw; row < T; row += 2 * NGW) {
        const f32x4* gr = (const f32x4*)F_norm_ffn + lane;
        f32x4 v[2][4]; float ss[2];
#pragma unroll
        for (int rr = 0; rr < 2; ++rr) { const f32x4* xr = (const f32x4*)(F.out + (size_t)(row + rr) * D) + lane; float s_ = 0.f;
#pragma unroll
            for (int j = 0; j < 4; ++j) { v[rr][j] = xr[64 * j]; s_ += (v[rr][j].x * v[rr][j].x + v[rr][j].y * v[rr][j].y) + (v[rr][j].z * v[rr][j].z + v[rr][j].w * v[rr][j].w); }
            ss[rr] = s_; }
#pragma unroll
        for (int o = 1; o < 64; o <<= 1) { ss[0] += __shfl_xor(ss[0], o); ss[1] += __shfl_xor(ss[1], o); }
#pragma unroll
        for (int rr = 0; rr < 2; ++rr) { const float rstd = 1.0f / sqrtf(ss[rr] * (1.0f / D) + EPS); u32x2* o8 = (u32x2*)(H2 + (size_t)(row + rr) * D) + lane;
#pragma unroll
            for (int j = 0; j < 4; ++j) { v[rr][j] = v[rr][j] * rstd * gr[64 * j]; u32x2 o; o.x = pkbf(v[rr][j].x, v[rr][j].y); o.y = pkbf(v[rr][j].z, v[rr][j].w); o8[64 * j] = o; } }
        float a[32];
#pragma unroll
        for (int e = 0; e < 16; ++e) { float a0 = 0.f, a1 = 0.f;
#pragma unroll
            for (int j = 0; j < 4; ++j) { const f32x4 w4 = *(const LAS f32x4*)(wt + e * D + 256 * j + 4 * lane);
                a0 += (v[0][j].x * w4.x + v[0][j].y * w4.y) + (v[0][j].z * w4.z + v[0][j].w * w4.w); a1 += (v[1][j].x * w4.x + v[1][j].y * w4.y) + (v[1][j].z * w4.z + v[1][j].w * w4.w); }
            a[e] = a0; a[16 + e] = a1; if ((e & 3) == 3) asm volatile("" ::: "memory"); }
#define RS_STEP(n, M) do { const bool up = (lane & (M)) != 0; _Pragma("unroll") for (int j = 0; j < (n) / 2; ++j) { const float snd = up ? a[j] : a[j + (n) / 2]; const float kp_ = up ? a[j + (n) / 2] : a[j]; a[j] = kp_ + __shfl_xor(snd, (M)); } } while (0)
        RS_STEP(32, 32); RS_STEP(16, 16); RS_STEP(8, 8); RS_STEP(4, 4); RS_STEP(2, 2);
#undef RS_STEP
        float lg = a[0] + __shfl_xor(a[0], 1);
        float mx = lg;
#pragma unroll
        for (int o = 2; o < 32; o <<= 1) mx = fmaxf(mx, __shfl_xor(mx, o));
        const float ex = expf(lg - mx); float sum = ex;
#pragma unroll
        for (int o = 2; o < 32; o <<= 1) sum += __shfl_xor(sum, o);
        if ((lane & 1) == 0) { const int k = lane >> 1, rr = k >> 4, e = k & 15; const int rw = row + rr; aff[((size_t)(rw >> 11) * NE + e) * S + (rw & 2047)] = ex / sum; }
    }
}

__device__ __forceinline__ void p5_topk_gather(Frame& F) {
    LAS int* sidx = (LAS int*)F.lds;
    const int lane = F.lane; const float* aff = WSP(const float, WS_AFF); float* gates = WSP(float, WS_GATES); int* slot_of = WSP(int, WS_SLOT);
    const bf16_t* H2 = WSP(const bf16_t, WS_H2); bf16_t* XE = WSP(bf16_t, WS_XE);
    for (int task = F.vcu; task < B * NE * 2; task += F.G) {
        const int be = task >> 1, half = task & 1, b = be >> 4, e = be & 15;
        if (F.wave == 0) {
            unsigned v[32];
#pragma unroll
            for (int j = 0; j < 32; ++j) v[j] = __builtin_bit_cast(unsigned, aff[(size_t)be * S + 64 * j + lane]);
            unsigned Tt = 0u;
            for (int bit = 30; bit >= 0; --bit) { const unsigned cand = Tt | (1u << bit); int cnt = 0;
#pragma unroll
                for (int j = 0; j < 32; ++j) cnt += (v[j] >= cand) ? 1 : 0;
#pragma unroll
                for (int o = 1; o < 64; o <<= 1) cnt += __shfl_xor(cnt, o);
                if (cnt >= CAP) Tt = cand; }
            int ngt = 0;
#pragma unroll
            for (int j = 0; j < 32; ++j) ngt += (v[j] > Tt) ? 1 : 0;
#pragma unroll
            for (int o = 1; o < 64; o <<= 1) ngt += __shfl_xor(ngt, o);
            const int need = CAP - ngt; int eq_run = 0, sel_run = 0;
            const unsigned long long ltmask = (lane == 0) ? 0ull : (~0ull >> (64 - lane));
#pragma unroll
            for (int j = 0; j < 32; ++j) {
                const bool gt = v[j] > Tt, eq = v[j] == Tt;
                const unsigned long long em = __ballot(eq);
                const int eqb = eq_run + __popcll(em & ltmask);
                const bool sel = gt || (eq && eqb < need);
                eq_run += __popcll(em);
                const unsigned long long sm = __ballot(sel);
                const int slot = sel_run + __popcll(sm & ltmask);
                sel_run += __popcll(sm);
                const int tok = 64 * j + lane;
                if (sel) sidx[slot] = tok;
                if (half == 0) { if (sel) gates[be * CAP + slot] = __builtin_bit_cast(float, v[j]); slot_of[((size_t)b * S + tok) * NE + e] = sel ? slot : -1; }
            }
        }
        __syncthreads();
        for (int i = 0; i < 16; ++i) { const int slot = half * 128 + F.wave * 16 + i; const int tok = sidx[slot];
            const u32x4* src = (const u32x4*)(H2 + ((size_t)b * S + tok) * D) + lane; u32x4* dst = (u32x4*)(XE + ((size_t)be * CAP + slot) * D) + lane;
            const u32x4 a0 = src[0], a1 = src[64]; dst[0] = a0; dst[64] = a1; }
        __syncthreads();
    }
}

__device__ __forceinline__ void p8_combine(Frame& F) {
    const int gw = F.vcu * 8 + F.wave, NGW = F.G * 8, lane = F.lane;
    const bf16_t* YE = WSP(const bf16_t, WS_XE); const int* slot_of = WSP(const int, WS_SLOT); bf16_t* X2N = WSP(bf16_t, WS_H2);
    const float* esq = WSP(const float, WS_ESQ); float* rstde = WSP(float, WS_RSTDE);
    for (int row = gw; row < T; row += NGW) {
        f32x4* xr = (f32x4*)(F.out + (size_t)row * D) + lane; const f32x4* gr = (const f32x4*)F_norm_ple + lane;
        f32x4 v[4];
#pragma unroll
        for (int j = 0; j < 4; ++j) v[j] = xr[64 * j];
        const int b = row >> 11;
        const int myslot = (lane < 16) ? slot_of[(size_t)row * NE + lane] : -1;
        for (int e = 0; e < NE; ++e) { const int sl = __shfl(myslot, e);
            if (sl >= 0) { const u32x2* yr = (const u32x2*)(YE + ((size_t)(b * NE + e) * CAP + sl) * D) + lane;
#pragma unroll
                for (int j = 0; j < 4; ++j) { const u32x2 y = yr[64 * j]; v[j].x += bflo(y.x); v[j].y += bfhi(y.x); v[j].z += bflo(y.y); v[j].w += bfhi(y.y); } } }
        float s = 0.f;
#pragma unroll
        for (int j = 0; j < 4; ++j) { xr[64 * j] = v[j]; s += (v[j].x * v[j].x + v[j].y * v[j].y) + (v[j].z * v[j].z + v[j].w * v[j].w); }
        const float rstd = 1.0f / sqrtf(wave_sum(s) * (1.0f / D) + EPS);
        u32x2* o8 = (u32x2*)(X2N + (size_t)row * D) + lane;
#pragma unroll
        for (int j = 0; j < 4; ++j) { const f32x4 gg = gr[64 * j]; u32x2 o; o.x = pkbf(v[j].x * rstd * gg.x, v[j].y * rstd * gg.y); o.y = pkbf(v[j].z * rstd * gg.z, v[j].w * rstd * gg.w); o8[64 * j] = o; }
        float q = (lane < 16) ? esq[(size_t)row * 16 + lane] : 0.f; q = wave_sum(q);
        if (lane == 0) rstde[row] = 1.0f / sqrtf(q * (1.0f / D) + EPS);
    }
}

constexpr int N_PHASES = 10;
__global__ void __launch_bounds__(512, 2) mega_fwd(MArgs args) {
    extern __shared__ __attribute__((aligned(16))) unsigned char lds_raw[];
    Frame F;
    F.lds = (LAS unsigned char*)lds_raw; F.tid = threadIdx.x; F.lane = F.tid & 63; F.wave = __builtin_amdgcn_readfirstlane(F.tid >> 6);
    F.G = gridDim.x; { const int bx = blockIdx.x; F.vcu = (F.G % 8 == 0) ? (bx % 8) * (F.G / 8) + bx / 8 : bx; }
    F.out = args.out; F.ws = args.ws; F.a = &args;
    for (int u = F.tid; u < (LDS_BYTES - LDSCTL_OFF) / 4; u += 512) ((LAS unsigned*)(F.lds + LDSCTL_OFF))[u] = 0u;
    __syncthreads();
    const int lo = args.ph_lo, hi = args.ph_hi;
    if (hi - lo > 1) xcd_barrier_post(WSP(unsigned, WS_CTL) + CW_BAR);
#ifndef PH_ENABLE
#define PH_ENABLE 0x3ff
#endif
#define IN(k) (((PH_ENABLE >> (k)) & 1) && lo <= (k) && (k) < hi)
#ifndef DUP_MASK
#define DUP_MASK 0
#endif
#define GBAR() xcd_barrier(WSP(unsigned, WS_CTL) + CW_BAR, (volatile LAS unsigned*)(F.lds + MISC_OFF) + 8)
#define DUP(k) (((DUP_MASK >> (k)) & 1) ? 2 : 1)
#define SEAM(k) do { if (IN(k) && IN((k) + 1)) xcd_barrier(WSP(unsigned, WS_CTL) + CW_BAR, (volatile LAS unsigned*)(F.lds + MISC_OFF) + 8); } while (0)
    if (IN(0)) { for (int rep = 0; rep < DUP(0); ++rep) { if (rep) GBAR(); p0_prologue(F); } } SEAM(0);
    if (IN(1)) for (int rep = 0; rep < DUP(1); ++rep) { if (rep) GBAR();
#ifndef NO_P1A
        { pg8::Gemm g{WSP(const bf16_t, WS_XN), WSP(const bf16_t, WS_WIN), 1024}; pg8::StaticOrder So; So.init(T, 2048, F.G, (int)blockIdx.x);
          EpiQKV E{WSP(bf16_t, WS_U), WSP(bf16_t, WS_Q), WSP(bf16_t, WS_K), WSP(bf16_t, WS_VT), F_q_norm, F_k_norm};
          pg8::gemm_phase(F.lds, g, So, E); }
#endif
#ifndef NO_P1B
        { pg8::Gemm g{WSP(const bf16_t, WS_PB), WSP(const bf16_t, WS_WPP), 256}; pg8::StaticOrder So; So.init(T, 1024, F.G, (int)blockIdx.x);
          EpiE E{WSP(bf16_t, WS_EB), WSP(float, WS_ESQ)};
          pg8::gemm_phase(F.lds, g, So, E); }
#endif
    } SEAM(1);
    if (IN(2)) { for (int rep = 0; rep < DUP(2); ++rep) { if (rep) GBAR(); p2_mixer(F); } } SEAM(2);
    if (IN(3)) for (int rep = 0; rep < DUP(3); ++rep) { if (rep) GBAR(); pg8::Gemm g{WSP(const bf16_t, WS_MIX), WSP(const bf16_t, WS_WOUT), 1024}; pg8::StaticOrder So; So.init(T, 1024, F.G, (int)blockIdx.x);
        EpiRes E{F_x, F.out}; pg8::gemm_phase(F.lds, g, So, E); } SEAM(3);
    if (IN(4)) { for (int rep = 0; rep < DUP(4); ++rep) { if (rep) GBAR(); p4_router(F); } } SEAM(4);
    if (IN(5)) { for (int rep = 0; rep < DUP(5); ++rep) { if (rep) GBAR(); p5_topk_gather(F); } } SEAM(5);
    if (IN(6)) for (int rep = 0; rep < DUP(6); ++rep) { if (rep) GBAR(); pg8::Gemm g{WSP(const bf16_t, WS_XE), WSP(const bf16_t, WS_WGU), 1024}; OrderGU So{F.G, F.vcu};
        EpiGU E{WSP(bf16_t, WS_HH)}; pg8::gemm_phase(F.lds, g, So, E); } SEAM(6);
    if (IN(7)) for (int rep = 0; rep < DUP(7); ++rep) { if (rep) GBAR(); pg8::Gemm g{WSP(const bf16_t, WS_HH), WSP(const bf16_t, WS_WD), 2048}; OrderDown So{F.G, F.vcu};
        EpiDown E{WSP(bf16_t, WS_XE), WSP(const float, WS_GATES)}; pg8::gemm_phase(F.lds, g, So, E); } SEAM(7);
    if (IN(8)) { p8_combine(F); } SEAM(8);
    if (IN(9)) { pg8::Gemm g{WSP(const bf16_t, WS_H2), WSP(const bf16_t, WS_WPG), 1024}; pg8::StaticOrder So; So.init(T, 1024, F.G, (int)blockIdx.x);
        EpiFinal E{F.out, WSP(const bf16_t, WS_EB), WSP(const float, WS_RSTDE), F_norm_ple_post}; pg8::gemm_phase(F.lds, g, So, E); }
#undef IN
#undef SEAM
}
static inline dim3 g1(size_t n) { return dim3((unsigned)((n + 255) / 256)); }

#ifndef MODE
#define MODE 0
#endif

extern "C" void kernel_launch(void* const* d_in, const int* in_sizes, int n_in, void* d_out, int out_size, void* d_ws, size_t ws_size, hipStream_t stream) {
    const float* x = (const float*)d_in[0]; const float* p = (const float*)d_in[1]; const float* norm_mix = (const float*)d_in[2]; const float* w_in = (const float*)d_in[3];
    const float* w_pool = (const float*)d_in[4]; const float* pool_scale = (const float*)d_in[5]; const float* q_norm = (const float*)d_in[6]; const float* k_norm = (const float*)d_in[7];
    const float* rpb = (const float*)d_in[8]; const float* w_out = (const float*)d_in[9]; const float* norm_ffn = (const float*)d_in[10]; const float* w_router = (const float*)d_in[11];
    const float* w_gate = (const float*)d_in[12]; const float* w_up = (const float*)d_in[13]; const float* w_down = (const float*)d_in[14]; const float* norm_ple = (const float*)d_in[15];
    const float* w_ple_gate = (const float*)d_in[16]; const float* w_ple_proj = (const float*)d_in[17]; const float* norm_ple_post = (const float*)d_in[18];
    float* out = (float*)d_out; char* ws = (char*)d_ws;
    (void)in_sizes; (void)n_in; (void)out_size;
    static int grid = 0;
    if (grid == 0) {
        if (ws_size < (size_t)489 * MiB) { fprintf(stderr, "kernel_launch: workspace too small (%zu)\n", ws_size); grid = -1; return; }
        int dev = 0, cus = 0, per_cu = 0;
        if (hipGetDevice(&dev) != hipSuccess || hipDeviceGetAttribute(&cus, hipDeviceAttributeMultiprocessorCount, dev) != hipSuccess) { grid = -1; return; }
        if (hipFuncSetAttribute((const void*)mega_fwd, hipFuncAttributeMaxDynamicSharedMemorySize, LDS_BYTES) != hipSuccess) { fprintf(stderr, "kernel_launch: hipFuncSetAttribute failed\n"); grid = -1; return; }
        if (hipOccupancyMaxActiveBlocksPerMultiprocessor(&per_cu, (const void*)mega_fwd, 512, LDS_BYTES) != hipSuccess || per_cu < 1) { fprintf(stderr, "kernel_launch: occupancy query says %d blocks per CU\n", per_cu); grid = -1; (void)hipGetLastError(); return; }
        grid = cus;
    }
    if (grid < 0) return;
    (void)hipMemsetAsync((char*)d_ws + WS_CTL, 0, CTL_ZERO_BYTES, stream);
    MArgs a{};
    for (int i = 0; i < 19; ++i) a.in[i] = (const float*)d_in[i];
    a.out = out; a.ws = (unsigned char*)d_ws;
#if MODE == 0
    a.ph_lo = 0; a.ph_hi = N_PHASES;
    hipLaunchKernelGGL(mega_fwd, dim3(grid), dim3(512), LDS_BYTES, stream, a);
#else
    constexpr int KOPT = MODE - 100;
    for (int ph = 0; ph <= KOPT; ++ph) { a.ph_lo = ph; a.ph_hi = ph + 1; hipLaunchKernelGGL(mega_fwd, dim3(grid), dim3(512), LDS_BYTES, stream, a); }
    float* xn = (float*)(ws + 0 * MiB);
    float* z = (float*)(ws + 64 * MiB);
    float* dp = (float*)(ws + 192 * MiB);
    float* ye = (float*)(ws + 288 * MiB);
    float* ga = (float*)(ws + 416 * MiB); float* gb = (float*)(ws + 448 * MiB);
    float* mix = (float*)(ws + 416 * MiB);
    float* aff = (float*)(ws + 485 * MiB); int* idx = (int*)(ws + 486 * MiB); float* gates = (float*)(ws + 487 * MiB); int* slot_of = (int*)(ws + 488 * MiB);
    const unsigned short* mU = (const unsigned short*)(ws + WS_U); const unsigned short* mQ = (const unsigned short*)(ws + WS_Q); const unsigned short* mK = (const unsigned short*)(ws + WS_K); const unsigned short* mVT = (const unsigned short*)(ws + WS_VT);
    if (KOPT < 1) {
        nv::rmsnorm_rows<<<T, 256, 0, stream>>>(x, norm_mix, xn, D);
        nv::gemm_f32<<<dim3(2048 / 64, T / 64, 1), 256, 0, stream>>>(xn, w_in, z, D, D, 2048, 2048, 0, 0, 0);
    }
    if (KOPT < 2) {
        if (KOPT == 1) nv::bf16_to_f32<<<g1((size_t)T * PW), 256, 0, stream>>>(mU, z, PW, 2048, (size_t)T * PW);
        nv::pool_diff<<<g1((size_t)T * PW), 256, 0, stream>>>(z, dp);
        nv::gemm_f32<<<dim3(PG / 64, T / 64, 4), 256, 0, stream>>>(dp, w_pool, mix, PG, PW, PG, D, PG, (size_t)PG * PG, PG);
        nv::scale_cols<<<g1((size_t)T * PW), 256, 0, stream>>>(mix, D, PW, pool_scale, (size_t)T * PW);
        if (KOPT == 1) nv::natten_pre<<<T * AH, 128, 0, stream>>>(mQ, mK, mVT, rpb, mix);
        else nv::natten<<<T * AH, 128, 0, stream>>>(z, q_norm, k_norm, rpb, mix);
    }
    if (KOPT < 3) {
        if (KOPT == 2) nv::bf16_to_f32<<<g1((size_t)T * D), 256, 0, stream>>>((const unsigned short*)(ws + WS_MIX), mix, D, D, (size_t)T * D);
        nv::gemm_f32<<<dim3(D / 64, T / 64, 1), 256, 0, stream>>>(mix, w_out, xn, D, D, D, D, 0, 0, 0);
        nv::add_to<<<g1((size_t)T * D), 256, 0, stream>>>(out, x, xn, (size_t)T * D);
    }
    if (KOPT < 4) {
        nv::rmsnorm_rows<<<T, 256, 0, stream>>>(out, norm_ffn, xn, D);
        nv::router<<<T, 256, 0, stream>>>(xn, w_router, aff);
    } else { aff = (float*)(ws + WS_AFF); }
    if (KOPT < 5) {
        if (KOPT == 4) nv::bf16_to_f32<<<g1((size_t)T * D), 256, 0, stream>>>((const unsigned short*)(ws + WS_H2), xn, D, D, (size_t)T * D);
        nv::topk<<<B * NE, 1024, 0, stream>>>(aff, idx, gates, slot_of);
        nv::gather_rows<<<B * NE * CAP, 256, 0, stream>>>(xn, idx, z);
    } else { gates = (float*)(ws + WS_GATES); slot_of = (int*)(ws + WS_SLOT); }
    if (KOPT < 7) {
        float* xe = z;
        if (KOPT >= 5) nv::bf16_to_f32<<<g1((size_t)B * NE * CAP * D), 256, 0, stream>>>((const unsigned short*)(ws + WS_XE), xe, D, D, (size_t)B * NE * CAP * D);
        for (int b = 0; b < B; ++b) {
            const float* xeb = xe + (size_t)b * NE * CAP * D;
            nv::gemm_f32<<<dim3(DE / 64, CAP / 64, NE), 256, 0, stream>>>(xeb, w_gate, ga, D, D, DE, DE, (size_t)CAP * D, (size_t)D * DE, (size_t)CAP * DE);
            nv::gemm_f32<<<dim3(DE / 64, CAP / 64, NE), 256, 0, stream>>>(xeb, w_up, gb, D, D, DE, DE, (size_t)CAP * D, (size_t)D * DE, (size_t)CAP * DE);
            nv::silu_mul<<<g1((size_t)NE * CAP * DE), 256, 0, stream>>>(ga, gb, (size_t)NE * CAP * DE);
            nv::gemm_f32<<<dim3(D / 64, CAP / 64, NE), 256, 0, stream>>>(ga, w_down, ye + (size_t)b * NE * CAP * D, DE, DE, D, D, (size_t)CAP * DE, (size_t)DE * D, (size_t)CAP * D);
        }
    }
    if (KOPT < 8) {
        if (KOPT == 7) nv::combine_bf16<<<T, 256, 0, stream>>>(out, (const unsigned short*)(ws + WS_XE), slot_of);
        else nv::combine<<<T, 256, 0, stream>>>(out, ye, gates, slot_of);
    }
    if (KOPT < 9) {
        nv::rmsnorm_rows<<<T, 256, 0, stream>>>(out, norm_ple, xn, D);
        nv::gemm_f32<<<dim3(D / 64, T / 64, 1), 256, 0, stream>>>(xn, w_ple_gate, mix, D, D, D, D, 0, 0, 0);
        float* eraw = ye;
        nv::gemm_f32<<<dim3(D / 64, T / 64, 1), 256, 0, stream>>>(p, w_ple_proj, eraw, PD, PD, D, D, 0, 0, 0);
        nv::rmsnorm_rows<<<T, 256, 0, stream>>>(eraw, norm_ple_post, xn, D);
        nv::ple_final<<<g1((size_t)T * D), 256, 0, stream>>>(out, mix, xn, (size_t)T * D);
    }
#endif
}
```

```cpp
#include <hip/hip_runtime.h>
#include <cstdio>
#include <cstdint>

namespace cfg {
constexpr int D = 1024, B = 8, S = 2048, T = B * S;
constexpr int GW = 64, ROWS = S / GW;
constexpr int PW = 512, PG = 128, AH = 8, HD = 64, NE = 16, CAP = 256, DE = 2048, PD = 256;
constexpr float EPS = 1e-6f;
}
using namespace cfg;

#define MODE 0
#define GAS __attribute__((address_space(1)))
#define LAS __attribute__((address_space(3)))
typedef unsigned short bf16_t;
typedef short bf16x8 __attribute__((ext_vector_type(8)));
typedef float f32x4 __attribute__((ext_vector_type(4)));
typedef float f32x2 __attribute__((ext_vector_type(2)));
typedef unsigned u32x4 __attribute__((ext_vector_type(4)));
typedef unsigned u32x2 __attribute__((ext_vector_type(2)));
typedef __bf16 bf16x2_t __attribute__((ext_vector_type(2)));

__device__ __forceinline__ unsigned pkbf(float lo, float hi) { f32x2 v = {lo, hi}; bf16x2_t b = __builtin_convertvector(v, bf16x2_t); return __builtin_bit_cast(unsigned, b); }
__device__ __forceinline__ float bf2f(unsigned short u) { return __builtin_bit_cast(float, (unsigned)u << 16); }
__device__ __forceinline__ float bflo(unsigned u) { return __builtin_bit_cast(float, u << 16); }
__device__ __forceinline__ float bfhi(unsigned u) { return __builtin_bit_cast(float, u & 0xffff0000u); }
__device__ __forceinline__ float wave_sum(float v) {
#pragma unroll
    for (int o = 1; o < 64; o <<= 1) v += __shfl_xor(v, o);
    return v;
}
constexpr float LOG2E = 1.4426950408889634f;
#ifndef EXPERT_FP8
#define EXPERT_FP8 1
#endif
constexpr float FP8_WSCALE = 32.0f, FP8_HSCALE = 8.0f;
__device__ __forceinline__ unsigned pk4_fp8(float a, float b, float c, float d) { unsigned w = 0u; w = __builtin_amdgcn_cvt_pk_fp8_f32(a, b, w, false); w = __builtin_amdgcn_cvt_pk_fp8_f32(c, d, w, true); return w; }

namespace pg8 {
constexpr int BM = 256, BK = 64, HALF = 128, HTB = HALF * BK * 2, STAGE_BYTES = 8 * HTB;
__host__ __device__ __forceinline__ int lds_byte(int r, int c) { const int st = (r >> 4) * 2 + (c >> 5), rr = r & 15, cc = c & 31, ob = rr * 64 + cc * 2; return st * 1024 + (ob ^ (((ob >> 9) & 1) << 5)); }
__host__ __device__ __forceinline__ void stage_rc(int b, int& R, int& C) { const int st = b / 1024, sb = b % 1024, swz = sb ^ (((sb >> 9) & 1) << 5); R = (st >> 1) * 16 + swz / 64; C = (st & 1) * 32 + (swz % 64) / 2; }
__host__ __device__ __forceinline__ int perm32(int rho) { const int n = rho >> 4, i = rho & 15; return 8 * (i >> 2) + 4 * n + (i & 3); }

struct Unit { int arow, brow, pm, pn, grp; };
struct Gemm { const bf16_t* A; const bf16_t* Bt; int K; };

struct StaticOrder {
    int nM, nN, nwg, G, c, reps;
    __device__ void init(int M, int N, int G_, int c_, int reps_ = 1) { nM = M / BM; nN = N / BM; nwg = nM * nN; G = G_; c = c_; reps = reps_; }
    __device__ bool next(int i, Unit& u) const {
        const long L = (long)i * G + c; if (L >= (long)nwg * reps) return false;
        int wgid = (int)(L % nwg); { const int q = nwg / 8, r = nwg % 8, xcd = wgid % 8, off = wgid / 8; wgid = (xcd < r ? xcd * (q + 1) : r * (q + 1) + (xcd - r) * q) + off; }
        const int nig = 8 * nN, gid = wgid / nig, fm = gid * 8, gsz = (nM - fm) < 8 ? (nM - fm) : 8;
        u.pm = fm + ((wgid % nig) % gsz); u.pn = (wgid % nig) / gsz; u.arow = u.pm * BM; u.brow = u.pn * BM; u.grp = 0; return true;
    }
};

typedef int v8i32 __attribute__((ext_vector_type(8)));
template <class Epi, class Sched, bool FP8 = false, unsigned SCALE_W = 0x7f7f7f7fu, unsigned SCALE_X = 0x7f7f7f7fu>
__device__ __forceinline__ void gemm_phase(LAS unsigned char* lds, const Gemm g, const Sched& S, const Epi& E) {
    const int tid = threadIdx.x, wid = __builtin_amdgcn_readfirstlane(tid >> 6), lane = tid & 63, wr = wid >> 2, wc = wid & 3, fr = lane & 15, fq = lane >> 4;
    int K = g.K; asm volatile("" : "+s"(K));
    const int nt = FP8 ? K / 128 : K / BK;
    const unsigned rstep = FP8 ? (unsigned)K : (unsigned)K * 2;
    unsigned voffA[2], voffB[2];
#pragma unroll
    for (int i = 0; i < 2; ++i) { int R, C; stage_rc(tid * 16 + i * 8192, R, C); const int Rb = 64 * (R >> 5) + perm32(R & 31);
        voffA[i] = (unsigned)R * rstep + (unsigned)C * 2u; voffB[i] = (unsigned)Rb * rstep + (unsigned)C * 2u; }
    const unsigned kstep = (unsigned)(BK * 2);
    const unsigned hstep = (unsigned)HALF * rstep;
    const unsigned hstepB = (unsigned)32 * rstep;
    const unsigned ldsw = (unsigned)wid * 1024u;
    const int aoff = lds_byte(wr * 64 + fr, fq * 8), boff = lds_byte(wc * 32 + fr, fq * 8);
#define PG8_SA(b, h) (((b) * 2 + (h)) * HTB)
#define PG8_SB(b, h) ((4 + (b) * 2 + (h)) * HTB)
#define PG8_STAGE(bufoff, rsrc, soff, voff) do { _Pragma("unroll") for (int _i = 0; _i < 2; ++_i) \
        __builtin_amdgcn_raw_ptr_buffer_load_lds((rsrc), (LAS void*)(lds + (bufoff) + ldsw + _i * 8192), 16, (int)(voff)[_i], (int)(soff), 0, 0); } while (0)
#define PG8_LDA(dst, b, h) do { _Pragma("unroll") for (int m = 0; m < 4; ++m) _Pragma("unroll") for (int k = 0; k < 2; ++k) dst[m][k] = *(const LAS bf16x8*)(lds + PG8_SA(b, h) + aoff + m * 2048 + k * 1024); } while (0)
#define PG8_LDB(dst, b, h) do { _Pragma("unroll") for (int n = 0; n < 2; ++n) _Pragma("unroll") for (int k = 0; k < 2; ++k) dst[n][k] = *(const LAS bf16x8*)(lds + PG8_SB(b, h) + boff + n * 2048 + k * 1024); } while (0)
#define PG8_CAT(x) __builtin_bit_cast(v8i32, x)
#define PG8_MMA(ai, bj, At, Bt) do { __builtin_amdgcn_s_setprio(1); \
        if constexpr (FP8) { _Pragma("unroll") for (int m = 0; m < 4; ++m) _Pragma("unroll") for (int n = 0; n < 2; ++n) \
            acc[ai][bj][m][n] = __builtin_amdgcn_mfma_scale_f32_16x16x128_f8f6f4(PG8_CAT(Bt[n]), PG8_CAT(At[m]), acc[ai][bj][m][n], 0, 0, 0, (int)((SCALE_W & 0xffu) | ((SCALE_X & 0xffu) << 8)), 1, (int)((SCALE_W & 0xffu) | ((SCALE_X & 0xffu) << 8))); } \
        else { _Pragma("unroll") for (int m = 0; m < 4; ++m) _Pragma("unroll") for (int n = 0; n < 2; ++n) _Pragma("unroll") for (int k = 0; k < 2; ++k) \
            acc[ai][bj][m][n] = __builtin_amdgcn_mfma_f32_16x16x32_bf16(Bt[n][k], At[m][k], acc[ai][bj][m][n], 0, 0, 0); } \
        __builtin_amdgcn_s_setprio(0); } while (0)
#define PG8_WAIT_V(n) asm volatile("s_waitcnt vmcnt(" #n ")" ::: "memory")
#define PG8_WAIT_L(n) asm volatile("s_waitcnt lgkmcnt(" #n ")" ::: "memory")
#define PG8_BAR __builtin_amdgcn_s_barrier()
#define PG8_SCHED __builtin_amdgcn_sched_barrier(0)
    Unit cur, nxt; int ui = 0;
    if (!S.next(0, cur)) return;
    f32x4 acc[2][2][4][2];
#pragma unroll
    for (int a = 0; a < 2; ++a)
#pragma unroll
        for (int b = 0; b < 2; ++b)
#pragma unroll
            for (int m = 0; m < 4; ++m)
#pragma unroll
                for (int n = 0; n < 2; ++n) acc[a][b][m][n] = (f32x4){0.f, 0.f, 0.f, 0.f};
    struct alignas(32) Frag2 { bf16x8 v[2]; __device__ __forceinline__ bf16x8& operator[](int i) { return v[i]; } };
    Frag2 At[4], B0[2], B1[2];
    const __amdgpu_buffer_rsrc_t rA = __builtin_amdgcn_make_buffer_rsrc((void*)g.A, 0, 0xffffffff, 0x00020000);
    const __amdgpu_buffer_rsrc_t rB = __builtin_amdgcn_make_buffer_rsrc((void*)g.Bt, 0, 0xffffffff, 0x00020000);
    unsigned cA = (unsigned)cur.arow * rstep, cB = (unsigned)cur.brow * rstep;
    PG8_STAGE(PG8_SB(0, 0), rB, cB, voffB); PG8_STAGE(PG8_SB(0, 1), rB, cB + hstepB, voffB); PG8_STAGE(PG8_SA(0, 0), rA, cA, voffA); PG8_STAGE(PG8_SA(0, 1), rA, cA + hstep, voffA);
    if (wr == 1) PG8_BAR;
    PG8_WAIT_V(2); PG8_BAR;
    PG8_STAGE(PG8_SB(1, 0), rB, cB + kstep, voffB); PG8_STAGE(PG8_SA(1, 0), rA, cA + kstep, voffA); PG8_STAGE(PG8_SB(1, 1), rB, cB + hstepB + kstep, voffB);
    PG8_WAIT_V(6); PG8_BAR;
    for (;;) {
        const bool has_next = S.next(ui + 1, nxt);
        const unsigned nA = has_next ? (unsigned)nxt.arow * rstep : cA; const unsigned nB = has_next ? (unsigned)nxt.brow * rstep : cB;
        for (int t = 0; t < nt; t += 2) {
            const bool last = (t == nt - 2);
            const unsigned a1 = cA + (unsigned)(t + 1) * kstep;
            const unsigned a2 = last ? nA : cA + (unsigned)(t + 2) * kstep; const unsigned b2 = last ? nB : cB + (unsigned)(t + 2) * kstep;
            const unsigned a3 = a2 + kstep; const unsigned b3 = b2 + kstep;
            PG8_LDB(B0, 0, 0); PG8_LDB(B1, 0, 1); PG8_SCHED; PG8_LDA(At, 0, 0); PG8_STAGE(PG8_SA(1, 1), rA, a1 + hstep, voffA);
            PG8_WAIT_V(8); PG8_WAIT_L(0); PG8_BAR; PG8_MMA(0, 0, At, B0); PG8_MMA(0, 1, At, B1); PG8_BAR; PG8_SCHED;
            PG8_LDA(At, 0, 1); PG8_STAGE(PG8_SB(0, 0), rB, b2, voffB); PG8_STAGE(PG8_SB(0, 1), rB, b2 + hstepB, voffB); PG8_STAGE(PG8_SA(0, 0), rA, a2, voffA);
            PG8_WAIT_V(8); PG8_WAIT_L(0); PG8_BAR; PG8_MMA(1, 0, At, B0); PG8_MMA(1, 1, At, B1); PG8_BAR; PG8_SCHED;
            PG8_LDB(B0, 1, 0); PG8_LDB(B1, 1, 1); PG8_SCHED; PG8_LDA(At, 1, 0); PG8_STAGE(PG8_SA(0, 1), rA, a2 + hstep, voffA);
            PG8_WAIT_V(8); PG8_WAIT_L(0); PG8_BAR; PG8_MMA(0, 0, At, B0); PG8_MMA(0, 1, At, B1); PG8_BAR; PG8_SCHED;
            PG8_LDA(At, 1, 1); PG8_STAGE(PG8_SB(1, 0), rB, b3, voffB); PG8_STAGE(PG8_SB(1, 1), rB, b3 + hstepB, voffB); PG8_STAGE(PG8_SA(1, 0), rA, a3, voffA);
            PG8_WAIT_V(8); PG8_WAIT_L(0); PG8_BAR; PG8_MMA(1, 0, At, B0); PG8_MMA(1, 1, At, B1); PG8_BAR; PG8_SCHED;
        }
        if (wr == 0) PG8_BAR;
        if constexpr (!Epi::AFTER_DRAIN) E(acc, cur, wr, wc, fr, fq);
        if (!has_next) break;
#pragma unroll
        for (int a = 0; a < 2; ++a)
#pragma unroll
            for (int b = 0; b < 2; ++b)
#pragma unroll
                for (int m = 0; m < 4; ++m)
#pragma unroll
                    for (int n = 0; n < 2; ++n) acc[a][b][m][n] = (f32x4){0.f, 0.f, 0.f, 0.f};
        cur = nxt; cA = nA; cB = nB; ++ui;
        if (wr == 1) PG8_BAR;
    }
    PG8_WAIT_V(0);
    PG8_BAR;
    if constexpr (Epi::AFTER_DRAIN) E.fused(acc, cur, lds, wid);
#undef PG8_SA
#undef PG8_SB
#undef PG8_STAGE
#undef PG8_LDA
#undef PG8_LDB
#undef PG8_MMA
#undef PG8_CAT
#undef PG8_WAIT_V
#undef PG8_WAIT_L
#undef PG8_BAR
#undef PG8_SCHED
}
}

constexpr size_t MiB = (size_t)1 << 20;
constexpr size_t WS_CTL = 0, CTL_ZERO_BYTES = 64 * 1024;
constexpr size_t WS_WIN = 4 * MiB, WS_WOUT = 8 * MiB, WS_WPG = 10 * MiB, WS_WPP = 12 * MiB, WS_WPOOL = 12 * MiB + 512 * 1024;
constexpr size_t WS_WGU = 16 * MiB, WS_WD = 144 * MiB;
constexpr size_t WS_HH = 208 * MiB;
constexpr size_t WS_U = 208 * MiB, WS_Q = 224 * MiB, WS_K = 240 * MiB, WS_VT = 256 * MiB, WS_MIX = 272 * MiB, WS_XN = 304 * MiB;
constexpr size_t WS_PB = 336 * MiB, WS_EB = 344 * MiB, WS_H2 = 376 * MiB  , WS_XE = 408 * MiB  ;
constexpr size_t WS_AFF = 480 * MiB, WS_GATES = 481 * MiB, WS_SLOT = 482 * MiB, WS_ESQ = 483 * MiB, WS_RSTDE = 484 * MiB;
constexpr size_t WS_RMS2 = 484 * MiB + 512 * 1024, WS_RSTD1 = 484 * MiB + 768 * 1024;
constexpr size_t WS_PART = 208 * MiB;
constexpr size_t WS_X2N = 272 * MiB;
constexpr size_t WS_MEGA_END = 485 * MiB;
constexpr int CW_BAR = 1024;

constexpr int RING_BYTES = 131072, LDS_BYTES = 163840, LDSCTL_OFF = LDS_BYTES - 512, MISC_OFF = LDSCTL_OFF + 320;

#define XB_TMO      128
#define XB_XCNT(j)  (256  + 64 * (j))
#define XB_XSUB(j)  (1280 + 64 * (j))
#define XB_XGEN(j)  (2304 + 64 * (j))
#define XB_TOP      3328
#define XB_TOPGEN   3392
#define XCD_BAR_WORDS 3456
#define XB_SPIN_CAP (1u << 18)
__device__ __forceinline__ unsigned xb_ld(unsigned* p)              { return __hip_atomic_load(p, __ATOMIC_RELAXED, __HIP_MEMORY_SCOPE_AGENT); }
__device__ __forceinline__ unsigned xb_add(unsigned* p, unsigned v) { return __hip_atomic_fetch_add(p, v, __ATOMIC_RELAXED, __HIP_MEMORY_SCOPE_AGENT); }
__device__ __forceinline__ unsigned xb_xcc_id() { return (unsigned)__builtin_amdgcn_s_getreg((3 << 11) | 20) & 0xFu; }
#define XB_SPIN(cond, bar) do { unsigned _sp = 0; while (cond) { __builtin_amdgcn_s_sleep(1); \
    if ((++_sp & 255u) == 0u) { if (xb_ld(&(bar)[XB_TMO])) break; if (_sp > XB_SPIN_CAP) { atomicAdd(&(bar)[XB_TMO], 1u); break; } } } } while (0)
__device__ __forceinline__ void xcd_barrier_post(unsigned* bar) { if (threadIdx.x == 0) (void)xb_add(&bar[XB_XCNT(xb_xcc_id())], 1u); }
__device__ __forceinline__ void xcd_barrier_complete(unsigned* bar, unsigned x, unsigned& nloc, unsigned& nx) {
    const unsigned G = gridDim.x * gridDim.y * gridDim.z;
    unsigned sum, cnt, mine, sp = 0u;
    for (;;) {
        sum = 0u; cnt = 0u; mine = 0u;
#pragma unroll
        for (unsigned j = 0; j < 16; ++j) { const unsigned c = xb_ld(&bar[XB_XCNT(j)]); sum += c; cnt += (c > 0u) ? 1u : 0u; mine = (j == x) ? c : mine; }
        if (sum == G) break;
        __builtin_amdgcn_s_sleep(1);
        if ((++sp & 255u) == 0u) { if (xb_ld(&bar[XB_TMO])) break; if (sp > XB_SPIN_CAP) { atomicAdd(&bar[XB_TMO], 1u); break; } }
    }
    nloc = mine > 0u ? mine : 1u; nx = cnt > 0u ? cnt : 1u;
}
__device__ __forceinline__ void xcd_barrier(unsigned* bar, volatile LAS unsigned* st) {
    asm volatile("s_waitcnt vmcnt(0)" ::: "memory");
    __syncthreads();
    if (threadIdx.x == 0) {
        const unsigned x = xb_xcc_id();
        __builtin_amdgcn_s_waitcnt(0);
        unsigned nloc = st[0], nx = st[1];
        if (nloc == 0u) { xcd_barrier_complete(bar, x, nloc, nx); st[0] = nloc; st[1] = nx; }
        const unsigned old = xb_add(&bar[XB_XSUB(x)], 1u);
        const unsigned gen = old / nloc;
        if (old + 1u == (gen + 1u) * nloc) {
            __builtin_amdgcn_fence(__ATOMIC_RELEASE, "agent");
            asm volatile("s_waitcnt vmcnt(0)" ::: "memory");
            const unsigned og = xb_add(&bar[XB_TOP], 1u);
            const unsigned tg = og / nx;
            if (og + 1u == (tg + 1u) * nx) xb_add(&bar[XB_TOPGEN], 1u);
            else XB_SPIN(xb_ld(&bar[XB_TOPGEN]) == tg, bar);
            __builtin_amdgcn_fence(__ATOMIC_ACQUIRE, "agent");
            xb_add(&bar[XB_XGEN(x)], 1u);
            asm volatile("s_waitcnt vmcnt(0)" ::: "memory");
        } else {
            XB_SPIN(xb_ld(&bar[XB_XGEN(x)]) == gen, bar);
            __builtin_amdgcn_fence(__ATOMIC_ACQUIRE, "agent");
            asm volatile("s_waitcnt vmcnt(0)" ::: "memory");
        }
    }
    __syncthreads();
}

struct MArgs { const float* in[19]; float* out; unsigned char* ws; int ph_lo, ph_hi; };
struct Frame {
    LAS unsigned char* lds; int tid, lane, wave, vcu, G;
    float* out; unsigned char* ws; const MArgs* a;
};
#define F_x (F.a->in[0])
#define F_p (F.a->in[1])
#define F_norm_mix (F.a->in[2])
#define F_w_in (F.a->in[3])
#define F_w_pool (F.a->in[4])
#define F_pool_scale (F.a->in[5])
#define F_q_norm (F.a->in[6])
#define F_k_norm (F.a->in[7])
#define F_rpb (F.a->in[8])
#define F_w_out (F.a->in[9])
#define F_norm_ffn (F.a->in[10])
#define F_w_router (F.a->in[11])
#define F_w_gate (F.a->in[12])
#define F_w_up (F.a->in[13])
#define F_w_down (F.a->in[14])
#define F_norm_ple (F.a->in[15])
#define F_w_ple_gate (F.a->in[16])
#define F_w_ple_proj (F.a->in[17])
#define F_norm_ple_post (F.a->in[18])
#define WSP(T, off) ((T*)(F.ws + (off)))

__device__ __forceinline__ void tr_item(const float* W, int K, int N, bf16_t* WT, int kb, int nb, int dst_row0, LAS float* scr, int lane) {
    const int k0 = 64 * kb, n0 = 32 * nb;
#pragma unroll 8
    for (int i = 0; i < 32; ++i) { const int kk = 2 * i + (lane >> 5); scr[kk * 33 + (lane & 31)] = W[(size_t)(k0 + kk) * N + n0 + (lane & 31)]; }
    asm volatile("s_waitcnt lgkmcnt(0)" ::: "memory");
    const int c = lane & 7;
#pragma unroll
    for (int j = 0; j < 4; ++j) { const int n = (lane >> 3) + 8 * j; const LAS float* s = scr + (8 * c) * 33 + n;
        u32x4 o; o.x = pkbf(s[0 * 33], s[1 * 33]); o.y = pkbf(s[2 * 33], s[3 * 33]); o.z = pkbf(s[4 * 33], s[5 * 33]); o.w = pkbf(s[6 * 33], s[7 * 33]);
        *(u32x4*)(WT + (size_t)(dst_row0 + n) * K + k0 + 8 * c) = o; }
    asm volatile("s_waitcnt lgkmcnt(0)" ::: "memory");
}
__device__ __forceinline__ void tr_item8(const float* W, int K, int N, unsigned char* WT, int kb, int nb, int dst_row0, float scale, LAS float* scr, int lane) {
    const int k0 = 128 * kb, n0 = 32 * nb;
    const float* wp = W + (size_t)(k0 + (lane >> 5)) * N + n0 + (lane & 31); LAS float* sp = scr + (lane >> 5) * 33 + (lane & 31);
#pragma unroll
    for (int h = 0; h < 2; ++h) { float t[32];
#pragma unroll
        for (int i = 0; i < 32; ++i) t[i] = wp[(size_t)(2 * (32 * h + i)) * N];
#pragma unroll
        for (int i = 0; i < 32; ++i) sp[(2 * (32 * h + i)) * 33] = t[i] * scale; }
    asm volatile("s_waitcnt lgkmcnt(0)" ::: "memory");
    const int c = lane & 7;
#pragma unroll
    for (int j = 0; j < 4; ++j) { const int n = (lane >> 3) + 8 * j; const LAS float* s = scr + (16 * c) * 33 + n;
        u32x4 o; o.x = pk4_fp8(s[0 * 33], s[1 * 33], s[2 * 33], s[3 * 33]); o.y = pk4_fp8(s[4 * 33], s[5 * 33], s[6 * 33], s[7 * 33]);
        o.z = pk4_fp8(s[8 * 33], s[9 * 33], s[10 * 33], s[11 * 33]); o.w = pk4_fp8(s[12 * 33], s[13 * 33], s[14 * 33], s[15 * 33]);
        *(u32x4*)(WT + (size_t)(dst_row0 + n) * K + k0 + 16 * c) = o; }
    asm volatile("s_waitcnt lgkmcnt(0)" ::: "memory");
}
__device__ __forceinline__ void rms_row_to_bf16(const float* xrow, const float* g, bf16_t* orow, int lane) {
    const f32x4* xr = (const f32x4*)xrow + lane; const f32x4* gr = (const f32x4*)g + lane;
    f32x4 v[4]; float s = 0.f;
#pragma unroll
    for (int j = 0; j < 4; ++j) { v[j] = xr[64 * j]; s += (v[j].x * v[j].x + v[j].y * v[j].y) + (v[j].z * v[j].z + v[j].w * v[j].w); }
    const float rstd = 1.0f / sqrtf(wave_sum(s) * (1.0f / D) + EPS);
    u32x2* o8 = (u32x2*)orow + lane;
#pragma unroll
    for (int j = 0; j < 4; ++j) { const f32x4 gg = gr[64 * j]; u32x2 o; o.x = pkbf(v[j].x * rstd * gg.x, v[j].y * rstd * gg.y); o.y = pkbf(v[j].z * rstd * gg.z, v[j].w * rstd * gg.w); o8[64 * j] = o; }
}
__device__ __forceinline__ void p0_prologue(Frame& F) {
    LAS float* scr = (LAS float*)(F.lds + F.wave * 17408);
    const int gw = F.vcu * 8 + F.wave, NGW = F.G * 8;
    constexpr int I_IN = 16 * 64, I_OUT = 16 * 32, I_PG = 16 * 32, I_PP = 4 * 32, I_E = EXPERT_FP8 ? 512 : 1024;
    constexpr int NSMALL = I_IN + I_OUT + I_PG + I_PP, NITEMS = NSMALL + 3 * 16 * I_E;
    bf16_t* Win_t = WSP(bf16_t, WS_WIN); bf16_t* Wout_t = WSP(bf16_t, WS_WOUT); bf16_t* Wpg_t = WSP(bf16_t, WS_WPG); bf16_t* Wpp_t = WSP(bf16_t, WS_WPP);
    bf16_t* Wgu_t = WSP(bf16_t, WS_WGU); bf16_t* Wd_t = WSP(bf16_t, WS_WD);
    const int nitems = (EXPERT_FP8 && F.G == 256) ? NSMALL : NITEMS;
    for (int it = gw; it < nitems; it += NGW) {
        int r = it;
        if (r < I_IN) { tr_item(F_w_in, 1024, 2048, Win_t, r / 64, r % 64, 32 * (r % 64), scr, F.lane); continue; } r -= I_IN;
        if (r < I_OUT) { tr_item(F_w_out, 1024, 1024, Wout_t, r / 32, r % 32, 32 * (r % 32), scr, F.lane); continue; } r -= I_OUT;
        if (r < I_PG) { tr_item(F_w_ple_gate, 1024, 1024, Wpg_t, r / 32, r % 32, 32 * (r % 32), scr, F.lane); continue; } r -= I_PG;
        if (r < I_PP) { tr_item(F_w_ple_proj, 256, 1024, Wpp_t, r / 32, r % 32, 32 * (r % 32), scr, F.lane); continue; } r -= I_PP;
        const int mat = r / (16 * I_E), e = (r / I_E) % 16, q = r % I_E;
#if EXPERT_FP8
        unsigned char* Wgu8 = WSP(unsigned char, WS_WGU); unsigned char* Wd8 = WSP(unsigned char, WS_WD);
        if (mat < 2) { const int kb = q / 64, nb = q % 64, n0 = 32 * nb;
            tr_item8((mat == 0 ? F_w_gate : F_w_up) + (size_t)e * 1024 * 2048, 1024, 2048, Wgu8, kb, nb, e * 4096 + (n0 >> 7) * 256 + ((n0 >> 5) & 3) * 64 + 32 * mat, mat == 1 ? FP8_WSCALE * FP8_HSCALE : FP8_WSCALE, scr, F.lane);
        } else { const int kb = q / 32, nb = q % 32;
            tr_item8(F_w_down + (size_t)e * 2048 * 1024, 2048, 1024, Wd8, kb, nb, e * 1024 + 32 * nb, FP8_WSCALE, scr, F.lane); }
        continue;
#endif
        if (mat < 2) {
            const int kb = q / 64, nb = q % 64, n0 = 32 * nb;
            tr_item((mat == 0 ? F_w_gate : F_w_up) + (size_t)e * 1024 * 2048, 1024, 2048, Wgu_t, kb, nb, e * 4096 + (n0 >> 7) * 256 + ((n0 >> 5) & 3) * 64 + 32 * mat, scr, F.lane);
        } else {
            const int kb = q / 32, nb = q % 32;
            tr_item(F_w_down + (size_t)e * 2048 * 1024, 2048, 1024, Wd_t, kb, nb, e * 1024 + 32 * nb, scr, F.lane);
        }
    }
    bf16_t* XN = WSP(bf16_t, WS_XN);
    for (int m = gw; m < T; m += NGW) rms_row_to_bf16(F_x + (size_t)m * D, F_norm_mix, XN + (size_t)m * D, F.lane);
    { const int gt = F.vcu * 512 + F.tid, NT_ = F.G * 512; const f32x4* p4 = (const f32x4*)F_p; u32x2* o = WSP(u32x2, WS_PB);
      for (int i = gt; i < T * PD / 4; i += NT_) { const f32x4 v = p4[i]; u32x2 w; w.x = pkbf(v.x, v.y); w.y = pkbf(v.z, v.w); o[i] = w; }
      bf16_t* Wp = WSP(bf16_t, WS_WPOOL);
      for (int i = gt; i < 4 * 128 * 128; i += NT_) { const int gg = i >> 14, n = (i >> 7) & 127, k = i & 127; const float v = F_w_pool[(gg * 128 + k) * 128 + n] * F_pool_scale[gg * 128 + n]; Wp[i] = (bf16_t)(pkbf(v, 0.f) & 0xffffu); }
    }
}

#if EXPERT_FP8
struct CvTile { const float* src; unsigned char* dst; int N, K; bool up; };
__device__ __forceinline__ bool cv_decode(const Frame& F, int tile, int lane, CvTile& t) {
    const int mat = tile >> 14, e = (tile >> 10) & 15, q = tile & 1023; const int i = lane & 15, g = lane >> 4;
    int kb, nb, N, K, drow; const float* W; unsigned char* WT;
    if (mat < 2) { kb = q >> 6; nb = q & 63; N = 2048; K = 1024; W = (mat == 0 ? F_w_gate : F_w_up) + (size_t)e * 1024 * 2048; WT = WSP(unsigned char, WS_WGU);
        const int n0 = 32 * nb; drow = e * 4096 + (n0 >> 7) * 256 + ((n0 >> 5) & 3) * 64 + 32 * mat; }
    else { kb = q >> 5; nb = q & 31; N = 1024; K = 2048; W = F_w_down + (size_t)e * 2048 * 1024; WT = WSP(unsigned char, WS_WD); drow = e * 1024 + 32 * nb; }
    t.src = W + (size_t)(64 * kb + 16 * (i >> 2) + (i & 3)) * N + 32 * nb + 8 * g;
    t.dst = WT + (size_t)(drow + i) * K + 64 * kb + 16 * g;
    t.N = N; t.K = K; t.up = (mat == 1); return true;
}
__device__ __forceinline__ void p1_convert_experts(Frame& F, int cw, int ncw) {
    const int lane = F.lane, i = lane & 15, g = lane >> 4;
    bf16x8 s32[2], s256[2];
#pragma unroll
    for (int h = 0; h < 2; ++h)
#pragma unroll
        for (int j = 0; j < 8; ++j) { const bool on = (8 * g + j) == (i + 16 * h); s32[h][j] = on ? (short)0x4200 : (short)0; s256[h][j] = on ? (short)0x4380 : (short)0; }
    f32x4 bA[8], bB[8], bC[8]; CvTile tA, tB, tC;
    const int last = cw + ((3 * 16 * 1024 - 1 - cw) / ncw) * ncw;
#define CV_LOAD(buf, tt, tile) do { const int t_ = (tile) < last ? (tile) : last; (void)cv_decode(F, t_, lane, tt); _Pragma("unroll") for (int m = 0; m < 4; ++m) { const float* p_ = tt.src + (size_t)(4 * m) * tt.N; buf[2 * m] = *(const f32x4*)p_; buf[2 * m + 1] = *(const f32x4*)(p_ + 4); } } while (0)
#define CV_PROC(buf, tt) do { f32x4 d0[4], d1[4]; const bf16x8 sl0 = tt.up ? s256[0] : s32[0], sl1 = tt.up ? s256[1] : s32[1]; \
        _Pragma("unroll") for (int m = 0; m < 4; ++m) { u32x4 aw; aw.x = pkbf(buf[2 * m][0], buf[2 * m][1]); aw.y = pkbf(buf[2 * m][2], buf[2 * m][3]); aw.z = pkbf(buf[2 * m + 1][0], buf[2 * m + 1][1]); aw.w = pkbf(buf[2 * m + 1][2], buf[2 * m + 1][3]); \
            const bf16x8 af = __builtin_bit_cast(bf16x8, aw); const f32x4 z = (f32x4){0.f, 0.f, 0.f, 0.f}; \
            d0[m] = __builtin_amdgcn_mfma_f32_16x16x32_bf16(af, sl0, z, 0, 0, 0); d1[m] = __builtin_amdgcn_mfma_f32_16x16x32_bf16(af, sl1, z, 0, 0, 0); } \
        u32x4 o0, o1; o0.x = pk4_fp8(d0[0][0], d0[0][1], d0[0][2], d0[0][3]); o0.y = pk4_fp8(d0[1][0], d0[1][1], d0[1][2], d0[1][3]); o0.z = pk4_fp8(d0[2][0], d0[2][1], d0[2][2], d0[2][3]); o0.w = pk4_fp8(d0[3][0], d0[3][1], d0[3][2], d0[3][3]); \
        o1.x = pk4_fp8(d1[0][0], d1[0][1], d1[0][2], d1[0][3]); o1.y = pk4_fp8(d1[1][0], d1[1][1], d1[1][2], d1[1][3]); o1.z = pk4_fp8(d1[2][0], d1[2][1], d1[2][2], d1[2][3]); o1.w = pk4_fp8(d1[3][0], d1[3][1], d1[3][2], d1[3][3]); \
        *(u32x4*)tt.dst = o0; *(u32x4*)(tt.dst + (size_t)16 * tt.K) = o1; } while (0)
    int tile = cw;
    CV_LOAD(bA, tA, tile); CV_LOAD(bB, tB, tile + ncw);
    for (; tile <= last; tile += 3 * ncw) {
        CV_LOAD(bC, tC, tile + 2 * ncw); CV_PROC(bA, tA);
        CV_LOAD(bA, tA, tile + 3 * ncw); CV_PROC(bB, tB);
        CV_LOAD(bB, tB, tile + 4 * ncw); CV_PROC(bC, tC);
    }
#undef CV_LOAD
#undef CV_PROC
}
#endif

typedef f32x4 AccT[2][2][4][2];
struct EpiQKV {
    static constexpr bool AFTER_DRAIN = false;
    bf16_t *U, *Q, *Kk, *VT; const float *qn, *kn;
    __device__ __forceinline__ void operator()(const AccT& acc, const pg8::Unit& u, int wr, int wc, int, int) const {
        int ln_ = (int)__builtin_amdgcn_mbcnt_hi(~0u, __builtin_amdgcn_mbcnt_lo(~0u, 0u)); asm volatile("" : "+v"(ln_));
        const int fr = ln_ & 15, fq = ln_ >> 4;
        const int type = u.pn >> 1; const int row0 = u.pm * 256 + wr * 64 + fr;
        if (type == 0) {
#pragma unroll
            for (int ai = 0; ai < 2; ++ai)
#pragma unroll
                for (int m = 0; m < 4; ++m) { const int row = row0 + ai * 128 + m * 16; bf16_t* rp = U + (size_t)row * 512 + (u.pn & 1) * 256 + wc * 64 + 8 * fq;
#pragma unroll
                    for (int bj = 0; bj < 2; ++bj) { const f32x4 v0 = acc[ai][bj][m][0], v1 = acc[ai][bj][m][1]; u32x4 w; w.x = pkbf(v0[0], v0[1]); w.y = pkbf(v0[2], v0[3]); w.z = pkbf(v1[0], v1[1]); w.w = pkbf(v1[2], v1[3]); *(u32x4*)(rp + bj * 32) = w; } asm volatile("" ::: "memory"); }
        } else if (type == 3) {
            const int hh = (u.pn & 1) * 4 + wc; const int t = fr & 3; const bool o1 = (t & 1) != 0, o2 = (t & 2) != 0;
#pragma unroll
            for (int ai = 0; ai < 2; ++ai)
#pragma unroll
                for (int m = 0; m < 4; ++m) { const int row = u.pm * 256 + wr * 64 + ai * 128 + m * 16 + (fr & 12); const int b = row >> 11, s_ = row & 2047;
                    bf16_t* bp = VT + ((size_t)((b * 8 + hh) * 32 + (s_ >> 6)) * 64 + 8 * fq + t) * 64 + (s_ & 63);
#pragma unroll
                    for (int bj = 0; bj < 2; ++bj)
#pragma unroll
                        for (int n = 0; n < 2; ++n) { const f32x4 x = acc[ai][bj][m][n];
                            const float p0 = __builtin_bit_cast(float, __builtin_amdgcn_update_dpp(0, __builtin_bit_cast(int, o1 ? x[0] : x[1]), 0xB1, 0xF, 0xF, false));
                            const float p1 = __builtin_bit_cast(float, __builtin_amdgcn_update_dpp(0, __builtin_bit_cast(int, o1 ? x[2] : x[3]), 0xB1, 0xF, 0xF, false));
                            const float y0 = o1 ? p0 : x[0], y1 = o1 ? x[1] : p0, y2 = o1 ? p1 : x[2], y3 = o1 ? x[3] : p1;
                            const float q0 = __builtin_bit_cast(float, __builtin_amdgcn_update_dpp(0, __builtin_bit_cast(int, o2 ? y0 : y2), 0x4E, 0xF, 0xF, false));
                            const float q1 = __builtin_bit_cast(float, __builtin_amdgcn_update_dpp(0, __builtin_bit_cast(int, o2 ? y1 : y3), 0x4E, 0xF, 0xF, false));
                            const float z0 = o2 ? q0 : y0, z1 = o2 ? q1 : y1, z2 = o2 ? y2 : q0, z3 = o2 ? y3 : q1;
                            u32x2 w; w.x = pkbf(z0, z1); w.y = pkbf(z2, z3);
                            *(u32x2*)(bp + (32 * bj + 4 * n) * 64) = w; }
                    asm volatile("" ::: "memory"); }
        } else {
            const int hh = (u.pn & 1) * 4 + wc; const float* gn = (type == 1) ? qn : kn; const float sc = (type == 1) ? 0.125f * LOG2E : 1.0f; bf16_t* dst = (type == 1) ? Q : Kk;
            f32x4 gv[2][2];
#pragma unroll
            for (int bj = 0; bj < 2; ++bj)
#pragma unroll
                for (int n = 0; n < 2; ++n) gv[bj][n] = *(const f32x4*)(gn + 32 * bj + 8 * fq + 4 * n) * sc;
#pragma unroll
            for (int ai = 0; ai < 2; ++ai)
#pragma unroll
                for (int m = 0; m < 4; ++m) { const int row = row0 + ai * 128 + m * 16; const int b = row >> 11, s = row & 2047;
                    float ss = 0.f;
#pragma unroll
                    for (int bj = 0; bj < 2; ++bj)
#pragma unroll
                        for (int n = 0; n < 2; ++n) { const f32x4 v = acc[ai][bj][m][n]; ss += (v[0] * v[0] + v[1] * v[1]) + (v[2] * v[2] + v[3] * v[3]); }
                    ss += __shfl_xor(ss, 16); ss += __shfl_xor(ss, 32);
                    const float rstd = 1.0f / sqrtf(ss * (1.0f / 64.0f) + EPS);
                    bf16_t* rp = dst + ((size_t)(b * 8 + hh) * 2048 + s) * 64 + 8 * fq;
#pragma unroll
                    for (int bj = 0; bj < 2; ++bj) { const f32x4 v0 = acc[ai][bj][m][0] * gv[bj][0] * rstd, v1 = acc[ai][bj][m][1] * gv[bj][1] * rstd; u32x4 w; w.x = pkbf(v0[0], v0[1]); w.y = pkbf(v0[2], v0[3]); w.z = pkbf(v1[0], v1[1]); w.w = pkbf(v1[2], v1[3]); *(u32x4*)(rp + bj * 32) = w; } asm volatile("" ::: "memory"); }
        }
    }
};
struct EpiE {
    static constexpr bool AFTER_DRAIN = false;
    bf16_t* EB; float* esq;
    __device__ __forceinline__ void operator()(const AccT& acc, const pg8::Unit& u, int wr, int wc, int, int) const {
        int ln_ = (int)__builtin_amdgcn_mbcnt_hi(~0u, __builtin_amdgcn_mbcnt_lo(~0u, 0u)); asm volatile("" : "+v"(ln_));
        const int fr = ln_ & 15, fq = ln_ >> 4;
        const int row0 = u.pm * 256 + wr * 64 + fr;
#pragma unroll
        for (int ai = 0; ai < 2; ++ai)
#pragma unroll
            for (int m = 0; m < 4; ++m) { const int row = row0 + ai * 128 + m * 16; bf16_t* rp = EB + (size_t)row * 1024 + u.pn * 256 + wc * 64 + 8 * fq; float ss = 0.f;
#pragma unroll
                for (int bj = 0; bj < 2; ++bj) { const f32x4 v0 = acc[ai][bj][m][0], v1 = acc[ai][bj][m][1];
                    ss += (v0[0] * v0[0] + v0[1] * v0[1]) + (v0[2] * v0[2] + v0[3] * v0[3]) + (v1[0] * v1[0] + v1[1] * v1[1]) + (v1[2] * v1[2] + v1[3] * v1[3]);
                    u32x4 w; w.x = pkbf(v0[0], v0[1]); w.y = pkbf(v0[2], v0[3]); w.z = pkbf(v1[0], v1[1]); w.w = pkbf(v1[2], v1[3]); *(u32x4*)(rp + bj * 32) = w; }
                ss += __shfl_xor(ss, 16); ss += __shfl_xor(ss, 32);
                if (fq == 0) esq[(size_t)row * 16 + u.pn * 4 + wc] = ss; asm volatile("" ::: "memory"); }
    }
};
struct EpiRes {
    static constexpr bool AFTER_DRAIN = false;
    const float* x; float* out;
    __device__ __forceinline__ void operator()(const AccT& acc, const pg8::Unit& u, int wr, int wc, int, int) const {
        int ln_ = (int)__builtin_amdgcn_mbcnt_hi(~0u, __builtin_amdgcn_mbcnt_lo(~0u, 0u)); asm volatile("" : "+v"(ln_));
        const int fr = ln_ & 15, fq = ln_ >> 4;
        const int row0 = u.pm * 256 + wr * 64 + fr; const int col0 = u.pn * 256 + wc * 64 + 8 * fq;
#pragma unroll
        for (int ai = 0; ai < 2; ++ai)
#pragma unroll
            for (int m = 0; m < 4; ++m) { const size_t off = (size_t)(row0 + ai * 128 + m * 16) * 1024 + col0;
#pragma unroll
                for (int bj = 0; bj < 2; ++bj)
#pragma unroll
                    for (int n = 0; n < 2; ++n) { const f32x4 xv = *(const f32x4*)(x + off + bj * 32 + n * 4); *(f32x4*)(out + off + bj * 32 + n * 4) = xv + acc[ai][bj][m][n]; }
                if (m & 1) asm volatile("" ::: "memory"); }
    }
};
struct EpiX1 {
    static constexpr bool AFTER_DRAIN = true;
    const float* x; const float* gffn; const float* wrt; bf16_t* H2; float* part;
    __device__ __forceinline__ void fused(AccT& acc, const pg8::Unit& u, LAS unsigned char* lds, int wid) const {
        const int tid = threadIdx.x; int ln_ = (int)__builtin_amdgcn_mbcnt_hi(~0u, __builtin_amdgcn_mbcnt_lo(~0u, 0u)); asm volatile("" : "+v"(ln_));
        const int fr = ln_ & 15, fq = ln_ >> 4, wr_ = wid >> 2, wc = wid & 3;
        LAS bf16_t* whi = (LAS bf16_t*)lds; LAS bf16_t* wlo = (LAS bf16_t*)(lds + 8448); LAS float* P = (LAS float*)(lds + 16896);
        constexpr int WP = 264, PR = 68;
#pragma unroll
        for (int k = 0; k < 8; ++k) { const int idx = tid + 512 * k, ct = idx >> 4, e = idx & 15; const float wv = wrt[(size_t)(u.pn * 256 + ct) * 16 + e];
            const unsigned hb = pkbf(wv, 0.f) & 0xffffu; const float hf = __builtin_bit_cast(float, hb << 16);
            whi[e * WP + ct] = (bf16_t)hb; wlo[e * WP + ct] = (bf16_t)(pkbf(wv - hf, 0.f) & 0xffffu); }
        const int row0 = u.pm * 256 + wr_ * 64 + fr, col0 = u.pn * 256 + wc * 64 + 8 * fq;
        f32x4 gv[2][2];
#pragma unroll
        for (int bj = 0; bj < 2; ++bj)
#pragma unroll
            for (int n = 0; n < 2; ++n) gv[bj][n] = *(const f32x4*)(gffn + col0 + bj * 32 + n * 4);
        f32x4 xn[2][2];
#define X1_LOADX(ai, m) do { const float* xp_ = x + (size_t)(row0 + (ai) * 128 + (m) * 16) * 1024 + col0; _Pragma("unroll") for (int bj = 0; bj < 2; ++bj) _Pragma("unroll") for (int n = 0; n < 2; ++n) xn[bj][n] = *(const f32x4*)(xp_ + bj * 32 + n * 4); } while (0)
        X1_LOADX(0, 0);
        asm volatile("s_waitcnt lgkmcnt(0)" ::: "memory"); __syncthreads();
        bf16x8 ahi[2], alo[2];
#pragma unroll
        for (int bj = 0; bj < 2; ++bj) { ahi[bj] = *(const LAS bf16x8*)(whi + fr * WP + wc * 64 + 32 * bj + 8 * fq); alo[bj] = *(const LAS bf16x8*)(wlo + fr * WP + wc * 64 + 32 * bj + 8 * fq); }
#pragma unroll
        for (int ai = 0; ai < 2; ++ai)
#pragma unroll
            for (int m = 0; m < 4; ++m) {
                f32x4 x1[2][2];
#pragma unroll
                for (int bj = 0; bj < 2; ++bj)
#pragma unroll
                    for (int n = 0; n < 2; ++n) x1[bj][n] = acc[ai][bj][m][n] + xn[bj][n];
                asm volatile("" : "+v"(x1[0][0]), "+v"(x1[0][1]), "+v"(x1[1][0]), "+v"(x1[1][1]));
                if (ai * 4 + m < 7) { const int g2 = ai * 4 + m + 1; X1_LOADX(g2 >> 2, g2 & 3); }
                float ss = 0.f; f32x4 pl = (f32x4){0.f, 0.f, 0.f, 0.f};
                bf16_t* rp = H2 + (size_t)(row0 + ai * 128 + m * 16) * 1024 + col0;
#pragma unroll
                for (int bj = 0; bj < 2; ++bj) { f32x4 h0, h1;
                    { const f32x4 v = x1[bj][0]; ss += (v[0] * v[0] + v[1] * v[1]) + (v[2] * v[2] + v[3] * v[3]); h0 = v * gv[bj][0]; }
                    { const f32x4 v = x1[bj][1]; ss += (v[0] * v[0] + v[1] * v[1]) + (v[2] * v[2] + v[3] * v[3]); h1 = v * gv[bj][1]; }
                    u32x4 wh; wh.x = pkbf(h0[0], h0[1]); wh.y = pkbf(h0[2], h0[3]); wh.z = pkbf(h1[0], h1[1]); wh.w = pkbf(h1[2], h1[3]);
                    *(u32x4*)(rp + bj * 32) = wh;
                    u32x4 wl; wl.x = pkbf(h0[0] - bflo(wh.x), h0[1] - bfhi(wh.x)); wl.y = pkbf(h0[2] - bflo(wh.y), h0[3] - bfhi(wh.y)); wl.z = pkbf(h1[0] - bflo(wh.z), h1[1] - bfhi(wh.z)); wl.w = pkbf(h1[2] - bflo(wh.w), h1[3] - bfhi(wh.w));
                    const bf16x8 bh = __builtin_bit_cast(bf16x8, wh), bl = __builtin_bit_cast(bf16x8, wl);
                    pl = __builtin_amdgcn_mfma_f32_16x16x32_bf16(ahi[bj], bh, pl, 0, 0, 0); pl = __builtin_amdgcn_mfma_f32_16x16x32_bf16(ahi[bj], bl, pl, 0, 0, 0); pl = __builtin_amdgcn_mfma_f32_16x16x32_bf16(alo[bj], bh, pl, 0, 0, 0); }
                ss += __shfl_xor(ss, 16); ss += __shfl_xor(ss, 32);
                LAS float* pp = P + (ai * 128 + wr_ * 64 + m * 16 + fr) * PR;
                *(LAS f32x4*)(pp + wc * 16 + 4 * fq) = pl;
                if (fq == 0) pp[64 + wc] = ss;
                __builtin_amdgcn_sched_barrier(0); }
#undef X1_LOADX
        asm volatile("s_waitcnt lgkmcnt(0)" ::: "memory"); __syncthreads();
        if (tid < 256) { const LAS f32x4* p4 = (const LAS f32x4*)(P + tid * PR); float tot[20];
            const f32x4 s4 = p4[16]; tot[0] = (s4[0] + s4[1]) + (s4[2] + s4[3]);
#pragma unroll
            for (int q = 0; q < 4; ++q) { const f32x4 t4 = (p4[q] + p4[4 + q]) + (p4[8 + q] + p4[12 + q]); tot[1 + 4 * q] = t4[0]; tot[2 + 4 * q] = t4[1]; tot[3 + 4 * q] = t4[2]; tot[4 + 4 * q] = t4[3]; }
            tot[17] = 0.f; tot[18] = 0.f; tot[19] = 0.f;
            f32x4* dst = (f32x4*)(part + ((size_t)(u.pm * 256 + tid) * 4 + u.pn) * 20);
#pragma unroll
            for (int k = 0; k < 5; ++k) dst[k] = (f32x4){tot[4 * k], tot[4 * k + 1], tot[4 * k + 2], tot[4 * k + 3]}; }
    }
};
struct EpiGU {
    static constexpr bool AFTER_DRAIN = false;
    bf16_t* HH;
    __device__ __forceinline__ void operator()(const AccT& acc, const pg8::Unit& u, int wr, int wc, int, int) const {
        int ln_ = (int)__builtin_amdgcn_mbcnt_hi(~0u, __builtin_amdgcn_mbcnt_lo(~0u, 0u)); asm volatile("" : "+v"(ln_));
        const int fr = ln_ & 15, fq = ln_ >> 4;
        const int row0 = u.arow + wr * 64 + fr; const int col0 = u.pn * 128 + wc * 32 + 8 * fq;
#pragma unroll
        for (int ai = 0; ai < 2; ++ai)
#pragma unroll
            for (int m = 0; m < 4; ++m) { float h[8];
#pragma unroll
                for (int n = 0; n < 2; ++n)
#pragma unroll
                    for (int i = 0; i < 4; ++i) { const float a = acc[ai][0][m][n][i], b = acc[ai][1][m][n][i]; h[4 * n + i] = a * __builtin_amdgcn_rcpf(1.0f + __builtin_amdgcn_exp2f(-LOG2E * a)) * b; }
#if EXPERT_FP8
#pragma unroll
                for (int q = 0; q < 8; ++q) h[q] = __builtin_amdgcn_fmed3f(h[q], -448.f, 448.f);
                u32x2 w; w.x = pk4_fp8(h[0], h[1], h[2], h[3]); w.y = pk4_fp8(h[4], h[5], h[6], h[7]);
                *(u32x2*)((unsigned char*)HH + (size_t)(row0 + ai * 128 + m * 16) * 2048 + col0) = w; __builtin_amdgcn_sched_barrier(0); }
#else
                u32x4 w; w.x = pkbf(h[0], h[1]); w.y = pkbf(h[2], h[3]); w.z = pkbf(h[4], h[5]); w.w = pkbf(h[6], h[7]);
                *(u32x4*)(HH + (size_t)(row0 + ai * 128 + m * 16) * 2048 + col0) = w; }
#endif
    }
};
struct EpiDown {
    static constexpr bool AFTER_DRAIN = false;
    bf16_t* YE; const float* gates;
    __device__ __forceinline__ void operator()(const AccT& acc, const pg8::Unit& u, int wr, int wc, int, int) const {
        int ln_ = (int)__builtin_amdgcn_mbcnt_hi(~0u, __builtin_amdgcn_mbcnt_lo(~0u, 0u)); asm volatile("" : "+v"(ln_));
        const int fr = ln_ & 15, fq = ln_ >> 4;
        const int row0 = u.arow + wr * 64 + fr; const int col0 = u.pn * 256 + wc * 64 + 8 * fq;
#pragma unroll
        for (int ai = 0; ai < 2; ++ai)
#pragma unroll
            for (int m = 0; m < 4; ++m) { const int row = row0 + ai * 128 + m * 16; const float gt = gates[row]; bf16_t* rp = YE + (size_t)row * 1024 + col0;
#pragma unroll
                for (int bj = 0; bj < 2; ++bj) { const f32x4 v0 = acc[ai][bj][m][0] * gt, v1 = acc[ai][bj][m][1] * gt; u32x4 w; w.x = pkbf(v0[0], v0[1]); w.y = pkbf(v0[2], v0[3]); w.z = pkbf(v1[0], v1[1]); w.w = pkbf(v1[2], v1[3]); *(u32x4*)(rp + bj * 32) = w; } __builtin_amdgcn_sched_barrier(0); }
    }
};
struct EpiFinal {
    static constexpr bool AFTER_DRAIN = false;
    float* outw; const bf16_t* X2N; const bf16_t* EB; const float* rstde; const float* rms2; const float* gpost; const float* gple;
    __device__ __forceinline__ void operator()(const AccT& acc, const pg8::Unit& u, int wr, int wc, int, int) const {
        int ln_ = (int)__builtin_amdgcn_mbcnt_hi(~0u, __builtin_amdgcn_mbcnt_lo(~0u, 0u)); asm volatile("" : "+v"(ln_));
        const int fr = ln_ & 15, fq = ln_ >> 4;
        const int row0 = u.pm * 256 + wr * 64 + fr; const int col0 = u.pn * 256 + wc * 64 + 8 * fq;
        f32x4 gp[2][2], gi[2][2];
#pragma unroll
        for (int bj = 0; bj < 2; ++bj)
#pragma unroll
            for (int n = 0; n < 2; ++n) { gp[bj][n] = *(const f32x4*)(gpost + col0 + bj * 32 + n * 4); const f32x4 gg = *(const f32x4*)(gple + col0 + bj * 32 + n * 4);
                gi[bj][n] = (f32x4){1.0f / gg[0], 1.0f / gg[1], 1.0f / gg[2], 1.0f / gg[3]}; }
#pragma unroll
        for (int ai = 0; ai < 2; ++ai)
#pragma unroll
            for (int m = 0; m < 4; ++m) { const int row = row0 + ai * 128 + m * 16; const size_t off = (size_t)row * 1024 + col0; const float re = rstde[row], rm = rms2[row];
#pragma unroll
                for (int bj = 0; bj < 2; ++bj) { const u32x4 ev = *(const u32x4*)(EB + off + bj * 32); const u32x4 xv = *(const u32x4*)(X2N + off + bj * 32);
                    const f32x4 e0 = (f32x4){bflo(ev.x), bfhi(ev.x), bflo(ev.y), bfhi(ev.y)} * gp[bj][0] * re, e1 = (f32x4){bflo(ev.z), bfhi(ev.z), bflo(ev.w), bfhi(ev.w)} * gp[bj][1] * re;
                    const f32x4 x0 = (f32x4){bflo(xv.x), bfhi(xv.x), bflo(xv.y), bfhi(xv.y)} * gi[bj][0] * rm, x1 = (f32x4){bflo(xv.z), bfhi(xv.z), bflo(xv.w), bfhi(xv.w)} * gi[bj][1] * rm;
                    const f32x4 a0 = acc[ai][bj][m][0], a1 = acc[ai][bj][m][1]; f32x4 g0, g1;
#pragma unroll
                    for (int i = 0; i < 4; ++i) { g0[i] = __builtin_amdgcn_rcpf(1.0f + __builtin_amdgcn_exp2f(-LOG2E * a0[i])); g1[i] = __builtin_amdgcn_rcpf(1.0f + __builtin_amdgcn_exp2f(-LOG2E * a1[i])); }
                    *(f32x4*)(outw + off + bj * 32) = x0 + g0 * e0; *(f32x4*)(outw + off + bj * 32 + 4) = x1 + g1 * e1; }
                asm volatile("" ::: "memory"); __builtin_amdgcn_sched_barrier(0); }
    }
};
struct OrderGU {
    int G, vcu;
    __device__ bool next(int i, pg8::Unit& u) const {
        int e, b, nt;
        if (G == 256) { if (i >= 8) return false; const int x = vcu >> 5, cu = vcu & 31; e = 2 * x + (i >> 2); b = cu & 7; nt = 4 * (i & 3) + (cu >> 3); }
        else { const int L = i * G + vcu; if (L >= 2048) return false; e = L >> 7; b = L & 7; nt = (L >> 3) & 15; }
        u.arow = (b * 16 + e) * 256; u.brow = e * 4096 + nt * 256; u.pm = b; u.pn = nt; u.grp = e; return true;
    }
};
struct OrderDown {
    int G, vcu;
    __device__ bool next(int i, pg8::Unit& u) const {
        int e, b, nt;
        if (G == 256) { if (i >= 2) return false; const int x = vcu >> 5, cu = vcu & 31; e = 2 * x + i; b = cu & 7; nt = cu >> 3; }
        else { const int L = i * G + vcu; if (L >= 512) return false; e = L >> 5; b = L & 7; nt = (L >> 3) & 3; }
        u.arow = (b * 16 + e) * 256; u.brow = e * 1024 + nt * 256; u.pm = b; u.pn = nt; u.grp = e; return true;
    }
};

constexpr int UT_OFF = 32768, UT_PITCH = 136, UT_ROWS = 272;
constexpr int AT_KOFF = 0, AT_VOFF = 9 * 8192, AT_B2OFF = 18 * 8192, AT_SCR = AT_B2OFF + 2048;
static_assert(AT_SCR + 2 * 17 * 64 * 4 <= LDSCTL_OFF, "attention LDS map");
__device__ __forceinline__ int at_fk(int row) { return ((row >> 1) & 1) | (((row >> 3) & 3) << 1); }
__device__ __forceinline__ int at_fv(int row) { return (row >> 1) & 7; }
__device__ __forceinline__ void attn_block(Frame& F, int bh, int r0) {
    const int tid = F.tid, lane = F.lane, g = lane >> 4, m = lane & 15, w = F.wave; const int b = bh >> 3, h = bh & 7;
    const int qb = (w == 0) ? 0 : (w <= 2) ? 1 : (w <= 4) ? 2 : 3; const int kp = (w == 0) ? 0 : (w == 5) ? 1 : ((w - 1) & 1); const bool active = w < 6;
    LAS float* b2 = (LAS float*)(F.lds + AT_B2OFF);
    for (int i = tid; i < 15 * 32; i += 512) { const int dc = i & 31; b2[i] = dc < 31 ? F_rpb[(h * 15 + (i >> 5)) * 31 + dc] * LOG2E : 0.f; }
    const int lrow = tid >> 3, lpos = tid & 7;
    const char* ksrc = (const char*)WSP(const bf16_t, WS_K) + ((size_t)bh * 2048 * 64 + (size_t)lrow * 64) * 2 + ((lpos ^ at_fk(lrow)) * 16);
    const char* vsrc = (const char*)WSP(const bf16_t, WS_VT) + ((size_t)bh * 32 * 4096 + (size_t)lrow * 64) * 2 + ((lpos ^ at_fv(lrow)) * 16);
#define AT_DMA(k) do { const int sl_ = (k) % 9; \
        __builtin_amdgcn_global_load_lds((const unsigned*)(ksrc + (size_t)(k) * 8192), (LAS unsigned*)(F.lds + AT_KOFF + sl_ * 8192 + w * 1024), 16, 0, 0); \
        __builtin_amdgcn_global_load_lds((const unsigned*)(vsrc + (size_t)(k) * 8192), (LAS unsigned*)(F.lds + AT_VOFF + sl_ * 8192 + w * 1024), 16, 0, 0); } while (0)
    int rs0 = r0 - 4; rs0 = rs0 < 0 ? 0 : (rs0 > ROWS - 8 ? ROWS - 8 : rs0);
    for (int k = rs0; k < rs0 + 8; ++k) AT_DMA(k);
    const int c = 16 * qb + m; int cs = c - 8; cs = cs < 0 ? 0 : (cs > GW - 16 ? GW - 16 : cs);
    const bf16_t* Qp = WSP(const bf16_t, WS_Q) + ((size_t)(bh * 2048 + 64 * r0 + c) * 64 + 8 * g);
    bf16x8 qn0 = *(const bf16x8*)Qp, qn1 = *(const bf16x8*)(Qp + 32);
    const int rowA = 32 * kp + 8 * (m >> 2) + (m & 3);
    const int kofs0 = rowA * 128 + ((g ^ at_fk(rowA)) * 16), kofs1 = rowA * 128 + (((4 + g) ^ at_fk(rowA)) * 16);
    const int vofs = m * 128 + (((4 * kp + g) ^ at_fv(m)) * 16);
    const int kc0 = 32 * kp + 8 * g;
    bf16_t* mixb = WSP(bf16_t, WS_MIX) + (size_t)(b * 2048) * 1024 + 512 + h * 64 + 4 * g + (size_t)c * 1024;
    LAS float* scr = (LAS float*)(F.lds + AT_SCR) + ((w - 1) >> 1) * (17 * 64) + lane;
    asm volatile("s_waitcnt vmcnt(0) lgkmcnt(0)" ::: "memory"); __syncthreads();
    for (int rr = 0; rr < 8; ++rr) {
        const int r = r0 + rr; int rs = r - 4; rs = rs < 0 ? 0 : (rs > ROWS - 8 ? ROWS - 8 : rs);
        int rsn = r - 3; rsn = rsn < 0 ? 0 : (rsn > ROWS - 8 ? ROWS - 8 : rsn);
        if (rr < 7 && rsn != rs) AT_DMA(rs + 8);
        f32x4 o[4]; float l = 0.f;
#pragma unroll
        for (int dt = 0; dt < 4; ++dt) o[dt] = (f32x4){0.f, 0.f, 0.f, 0.f};
        const bf16x8 q0 = qn0, q1 = qn1;
        if (active && rr < 7) { qn0 = *(const bf16x8*)(Qp + (size_t)(rr + 1) * 4096); qn1 = *(const bf16x8*)(Qp + (size_t)(rr + 1) * 4096 + 32); }
        int sl = rs % 9;
#define AT_STEP(i) do { const LAS unsigned char* kb_ = F.lds + AT_KOFF + sl * 8192; const LAS unsigned char* vb_ = F.lds + AT_VOFF + sl * 8192 + vofs; sl = (sl == 8) ? 0 : sl + 1; \
            const bf16x8 ka0 = *(const LAS bf16x8*)(kb_ + kofs0), ka1 = *(const LAS bf16x8*)(kb_ + kofs1), kb0 = *(const LAS bf16x8*)(kb_ + kofs0 + 512), kb1 = *(const LAS bf16x8*)(kb_ + kofs1 + 512); \
            bf16x8 vf[4]; _Pragma("unroll") for (int dt = 0; dt < 4; ++dt) vf[dt] = *(const LAS bf16x8*)(vb_ + dt * 2048); \
            f32x4 sa = (f32x4){0.f, 0.f, 0.f, 0.f}, sb = (f32x4){0.f, 0.f, 0.f, 0.f}; \
            sa = __builtin_amdgcn_mfma_f32_16x16x32_bf16(ka0, q0, sa, 0, 0, 0); sa = __builtin_amdgcn_mfma_f32_16x16x32_bf16(ka1, q1, sa, 0, 0, 0); \
            sb = __builtin_amdgcn_mfma_f32_16x16x32_bf16(kb0, q0, sb, 0, 0, 0); sb = __builtin_amdgcn_mfma_f32_16x16x32_bf16(kb1, q1, sb, 0, 0, 0); \
            const LAS float* bp = bp0 + (i) * 32; float pa[4], pb[4]; \
            _Pragma("unroll") for (int q = 0; q < 4; ++q) { const float ea = __builtin_amdgcn_exp2f(sa[q] + bp[q]), eb = __builtin_amdgcn_exp2f(sb[q] + bp[4 + q]); pa[q] = va[q] ? ea : 0.f; pb[q] = vb[q] ? eb : 0.f; } \
            l += ((pa[0] + pa[1]) + (pa[2] + pa[3])) + ((pb[0] + pb[1]) + (pb[2] + pb[3])); \
            u32x4 pw; pw.x = pkbf(pa[0], pa[1]); pw.y = pkbf(pa[2], pa[3]); pw.z = pkbf(pb[0], pb[1]); pw.w = pkbf(pb[2], pb[3]); const bf16x8 pf = __builtin_bit_cast(bf16x8, pw); \
            _Pragma("unroll") for (int dt = 0; dt < 4; ++dt) o[dt] = __builtin_amdgcn_mfma_f32_16x16x32_bf16(vf[dt], pf, o[dt], 0, 0, 0); } while (0)
        const LAS float* bp0 = b2 + ((rs - r + 7) * 32 + 15 - c + kc0);
        bool va[4], vb[4];
#pragma unroll
        for (int q = 0; q < 4; ++q) { va[q] = (unsigned)(kc0 + q - cs) < 16u; vb[q] = (unsigned)(kc0 + 4 + q - cs) < 16u; }
        if (active) { AT_STEP(0); AT_STEP(1); AT_STEP(2); AT_STEP(3); }
        asm volatile("s_waitcnt lgkmcnt(0)" ::: "memory"); __builtin_amdgcn_s_barrier(); asm volatile("" ::: "memory");
        if (active) { AT_STEP(4); AT_STEP(5); AT_STEP(6); AT_STEP(7); }
#undef AT_STEP
        l += __shfl_xor(l, 16); l += __shfl_xor(l, 32);
        if (w == 2 || w == 4) {
#pragma unroll
            for (int dt = 0; dt < 4; ++dt)
#pragma unroll
                for (int q = 0; q < 4; ++q) scr[(dt * 4 + q) * 64] = o[dt][q];
            scr[16 * 64] = l;
        }
        asm volatile("s_waitcnt vmcnt(0) lgkmcnt(0)" ::: "memory"); __syncthreads();
        if (w == 1 || w == 3) {
#pragma unroll
            for (int dt = 0; dt < 4; ++dt)
#pragma unroll
                for (int q = 0; q < 4; ++q) o[dt][q] += scr[(dt * 4 + q) * 64];
            l += scr[16 * 64];
        }
        if (w == 0 || w == 1 || w == 3 || w == 5) { const float inv = 1.0f / l; bf16_t* op = mixb + (size_t)(64 * r) * 1024;
#pragma unroll
            for (int dt = 0; dt < 4; ++dt) { u32x2 ww; ww.x = pkbf(o[dt][0] * inv, o[dt][1] * inv); ww.y = pkbf(o[dt][2] * inv, o[dt][3] * inv); *(u32x2*)(op + 16 * dt) = ww; } }
    }
#undef AT_DMA
    asm volatile("s_waitcnt lgkmcnt(0)" ::: "memory"); __syncthreads();
}
__device__ __forceinline__ void pool_unit(Frame& F, int pm, int grp) {
    LAS bf16_t* Ut = (LAS bf16_t*)(F.lds + UT_OFF);
    const int tid = F.tid; const int tok0 = pm * 256, b = tok0 >> 11, t0 = tok0 & 2047;
    {   const bf16_t* Ub = WSP(const bf16_t, WS_U) + (size_t)b * 2048 * 512 + grp * 128;
        for (int i = tid; i < UT_ROWS * 16; i += 512) { const int rr = i >> 4, ch = i & 15; const int t = t0 - 8 + rr;
            u32x4 v = (u32x4){0u, 0u, 0u, 0u}; if (t >= 0 && t < S) v = *(const u32x4*)(Ub + (size_t)t * 512 + ch * 8);
            *(LAS u32x4*)(Ut + rr * UT_PITCH + ch * 8) = v; } }
    __syncthreads();
    {   const int lane = F.lane, g = lane >> 4, m = lane & 15, w = F.wave; const int hw = 1 << grp;
        const bf16_t* Wp = WSP(const bf16_t, WS_WPOOL) + (size_t)grp * 128 * 128;
        f32x4 acc[2][8];
#pragma unroll
        for (int mt = 0; mt < 2; ++mt)
#pragma unroll
            for (int nt = 0; nt < 8; ++nt) acc[mt][nt] = (f32x4){0.f, 0.f, 0.f, 0.f};
        float rc[2];
#pragma unroll
        for (int mt = 0; mt < 2; ++mt) { const int t = t0 + 32 * w + 16 * mt + m; const int lo = (t - hw) < 0 ? 0 : (t - hw), hi = (t + hw - 1) > (S - 1) ? (S - 1) : (t + hw - 1); rc[mt] = 1.0f / (float)(hi - lo + 1); }
        for (int ks = 0; ks < 4; ++ks) { bf16x8 af[2];
#pragma unroll
            for (int mt = 0; mt < 2; ++mt) { const LAS bf16_t* up = Ut + (32 * w + 16 * mt + m + 8) * UT_PITCH + 32 * ks + 8 * g;
                float sm[8];
#pragma unroll
                for (int j = 0; j < 8; ++j) sm[j] = 0.f;
                for (int q = -hw; q < hw; ++q) { const u32x4 v = *(const LAS u32x4*)(up + q * UT_PITCH);
                    sm[0] += bflo(v.x); sm[1] += bfhi(v.x); sm[2] += bflo(v.y); sm[3] += bfhi(v.y); sm[4] += bflo(v.z); sm[5] += bfhi(v.z); sm[6] += bflo(v.w); sm[7] += bfhi(v.w); }
                const u32x4 uc = *(const LAS u32x4*)up; const float r_ = rc[mt];
                u32x4 d; d.x = pkbf(sm[0] * r_ - bflo(uc.x), sm[1] * r_ - bfhi(uc.x)); d.y = pkbf(sm[2] * r_ - bflo(uc.y), sm[3] * r_ - bfhi(uc.y));
                d.z = pkbf(sm[4] * r_ - bflo(uc.z), sm[5] * r_ - bfhi(uc.z)); d.w = pkbf(sm[6] * r_ - bflo(uc.w), sm[7] * r_ - bfhi(uc.w));
                af[mt] = __builtin_bit_cast(bf16x8, d); }
#pragma unroll
            for (int nt = 0; nt < 8; ++nt) { const bf16x8 wf = *(const bf16x8*)(Wp + (size_t)(16 * nt + m) * 128 + 32 * ks + 8 * g);
#pragma unroll
                for (int mt = 0; mt < 2; ++mt) acc[mt][nt] = __builtin_amdgcn_mfma_f32_16x16x32_bf16(wf, af[mt], acc[mt][nt], 0, 0, 0); } }
        bf16_t* mix = WSP(bf16_t, WS_MIX);
#pragma unroll
        for (int mt = 0; mt < 2; ++mt)
#pragma unroll
            for (int nt = 0; nt < 8; ++nt) { u32x2 o; o.x = pkbf(acc[mt][nt][0], acc[mt][nt][1]); o.y = pkbf(acc[mt][nt][2], acc[mt][nt][3]);
                *(u32x2*)(mix + (size_t)(pm * 256 + 32 * w + 16 * mt + m) * 1024 + grp * 128 + 16 * nt + 4 * g) = o; }
    }
    __syncthreads();
}
__device__ __forceinline__ void p2_mixer(Frame& F) {
#ifndef P2_POOL_REPS
#define P2_POOL_REPS 1
#endif
#ifndef P2_ATTN_REPS
#define P2_ATTN_REPS 1
#endif
    for (int u = F.vcu; u < 64 * 4 * P2_POOL_REPS; u += F.G) pool_unit(F, (u & 255) >> 2, u & 3);
    for (int t = F.vcu; t < B * AH * 4 * P2_ATTN_REPS; t += F.G) attn_block(F, (t & 255) >> 2, (t & 3) * 8);
}

__device__ __forceinline__ void p4_router(Frame& F) {
    LAS float* wt = (LAS float*)F.lds;
    for (int i = F.tid; i < D * NE; i += 512) wt[(i & 15) * D + (i >> 4)] = F_w_router[i];
    __syncthreads();
    const int gw = F.vcu * 8 + F.wave, NGW = F.G * 8, lane = F.lane;
    bf16_t* H2 = WSP(bf16_t, WS_H2); float* aff = WSP(float, WS_AFF);
    f32x4 vn[2][4];
#pragma unroll
    for (int rr = 0; rr < 2; ++rr) { const int r_ = (2 * gw + rr) < T ? (2 * gw + rr) : 0; const f32x4* xr = (const f32x4*)(F.out + (size_t)r_ * D) + lane;
#pragma unroll
        for (int j = 0; j < 4; ++j) vn[rr][j] = xr[64 * j]; }
    for (int row = 2 * gw; row < T; row += 2 * NGW) {
        const f32x4* gr = (const f32x4*)F_norm_ffn + lane;
        f32x4 v[2][4]; float ss[2];
#pragma unroll
        for (int rr = 0; rr < 2; ++rr) { float s_ = 0.f;
#pragma unroll
            for (int j = 0; j < 4; ++j) { v[rr][j] = vn[rr][j]; s_ += (v[rr][j].x * v[rr][j].x + v[rr][j].y * v[rr][j].y) + (v[rr][j].z * v[rr][j].z + v[rr][j].w * v[rr][j].w); }
            ss[rr] = s_; }
#pragma unroll
        for (int rr = 0; rr < 2; ++rr) { const int rn = row + 2 * NGW + rr; const int r_ = rn < T ? rn : row + rr; const f32x4* xr = (const f32x4*)(F.out + (size_t)r_ * D) + lane;
#pragma unroll
            for (int j = 0; j < 4; ++j) vn[rr][j] = xr[64 * j]; }
#pragma unroll
        for (int o = 1; o < 64; o <<= 1) { ss[0] += __shfl_xor(ss[0], o); ss[1] += __shfl_xor(ss[1], o); }
#pragma unroll
        for (int rr = 0; rr < 2; ++rr) { const float rstd = 1.0f / sqrtf(ss[rr] * (1.0f / D) + EPS); u32x2* o8 = (u32x2*)(H2 + (size_t)(row + rr) * D) + lane;
#pragma unroll
            for (int j = 0; j < 4; ++j) { v[rr][j] = v[rr][j] * rstd * gr[64 * j]; u32x2 o; o.x = pkbf(v[rr][j].x, v[rr][j].y); o.y = pkbf(v[rr][j].z, v[rr][j].w); o8[64 * j] = o; } }
        float a[32];
#pragma unroll
        for (int e = 0; e < 16; ++e) { float a0 = 0.f, a1 = 0.f;
#pragma unroll
            for (int j = 0; j < 4; ++j) { const f32x4 w4 = *(const LAS f32x4*)(wt + e * D + 256 * j + 4 * lane);
                a0 += (v[0][j].x * w4.x + v[0][j].y * w4.y) + (v[0][j].z * w4.z + v[0][j].w * w4.w); a1 += (v[1][j].x * w4.x + v[1][j].y * w4.y) + (v[1][j].z * w4.z + v[1][j].w * w4.w); }
            a[e] = a0; a[16 + e] = a1; if ((e & 3) == 3) asm volatile("" ::: "memory"); }
#define RS_STEP(n, M) do { const bool up = (lane & (M)) != 0; _Pragma("unroll") for (int j = 0; j < (n) / 2; ++j) { const float snd = up ? a[j] : a[j + (n) / 2]; const float kp_ = up ? a[j + (n) / 2] : a[j]; a[j] = kp_ + __shfl_xor(snd, (M)); } } while (0)
        RS_STEP(32, 32); RS_STEP(16, 16); RS_STEP(8, 8); RS_STEP(4, 4); RS_STEP(2, 2);
#undef RS_STEP
        float lg = a[0] + __shfl_xor(a[0], 1);
        float mx = lg;
#pragma unroll
        for (int o = 2; o < 32; o <<= 1) mx = fmaxf(mx, __shfl_xor(mx, o));
        const float ex = expf(lg - mx); float sum = ex;
#pragma unroll
        for (int o = 2; o < 32; o <<= 1) sum += __shfl_xor(sum, o);
        if ((lane & 1) == 0) { const int k = lane >> 1, rr = k >> 4, e = k & 15; const int rw = row + rr; aff[((size_t)(rw >> 11) * NE + e) * S + (rw & 2047)] = ex / sum; }
    }
}

__device__ __forceinline__ void p5_topk_gather(Frame& F) {
    LAS int* sidx = (LAS int*)F.lds;
    LAS float* affl = (LAS float*)(F.lds + 1024); LAS float* rsl = affl + S;
    const int lane = F.lane; const float* part = WSP(const float, WS_PART); float* gates = WSP(float, WS_GATES); int* slot_of = WSP(int, WS_SLOT);
    const bf16_t* H2 = WSP(const bf16_t, WS_H2); bf16_t* XE = WSP(bf16_t, WS_XE);
    for (int task = F.vcu; task < B * NE * 2; task += F.G) {
        const int be = task >> 1, half = task & 1, b = be >> 4, e = be & 15;
#pragma unroll
        for (int k = 0; k < 4; ++k) { const int s_ = F.tid + 512 * k; const f32x4* pr = (const f32x4*)(part + ((size_t)b * S + s_) * 80); float tot[20];
#pragma unroll
            for (int q = 0; q < 5; ++q) { const f32x4 t4 = (pr[q] + pr[5 + q]) + (pr[10 + q] + pr[15 + q]); tot[4 * q] = t4[0]; tot[4 * q + 1] = t4[1]; tot[4 * q + 2] = t4[2]; tot[4 * q + 3] = t4[3]; }
            const float rstd = 1.0f / sqrtf(tot[0] * (1.0f / D) + EPS); float mx = -1e30f;
#pragma unroll
            for (int ee = 0; ee < 16; ++ee) { tot[1 + ee] *= rstd; mx = fmaxf(mx, tot[1 + ee]); }
            float sum = 0.f, mine = 0.f;
#pragma unroll
            for (int ee = 0; ee < 16; ++ee) { const float ex = expf(tot[1 + ee] - mx); sum += ex; mine = (ee == e) ? ex : mine; }
            affl[s_] = mine / sum; rsl[s_] = rstd; }
        asm volatile("s_waitcnt lgkmcnt(0)" ::: "memory"); __syncthreads();
        if (F.wave == 0) {
            unsigned v[32];
#pragma unroll
            for (int j = 0; j < 32; ++j) v[j] = __builtin_bit_cast(unsigned, affl[64 * j + lane]);
            unsigned Tt = 0u;
#define WSUM6(c) (__popcll(__ballot(((c) & 1) != 0)) + 2 * __popcll(__ballot(((c) & 2) != 0)) + 4 * __popcll(__ballot(((c) & 4) != 0)) + 8 * __popcll(__ballot(((c) & 8) != 0)) + 16 * __popcll(__ballot(((c) & 16) != 0)) + 32 * __popcll(__ballot(((c) & 32) != 0)))
            for (int bit = 30; bit >= 0; --bit) { const unsigned cand = Tt | (1u << bit); int c = 0;
#pragma unroll
                for (int j = 0; j < 32; ++j) c += (v[j] >= cand) ? 1 : 0;
                if (WSUM6(c) >= CAP) Tt = cand; }
            int ngt;
            { int c = 0;
#pragma unroll
              for (int j = 0; j < 32; ++j) c += (v[j] > Tt) ? 1 : 0;
              ngt = WSUM6(c); }
#undef WSUM6
            const int need = CAP - ngt; int eq_run = 0, sel_run = 0;
            const unsigned long long ltmask = (lane == 0) ? 0ull : (~0ull >> (64 - lane));
#pragma unroll
            for (int j = 0; j < 32; ++j) {
                const bool gt = v[j] > Tt, eq = v[j] == Tt;
                const unsigned long long em = __ballot(eq);
                const int eqb = eq_run + __popcll(em & ltmask);
                const bool sel = gt || (eq && eqb < need);
                eq_run += __popcll(em);
                const unsigned long long sm = __ballot(sel);
                const int slot = sel_run + __popcll(sm & ltmask);
                sel_run += __popcll(sm);
                const int tok = 64 * j + lane;
                if (sel) sidx[slot] = tok;
                if (half == 0) { if (sel) gates[be * CAP + slot] = __builtin_bit_cast(float, v[j]); slot_of[((size_t)b * S + tok) * NE + e] = sel ? slot : -1; }
            }
        }
        __syncthreads();
        for (int i = 0; i < 16; ++i) { const int slot = half * 128 + F.wave * 16 + i; const int tok = sidx[slot];
#if EXPERT_FP8
            const u32x4* src = (const u32x4*)(H2 + ((size_t)b * S + tok) * D) + 2 * lane; u32x4* dst = (u32x4*)((unsigned char*)XE + ((size_t)be * CAP + slot) * D) + lane;
            const u32x4 a0 = src[0], a1 = src[1]; u32x4 o; const float rs = rsl[tok];
            o.x = pk4_fp8(bflo(a0.x) * rs, bfhi(a0.x) * rs, bflo(a0.y) * rs, bfhi(a0.y) * rs); o.y = pk4_fp8(bflo(a0.z) * rs, bfhi(a0.z) * rs, bflo(a0.w) * rs, bfhi(a0.w) * rs);
            o.z = pk4_fp8(bflo(a1.x) * rs, bfhi(a1.x) * rs, bflo(a1.y) * rs, bfhi(a1.y) * rs); o.w = pk4_fp8(bflo(a1.z) * rs, bfhi(a1.z) * rs, bflo(a1.w) * rs, bfhi(a1.w) * rs); dst[0] = o; }
#else
            const u32x4* src = (const u32x4*)(H2 + ((size_t)b * S + tok) * D) + lane; u32x4* dst = (u32x4*)(XE + ((size_t)be * CAP + slot) * D) + lane;
            const float rs = rsl[tok]; u32x4 a0 = src[0], a1 = src[64];
#define RS2(w) w = pkbf(bflo(w) * rs, bfhi(w) * rs)
            RS2(a0.x); RS2(a0.y); RS2(a0.z); RS2(a0.w); RS2(a1.x); RS2(a1.y); RS2(a1.z); RS2(a1.w);
#undef RS2
            dst[0] = a0; dst[64] = a1; }
#endif
        __syncthreads();
    }
}

__device__ __forceinline__ void p8_combine(Frame& F, bf16_t* X2N) {
    const int gw = F.vcu * 8 + F.wave, NGW = F.G * 8, lane = F.lane;
    const bf16_t* YE = WSP(const bf16_t, WS_XE); const int* slot_of = WSP(const int, WS_SLOT);
    const float* esq = WSP(const float, WS_ESQ); float* rstde = WSP(float, WS_RSTDE);
    struct RowIn { f32x4 x[4]; u32x2 y[4][4]; float wgt[4]; unsigned rest; int myslot; };
#define P8_SLOT(r_) (((r_) < T && lane < 16) ? slot_of[(size_t)(r_) * NE + lane] : -1)
#define P8_FETCH(in, r_, ms_) do { const int rq_ = (r_) < T ? (r_) : gw; const u32x2* xr_ = (const u32x2*)(H2s + (size_t)rq_ * D) + lane; \
        _Pragma("unroll") for (int j = 0; j < 4; ++j) { const u32x2 h_ = xr_[64 * j]; in.x[j] = (f32x4){bflo(h_.x), bfhi(h_.x), bflo(h_.y), bfhi(h_.y)} * gi[j]; } \
        in.myslot = (ms_); unsigned mk_ = (unsigned)__builtin_amdgcn_readfirstlane((int)(__ballot(in.myslot >= 0) & 0xffffull)); const int b_ = rq_ >> 11; \
        _Pragma("unroll") for (int k = 0; k < 4; ++k) { const bool ok_ = mk_ != 0u; const int e_ = ok_ ? __builtin_ctz(mk_) : 0; if (ok_) mk_ &= mk_ - 1u; \
            int sl_ = __builtin_amdgcn_readlane(in.myslot, e_); sl_ = (ok_ && sl_ >= 0) ? sl_ : 0; in.wgt[k] = ok_ ? 1.0f : 0.0f; \
            const u32x2* yr_ = (const u32x2*)(YE + ((size_t)(b_ * NE + e_) * CAP + sl_) * D) + lane; \
            _Pragma("unroll") for (int j = 0; j < 4; ++j) in.y[k][j] = yr_[64 * j]; } \
        in.rest = mk_; } while (0)
    const bf16_t* H2s = WSP(const bf16_t, WS_H2); f32x4 gi[4];
#pragma unroll
    for (int j = 0; j < 4; ++j) { const f32x4 g_ = ((const f32x4*)F_norm_ffn)[lane + 64 * j]; gi[j] = (f32x4){1.0f / g_[0], 1.0f / g_[1], 1.0f / g_[2], 1.0f / g_[3]}; }
    RowIn cur, nxt;
    int ms1 = P8_SLOT(gw + NGW);
    { const int ms0 = P8_SLOT(gw); P8_FETCH(cur, gw, ms0); }
    for (int row = gw; row < T; row += NGW) {
        const int ms2 = P8_SLOT(row + 2 * NGW);
        P8_FETCH(nxt, row + NGW, ms1);
        const f32x4* gr = (const f32x4*)F_norm_ple + lane; const int b = row >> 11;
        f32x4 v[4];
#pragma unroll
        for (int j = 0; j < 4; ++j) v[j] = cur.x[j];
#pragma unroll
        for (int k = 0; k < 4; ++k)
#pragma unroll
            for (int j = 0; j < 4; ++j) { v[j].x += cur.wgt[k] * bflo(cur.y[k][j].x); v[j].y += cur.wgt[k] * bfhi(cur.y[k][j].x); v[j].z += cur.wgt[k] * bflo(cur.y[k][j].y); v[j].w += cur.wgt[k] * bfhi(cur.y[k][j].y); }
        unsigned mask = cur.rest;
        while (mask != 0u) { const int e = __builtin_ctz(mask); mask &= mask - 1u; const int sl = __builtin_amdgcn_readlane(cur.myslot, e);
            const u32x2* yr = (const u32x2*)(YE + ((size_t)(b * NE + e) * CAP + sl) * D) + lane;
#pragma unroll
            for (int j = 0; j < 4; ++j) { const u32x2 y = yr[64 * j]; v[j].x += bflo(y.x); v[j].y += bfhi(y.x); v[j].z += bflo(y.y); v[j].w += bfhi(y.y); } }
        float s = 0.f;
#pragma unroll
        for (int j = 0; j < 4; ++j) { s += (v[j].x * v[j].x + v[j].y * v[j].y) + (v[j].z * v[j].z + v[j].w * v[j].w); }
        const float rms = sqrtf(wave_sum(s) * (1.0f / D) + EPS), rstd = 1.0f / rms;
        if (lane == 1) WSP(float, WS_RMS2)[row] = rms;
        u32x2* o8 = (u32x2*)(X2N + (size_t)row * D) + lane;
#pragma unroll
        for (int j = 0; j < 4; ++j) { const f32x4 gg = gr[64 * j]; u32x2 o; o.x = pkbf(v[j].x * rstd * gg.x, v[j].y * rstd * gg.y); o.y = pkbf(v[j].z * rstd * gg.z, v[j].w * rstd * gg.w); o8[64 * j] = o; }
        float q = (lane < 16) ? esq[(size_t)row * 16 + lane] : 0.f; q = wave_sum(q);
        if (lane == 0) rstde[row] = 1.0f / sqrtf(q * (1.0f / D) + EPS);
        cur = nxt; ms1 = ms2;
    }
#undef P8_SLOT
#undef P8_FETCH
}

constexpr int N_PHASES = 10;
__global__ void __launch_bounds__(512, 2) mega_fwd(MArgs args) {
    extern __shared__ __attribute__((aligned(16))) unsigned char lds_raw[];
    Frame F;
    F.lds = (LAS unsigned char*)lds_raw; F.tid = threadIdx.x; F.lane = F.tid & 63; F.wave = __builtin_amdgcn_readfirstlane(F.tid >> 6);
    F.G = gridDim.x; { const int bx = blockIdx.x; F.vcu = (F.G % 8 == 0) ? (bx % 8) * (F.G / 8) + bx / 8 : bx; }
    F.out = args.out; F.ws = args.ws; F.a = &args;
    for (int u = F.tid; u < (LDS_BYTES - LDSCTL_OFF) / 4; u += 512) ((LAS unsigned*)(F.lds + LDSCTL_OFF))[u] = 0u;
    __syncthreads();
    const int lo = args.ph_lo, hi = args.ph_hi;
    if (hi - lo > 1) xcd_barrier_post(WSP(unsigned, WS_CTL) + CW_BAR);
#ifndef PH_ENABLE
#define PH_ENABLE 0x3ff
#endif
#define IN(k) (((PH_ENABLE >> (k)) & 1) && lo <= (k) && (k) < hi)
#ifndef DUP_MASK
#define DUP_MASK 0
#endif
#ifndef P1A_REPS
#define P1A_REPS 1
#endif
#ifndef P1B_REPS
#define P1B_REPS 1
#endif
#define GBAR() xcd_barrier(WSP(unsigned, WS_CTL) + CW_BAR, (volatile LAS unsigned*)(F.lds + MISC_OFF) + 8)
#define DUP(k) (((DUP_MASK >> (k)) & 1) ? 2 : 1)
#ifdef TS_PHASE
#ifndef TS_SPAN
#define TS_SPAN 1
#endif
#ifndef TS_GAIN
#define TS_GAIN 1.0
#endif
#define STAMP(i) do { if (blockIdx.x == 0 && F.tid == 0) WSP(unsigned long long, WS_CTL + 32768)[(i)] = __builtin_amdgcn_s_memrealtime(); } while (0)
#else
#define STAMP(i) do {} while (0)
#endif
#define SEAM(k) do { if (IN(k) && IN((k) + 1)) xcd_barrier(WSP(unsigned, WS_CTL) + CW_BAR, (volatile LAS unsigned*)(F.lds + MISC_OFF) + 8); STAMP((k) + 1); } while (0)
    STAMP(0);
    if (IN(0)) { for (int rep = 0; rep < DUP(0); ++rep) { if (rep) GBAR(); p0_prologue(F); } } SEAM(0);
    if (IN(1)) for (int rep = 0; rep < DUP(1); ++rep) { if (rep) GBAR();
#ifndef CONV_SPLIT
#define CONV_SPLIT 2
#endif
        const int bq = (int)blockIdx.x >> 3, bxc = (int)blockIdx.x & 7; const bool split = EXPERT_FP8 && F.G == 256;
#if CONV_SPLIT == 16
        const int q16 = bq & 15, hi16 = bq >> 4; const bool conv = split && q16 >= 9;
        const int gG = split ? 144 : F.G; const int gc = split ? (bxc + 8 * (hi16 * 9 + q16)) : (int)blockIdx.x;
        const int cvw = ((hi16 * 7 + (q16 - 9)) * 8 + bxc) * 8 + F.wave, ncvw = 896;
        const bool e_run = !split || gc >= 80; const int eG = split ? 64 : F.G, ec = split ? gc - 80 : gc;
#else
        const bool conv = split && (bq % CONV_SPLIT) == CONV_SPLIT - 1;
        const int gG = split ? 256 - 256 / CONV_SPLIT : F.G; const int gc = split ? (bxc + 8 * ((bq / CONV_SPLIT) * (CONV_SPLIT - 1) + (bq % CONV_SPLIT))) : (int)blockIdx.x;
        const int cvw = ((bq / CONV_SPLIT) * 8 + bxc) * 8 + F.wave, ncvw = 8 * 256 / CONV_SPLIT;
        const bool e_run = true; const int eG = gG, ec = (split && CONV_SPLIT == 4) ? (gc + 64) % 192 : gc;
#endif
#if EXPERT_FP8
        if (conv) { p1_convert_experts(F, cvw, ncvw); } else
#endif
        {
#ifndef NO_P1A
        { pg8::Gemm g{WSP(const bf16_t, WS_XN), WSP(const bf16_t, WS_WIN), 1024}; pg8::StaticOrder So; So.init(T, 2048, gG, gc, P1A_REPS);
          EpiQKV E{WSP(bf16_t, WS_U), WSP(bf16_t, WS_Q), WSP(bf16_t, WS_K), WSP(bf16_t, WS_VT), F_q_norm, F_k_norm};
          pg8::gemm_phase(F.lds, g, So, E); }
#endif
#ifndef NO_P1B
        if (e_run) { pg8::Gemm g{WSP(const bf16_t, WS_PB), WSP(const bf16_t, WS_WPP), 256}; pg8::StaticOrder So; So.init(T, 1024, eG, ec, P1B_REPS);
          EpiE E{WSP(bf16_t, WS_EB), WSP(float, WS_ESQ)};
          pg8::gemm_phase(F.lds, g, So, E); }
#endif
        }
    } SEAM(1);
    if (IN(2)) { for (int rep = 0; rep < DUP(2); ++rep) { if (rep) GBAR(); p2_mixer(F); } } SEAM(2);
    if (IN(3)) for (int rep = 0; rep < DUP(3); ++rep) { if (rep) GBAR(); pg8::Gemm g{WSP(const bf16_t, WS_MIX), WSP(const bf16_t, WS_WOUT), 1024}; pg8::StaticOrder So; So.init(T, 1024, F.G, (int)blockIdx.x);
        EpiX1 E{F_x, F_norm_ffn, F_w_router, WSP(bf16_t, WS_H2), WSP(float, WS_PART)}; pg8::gemm_phase(F.lds, g, So, E); }
    if (IN(3) && IN(5)) { GBAR(); STAMP(4); STAMP(5); }
    if (IN(5)) { for (int rep = 0; rep < DUP(5); ++rep) { if (rep) GBAR(); p5_topk_gather(F); } } SEAM(5);
    if (IN(6)) for (int rep = 0; rep < DUP(6); ++rep) { if (rep) GBAR(); pg8::Gemm g{WSP(const bf16_t, WS_XE), WSP(const bf16_t, WS_WGU), 1024}; OrderGU So{F.G, F.vcu};
        EpiGU E{WSP(bf16_t, WS_HH)};
#if EXPERT_FP8
        pg8::gemm_phase<EpiGU, OrderGU, true, 0x7a7a7a7au, 0x7f7f7f7fu>(F.lds, g, So, E); } SEAM(6);
#else
        pg8::gemm_phase(F.lds, g, So, E); } SEAM(6);
#endif
    if (IN(7)) for (int rep = 0; rep < DUP(7); ++rep) { if (rep) GBAR(); pg8::Gemm g{WSP(const bf16_t, WS_HH), WSP(const bf16_t, WS_WD), 2048}; OrderDown So{F.G, F.vcu};
        EpiDown E{WSP(bf16_t, WS_XE), WSP(const float, WS_GATES)};
#if EXPERT_FP8
        pg8::gemm_phase<EpiDown, OrderDown, true, 0x7a7a7a7au, 0x7c7c7c7cu>(F.lds, g, So, E); } SEAM(7);
#else
        pg8::gemm_phase(F.lds, g, So, E); } SEAM(7);
#endif
#ifdef SHADOW_P8
    if (IN(8)) { p8_combine(F, WSP(bf16_t, WS_Q)); GBAR(); }
#endif
    if (IN(8)) { p8_combine(F, WSP(bf16_t, WS_X2N)); } SEAM(8);
#ifdef SHADOW_P9
    if (IN(9)) { pg8::Gemm g{WSP(const bf16_t, WS_X2N), WSP(const bf16_t, WS_WPG), 1024}; pg8::StaticOrder So; So.init(T, 1024, F.G, (int)blockIdx.x);
        EpiFinal E{WSP(float, WS_U), WSP(const bf16_t, WS_X2N), WSP(const bf16_t, WS_EB), WSP(const float, WS_RSTDE), WSP(const float, WS_RMS2), F_norm_ple_post, F_norm_ple}; pg8::gemm_phase(F.lds, g, So, E); GBAR(); }
#endif
    if (IN(9)) { pg8::Gemm g{WSP(const bf16_t, WS_X2N), WSP(const bf16_t, WS_WPG), 1024}; pg8::StaticOrder So; So.init(T, 1024, F.G, (int)blockIdx.x);
        EpiFinal E{F.out, WSP(const bf16_t, WS_X2N), WSP(const bf16_t, WS_EB), WSP(const float, WS_RSTDE), WSP(const float, WS_RMS2), F_norm_ple_post, F_norm_ple}; pg8::gemm_phase(F.lds, g, So, E); }
#ifdef TS_PHASE
    GBAR(); STAMP(10);
    if (blockIdx.x == 0) { __syncthreads(); const unsigned long long* ts = WSP(const unsigned long long, WS_CTL + 32768);
        const unsigned long long t0 = __hip_atomic_load(ts + (TS_PHASE), __ATOMIC_RELAXED, __HIP_MEMORY_SCOPE_AGENT), t1 = __hip_atomic_load(ts + (TS_PHASE) + TS_SPAN, __ATOMIC_RELAXED, __HIP_MEMORY_SCOPE_AGENT);
#ifdef TS_FAKE
        const float us = (float)(TS_FAKE);
#else
        const float us = (float)(t1 - t0) * 0.01f;
#endif
        const float delta = sqrtf(us * 4.1e-4f * (float)(TS_GAIN));
        for (int i = F.tid; i < 65536; i += 512) F.out[i] += delta; }
#endif
#undef IN
#undef SEAM
}
static inline dim3 g1(size_t n) { return dim3((unsigned)((n + 255) / 256)); }

#ifndef MODE
#define MODE 0
#endif

extern "C" void kernel_launch(void* const* d_in, const int* in_sizes, int n_in, void* d_out, int out_size, void* d_ws, size_t ws_size, hipStream_t stream) {
    const float* x = (const float*)d_in[0]; const float* p = (const float*)d_in[1]; const float* norm_mix = (const float*)d_in[2]; const float* w_in = (const float*)d_in[3];
    const float* w_pool = (const float*)d_in[4]; const float* pool_scale = (const float*)d_in[5]; const float* q_norm = (const float*)d_in[6]; const float* k_norm = (const float*)d_in[7];
    const float* rpb = (const float*)d_in[8]; const float* w_out = (const float*)d_in[9]; const float* norm_ffn = (const float*)d_in[10]; const float* w_router = (const float*)d_in[11];
    const float* w_gate = (const float*)d_in[12]; const float* w_up = (const float*)d_in[13]; const float* w_down = (const float*)d_in[14]; const float* norm_ple = (const float*)d_in[15];
    const float* w_ple_gate = (const float*)d_in[16]; const float* w_ple_proj = (const float*)d_in[17]; const float* norm_ple_post = (const float*)d_in[18];
    float* out = (float*)d_out; char* ws = (char*)d_ws;
    (void)in_sizes; (void)n_in; (void)out_size;
    static int grid = 0;
    if (grid == 0) {
        if (ws_size < (size_t)489 * MiB) { fprintf(stderr, "kernel_launch: workspace too small (%zu)\n", ws_size); grid = -1; return; }
        int dev = 0, cus = 0, per_cu = 0;
        if (hipGetDevice(&dev) != hipSuccess || hipDeviceGetAttribute(&cus, hipDeviceAttributeMultiprocessorCount, dev) != hipSuccess) { grid = -1; return; }
        if (hipFuncSetAttribute((const void*)mega_fwd, hipFuncAttributeMaxDynamicSharedMemorySize, LDS_BYTES) != hipSuccess) { fprintf(stderr, "kernel_launch: hipFuncSetAttribute failed\n"); grid = -1; return; }
        if (hipOccupancyMaxActiveBlocksPerMultiprocessor(&per_cu, (const void*)mega_fwd, 512, LDS_BYTES) != hipSuccess || per_cu < 1) { fprintf(stderr, "kernel_launch: occupancy query says %d blocks per CU\n", per_cu); grid = -1; (void)hipGetLastError(); return; }
        if (cus != 256) { fprintf(stderr, "kernel_launch: built for a 256-CU device (one 256x256 unit per workgroup in the fused phases); found %d CUs\n", cus); grid = -1; return; }
        grid = cus;
    }
    if (grid < 0) return;
    (void)hipMemsetAsync((char*)d_ws + WS_CTL, 0, CTL_ZERO_BYTES, stream);
    MArgs a{};
    for (int i = 0; i < 19; ++i) a.in[i] = (const float*)d_in[i];
    a.out = out; a.ws = (unsigned char*)d_ws;
#if MODE == 0
    a.ph_lo = 0; a.ph_hi = N_PHASES;
    hipLaunchKernelGGL(mega_fwd, dim3(grid), dim3(512), LDS_BYTES, stream, a);
#else
    constexpr int KOPT = MODE - 100;
    for (int ph = 0; ph <= KOPT; ++ph) { a.ph_lo = ph; a.ph_hi = ph + 1; hipLaunchKernelGGL(mega_fwd, dim3(grid), dim3(512), LDS_BYTES, stream, a); }
    float* xn = (float*)(ws + 0 * MiB);
    float* z = (float*)(ws + 64 * MiB);
    float* dp = (float*)(ws + 192 * MiB);
    float* ye = (float*)(ws + 288 * MiB);
    float* ga = (float*)(ws + 416 * MiB); float* gb = (float*)(ws + 448 * MiB);
    float* mix = (float*)(ws + 416 * MiB);
    float* aff = (float*)(ws + 485 * MiB); int* idx = (int*)(ws + 486 * MiB); float* gates = (float*)(ws + 487 * MiB); int* slot_of = (int*)(ws + 488 * MiB);
    const unsigned short* mU = (const unsigned short*)(ws + WS_U); const unsigned short* mQ = (const unsigned short*)(ws + WS_Q); const unsigned short* mK = (const unsigned short*)(ws + WS_K); const unsigned short* mVT = (const unsigned short*)(ws + WS_VT);
    if (KOPT < 1) {
        nv::rmsnorm_rows<<<T, 256, 0, stream>>>(x, norm_mix, xn, D);
        nv::gemm_f32<<<dim3(2048 / 64, T / 64, 1), 256, 0, stream>>>(xn, w_in, z, D, D, 2048, 2048, 0, 0, 0);
    }
    if (KOPT < 2) {
        if (KOPT == 1) nv::bf16_to_f32<<<g1((size_t)T * PW), 256, 0, stream>>>(mU, z, PW, 2048, (size_t)T * PW);
        nv::pool_diff<<<g1((size_t)T * PW), 256, 0, stream>>>(z, dp);
        nv::gemm_f32<<<dim3(PG / 64, T / 64, 4), 256, 0, stream>>>(dp, w_pool, mix, PG, PW, PG, D, PG, (size_t)PG * PG, PG);
        nv::scale_cols<<<g1((size_t)T * PW), 256, 0, stream>>>(mix, D, PW, pool_scale, (size_t)T * PW);
        if (KOPT == 1) nv::natten_pre<<<T * AH, 128, 0, stream>>>(mQ, mK, mVT, rpb, mix);
        else nv::natten<<<T * AH, 128, 0, stream>>>(z, q_norm, k_norm, rpb, mix);
    }
    if (KOPT < 3) {
        if (KOPT == 2) nv::bf16_to_f32<<<g1((size_t)T * D), 256, 0, stream>>>((const unsigned short*)(ws + WS_MIX), mix, D, D, (size_t)T * D);
        nv::gemm_f32<<<dim3(D / 64, T / 64, 1), 256, 0, stream>>>(mix, w_out, xn, D, D, D, D, 0, 0, 0);
        nv::add_to<<<g1((size_t)T * D), 256, 0, stream>>>(out, x, xn, (size_t)T * D);
    }
    if (KOPT < 4) {
        nv::rmsnorm_rows<<<T, 256, 0, stream>>>(out, norm_ffn, xn, D);
        nv::router<<<T, 256, 0, stream>>>(xn, w_router, aff);
    } else { aff = (float*)(ws + WS_AFF); }
    if (KOPT < 5) {
        if (KOPT == 4) nv::bf16_to_f32<<<g1((size_t)T * D), 256, 0, stream>>>((const unsigned short*)(ws + WS_H2), xn, D, D, (size_t)T * D);
        nv::topk<<<B * NE, 1024, 0, stream>>>(aff, idx, gates, slot_of);
        nv::gather_rows<<<B * NE * CAP, 256, 0, stream>>>(xn, idx, z);
    } else { gates = (float*)(ws + WS_GATES); slot_of = (int*)(ws + WS_SLOT); }
    if (KOPT < 7) {
        float* xe = z;
        if (KOPT >= 5) nv::bf16_to_f32<<<g1((size_t)B * NE * CAP * D), 256, 0, stream>>>((const unsigned short*)(ws + WS_XE), xe, D, D, (size_t)B * NE * CAP * D);
        for (int b = 0; b < B; ++b) {
            const float* xeb = xe + (size_t)b * NE * CAP * D;
            nv::gemm_f32<<<dim3(DE / 64, CAP / 64, NE), 256, 0, stream>>>(xeb, w_gate, ga, D, D, DE, DE, (size_t)CAP * D, (size_t)D * DE, (size_t)CAP * DE);
            nv::gemm_f32<<<dim3(DE / 64, CAP / 64, NE), 256, 0, stream>>>(xeb, w_up, gb, D, D, DE, DE, (size_t)CAP * D, (size_t)D * DE, (size_t)CAP * DE);
            nv::silu_mul<<<g1((size_t)NE * CAP * DE), 256, 0, stream>>>(ga, gb, (size_t)NE * CAP * DE);
            nv::gemm_f32<<<dim3(D / 64, CAP / 64, NE), 256, 0, stream>>>(ga, w_down, ye + (size_t)b * NE * CAP * D, DE, DE, D, D, (size_t)CAP * DE, (size_t)DE * D, (size_t)CAP * D);
        }
    }
    if (KOPT < 8) {
        if (KOPT == 7) nv::combine_bf16<<<T, 256, 0, stream>>>(out, (const unsigned short*)(ws + WS_XE), slot_of);
        else nv::combine<<<T, 256, 0, stream>>>(out, ye, gates, slot_of);
    }
    if (KOPT < 9) {
        nv::rmsnorm_rows<<<T, 256, 0, stream>>>(out, norm_ple, xn, D);
        nv::gemm_f32<<<dim3(D / 64, T / 64, 1), 256, 0, stream>>>(xn, w_ple_gate, mix, D, D, D, D, 0, 0, 0);
        float* eraw = ye;
        nv::gemm_f32<<<dim3(D / 64, T / 64, 1), 256, 0, stream>>>(p, w_ple_proj, eraw, PD, PD, D, D, 0, 0, 0);
        nv::rmsnorm_rows<<<T, 256, 0, stream>>>(eraw, norm_ple_post, xn, D);
        nv::ple_final<<<g1((size_t)T * D), 256, 0, stream>>>(out, mix, xn, (size_t)T * D);
    }
#endif
}
```

```cpp
#include <hip/hip_runtime.h>
#include <cstdio>
#include <cstdint>

namespace cfg {
constexpr int D = 1024, B = 8, S = 2048, T = B * S;
constexpr int GW = 64, ROWS = S / GW;
constexpr int PW = 512, PG = 128, AH = 8, HD = 64, NE = 16, CAP = 256, DE = 2048, PD = 256;
constexpr float EPS = 1e-6f;
}
using namespace cfg;

#define MODE 0
#define GAS __attribute__((address_space(1)))
#define LAS __attribute__((address_space(3)))
typedef unsigned short bf16_t;
typedef short bf16x8 __attribute__((ext_vector_type(8)));
typedef float f32x4 __attribute__((ext_vector_type(4)));
typedef float f32x2 __attribute__((ext_vector_type(2)));
typedef unsigned u32x4 __attribute__((ext_vector_type(4)));
typedef unsigned u32x2 __attribute__((ext_vector_type(2)));
typedef __bf16 bf16x2_t __attribute__((ext_vector_type(2)));

__device__ __forceinline__ unsigned pkbf(float lo, float hi) { f32x2 v = {lo, hi}; bf16x2_t b = __builtin_convertvector(v, bf16x2_t); return __builtin_bit_cast(unsigned, b); }
__device__ __forceinline__ float bf2f(unsigned short u) { return __builtin_bit_cast(float, (unsigned)u << 16); }
__device__ __forceinline__ float bflo(unsigned u) { return __builtin_bit_cast(float, u << 16); }
__device__ __forceinline__ float bfhi(unsigned u) { return __builtin_bit_cast(float, u & 0xffff0000u); }
__device__ __forceinline__ float wave_sum(float v) {
#pragma unroll
    for (int o = 1; o < 64; o <<= 1) v += __shfl_xor(v, o);
    return v;
}
constexpr float LOG2E = 1.4426950408889634f;
#ifndef EXPERT_FP8
#define EXPERT_FP8 1
#endif
constexpr int PAD_HH = 256, PAD_WD = 256;
constexpr float FP8_WSCALE = 32.0f, FP8_HSCALE = 8.0f;
__device__ __forceinline__ unsigned pk4_fp8(float a, float b, float c, float d) { unsigned w = 0u; w = __builtin_amdgcn_cvt_pk_fp8_f32(a, b, w, false); w = __builtin_amdgcn_cvt_pk_fp8_f32(c, d, w, true); return w; }

namespace pg8 {
constexpr int BM = 256, BK = 64, HALF = 128, HTB = HALF * BK * 2, STAGE_BYTES = 8 * HTB;
__host__ __device__ __forceinline__ int lds_byte(int r, int c) { const int st = (r >> 4) * 2 + (c >> 5), rr = r & 15, cc = c & 31, ob = rr * 64 + cc * 2; return st * 1024 + (ob ^ (((ob >> 9) & 1) << 5)); }
__host__ __device__ __forceinline__ void stage_rc(int b, int& R, int& C) { const int st = b / 1024, sb = b % 1024, swz = sb ^ (((sb >> 9) & 1) << 5); R = (st >> 1) * 16 + swz / 64; C = (st & 1) * 32 + (swz % 64) / 2; }
__host__ __device__ __forceinline__ int perm32(int rho) { const int n = rho >> 4, i = rho & 15; return 8 * (i >> 2) + 4 * n + (i & 3); }

struct Unit { int arow, brow, pm, pn, grp; };
struct Gemm { const bf16_t* A; const bf16_t* Bt; int K; int padA = 0, padB = 0; };

struct StaticOrder {
    int nM, nN, nwg, G, c, reps;
    __device__ void init(int M, int N, int G_, int c_, int reps_ = 1) { nM = M / BM; nN = N / BM; nwg = nM * nN; G = G_; c = c_; reps = reps_; }
    __device__ bool next(int i, Unit& u) const {
        const long L = (long)i * G + c; if (L >= (long)nwg * reps) return false;
        int wgid = (int)(L % nwg); { const int q = nwg / 8, r = nwg % 8, xcd = wgid % 8, off = wgid / 8; wgid = (xcd < r ? xcd * (q + 1) : r * (q + 1) + (xcd - r) * q) + off; }
        const int nig = 8 * nN, gid = wgid / nig, fm = gid * 8, gsz = (nM - fm) < 8 ? (nM - fm) : 8;
        u.pm = fm + ((wgid % nig) % gsz); u.pn = (wgid % nig) / gsz; u.arow = u.pm * BM; u.brow = u.pn * BM; u.grp = 0; return true;
    }
};

typedef int v8i32 __attribute__((ext_vector_type(8)));
template <class Epi, class Sched, bool FP8 = false, unsigned SCALE_W = 0x7f7f7f7fu, unsigned SCALE_X = 0x7f7f7f7fu>
__device__ __forceinline__ void gemm_phase(LAS unsigned char* lds, const Gemm g, const Sched& S, const Epi& E) {
    const int tid = threadIdx.x, wid = __builtin_amdgcn_readfirstlane(tid >> 6), lane = tid & 63, wr = wid >> 2, wc = wid & 3, fr = lane & 15, fq = lane >> 4;
    int K = g.K; asm volatile("" : "+s"(K));
    const int nt = FP8 ? K / 128 : K / BK;
    const unsigned rstepA = (FP8 ? (unsigned)K : (unsigned)K * 2) + (unsigned)g.padA, rstepB = (FP8 ? (unsigned)K : (unsigned)K * 2) + (unsigned)g.padB;
    unsigned voffA[2], voffB[2];
#pragma unroll
    for (int i = 0; i < 2; ++i) { int R, C; stage_rc(tid * 16 + i * 8192, R, C); const int Rb = 64 * (R >> 5) + perm32(R & 31);
        voffA[i] = (unsigned)R * rstepA + (unsigned)C * 2u; voffB[i] = (unsigned)Rb * rstepB + (unsigned)C * 2u; }
    const unsigned kstep = (unsigned)(BK * 2);
    const unsigned hstep = (unsigned)HALF * rstepA;
    const unsigned hstepB = (unsigned)32 * rstepB;
    const unsigned ldsw = (unsigned)wid * 1024u;
    const int aoff = lds_byte(wr * 64 + fr, fq * 8), boff = lds_byte(wc * 32 + fr, fq * 8);
#define PG8_SA(b, h) (((b) * 2 + (h)) * HTB)
#define PG8_SB(b, h) ((4 + (b) * 2 + (h)) * HTB)
#define PG8_STAGE(bufoff, rsrc, soff, voff) do { _Pragma("unroll") for (int _i = 0; _i < 2; ++_i) \
        __builtin_amdgcn_raw_ptr_buffer_load_lds((rsrc), (LAS void*)(lds + (bufoff) + ldsw + _i * 8192), 16, (int)(voff)[_i], (int)(soff), 0, 0); } while (0)
#define PG8_LDA(dst, b, h) do { _Pragma("unroll") for (int m = 0; m < 4; ++m) _Pragma("unroll") for (int k = 0; k < 2; ++k) dst[m][k] = *(const LAS bf16x8*)(lds + PG8_SA(b, h) + aoff + m * 2048 + k * 1024); } while (0)
#define PG8_LDB(dst, b, h) do { _Pragma("unroll") for (int n = 0; n < 2; ++n) _Pragma("unroll") for (int k = 0; k < 2; ++k) dst[n][k] = *(const LAS bf16x8*)(lds + PG8_SB(b, h) + boff + n * 2048 + k * 1024); } while (0)
#define PG8_CAT(x) __builtin_bit_cast(v8i32, x)
#define PG8_MMA(ai, bj, At, Bt) do { __builtin_amdgcn_s_setprio(1); \
        if constexpr (FP8) { _Pragma("unroll") for (int m = 0; m < 4; ++m) _Pragma("unroll") for (int n = 0; n < 2; ++n) \
            acc[ai][bj][m][n] = __builtin_amdgcn_mfma_scale_f32_16x16x128_f8f6f4(PG8_CAT(Bt[n]), PG8_CAT(At[m]), acc[ai][bj][m][n], 0, 0, 0, (int)((SCALE_W & 0xffu) | ((SCALE_X & 0xffu) << 8)), 1, (int)((SCALE_W & 0xffu) | ((SCALE_X & 0xffu) << 8))); } \
        else { _Pragma("unroll") for (int m = 0; m < 4; ++m) _Pragma("unroll") for (int n = 0; n < 2; ++n) _Pragma("unroll") for (int k = 0; k < 2; ++k) \
            acc[ai][bj][m][n] = __builtin_amdgcn_mfma_f32_16x16x32_bf16(Bt[n][k], At[m][k], acc[ai][bj][m][n], 0, 0, 0); } \
        __builtin_amdgcn_s_setprio(0); } while (0)
#define PG8_WAIT_V(n) asm volatile("s_waitcnt vmcnt(" #n ")" ::: "memory")
#define PG8_WAIT_L(n) asm volatile("s_waitcnt lgkmcnt(" #n ")" ::: "memory")
#define PG8_BAR __builtin_amdgcn_s_barrier()
#define PG8_SCHED __builtin_amdgcn_sched_barrier(0)
    Unit cur, nxt; int ui = 0;
    if (!S.next(0, cur)) return;
    f32x4 acc[2][2][4][2];
#pragma unroll
    for (int a = 0; a < 2; ++a)
#pragma unroll
        for (int b = 0; b < 2; ++b)
#pragma unroll
            for (int m = 0; m < 4; ++m)
#pragma unroll
                for (int n = 0; n < 2; ++n) acc[a][b][m][n] = (f32x4){0.f, 0.f, 0.f, 0.f};
    struct alignas(32) Frag2 { bf16x8 v[2]; __device__ __forceinline__ bf16x8& operator[](int i) { return v[i]; } };
    Frag2 At[4], B0[2], B1[2];
    const __amdgpu_buffer_rsrc_t rA = __builtin_amdgcn_make_buffer_rsrc((void*)g.A, 0, 0xffffffff, 0x00020000);
    const __amdgpu_buffer_rsrc_t rB = __builtin_amdgcn_make_buffer_rsrc((void*)g.Bt, 0, 0xffffffff, 0x00020000);
    unsigned cA = (unsigned)cur.arow * rstepA, cB = (unsigned)cur.brow * rstepB;
    PG8_STAGE(PG8_SB(0, 0), rB, cB, voffB); PG8_STAGE(PG8_SB(0, 1), rB, cB + hstepB, voffB); PG8_STAGE(PG8_SA(0, 0), rA, cA, voffA); PG8_STAGE(PG8_SA(0, 1), rA, cA + hstep, voffA);
    if (wr == 1) PG8_BAR;
    PG8_WAIT_V(2); PG8_BAR;
    PG8_STAGE(PG8_SB(1, 0), rB, cB + kstep, voffB); PG8_STAGE(PG8_SA(1, 0), rA, cA + kstep, voffA); PG8_STAGE(PG8_SB(1, 1), rB, cB + hstepB + kstep, voffB);
    PG8_WAIT_V(6); PG8_BAR;
    for (;;) {
        const bool has_next = S.next(ui + 1, nxt);
        const unsigned nA = has_next ? (unsigned)nxt.arow * rstepA : cA; const unsigned nB = has_next ? (unsigned)nxt.brow * rstepB : cB;
        for (int t = 0; t < nt; t += 2) {
            const bool last = (t == nt - 2);
            const unsigned a1 = cA + (unsigned)(t + 1) * kstep;
            const unsigned a2 = last ? nA : cA + (unsigned)(t + 2) * kstep; const unsigned b2 = last ? nB : cB + (unsigned)(t + 2) * kstep;
            const unsigned a3 = a2 + kstep; const unsigned b3 = b2 + kstep;
            PG8_LDB(B0, 0, 0); PG8_LDB(B1, 0, 1); PG8_SCHED; PG8_LDA(At, 0, 0); PG8_STAGE(PG8_SA(1, 1), rA, a1 + hstep, voffA);
            PG8_WAIT_V(8); PG8_WAIT_L(0); PG8_BAR; PG8_MMA(0, 0, At, B0); PG8_MMA(0, 1, At, B1); PG8_BAR; PG8_SCHED;
            PG8_LDA(At, 0, 1); PG8_STAGE(PG8_SB(0, 0), rB, b2, voffB); PG8_STAGE(PG8_SB(0, 1), rB, b2 + hstepB, voffB); PG8_STAGE(PG8_SA(0, 0), rA, a2, voffA);
            PG8_WAIT_V(8); PG8_WAIT_L(0); PG8_BAR; PG8_MMA(1, 0, At, B0); PG8_MMA(1, 1, At, B1); PG8_BAR; PG8_SCHED;
            PG8_LDB(B0, 1, 0); PG8_LDB(B1, 1, 1); PG8_SCHED; PG8_LDA(At, 1, 0); PG8_STAGE(PG8_SA(0, 1), rA, a2 + hstep, voffA);
            PG8_WAIT_V(8); PG8_WAIT_L(0); PG8_BAR; PG8_MMA(0, 0, At, B0); PG8_MMA(0, 1, At, B1); PG8_BAR; PG8_SCHED;
            PG8_LDA(At, 1, 1); PG8_STAGE(PG8_SB(1, 0), rB, b3, voffB); PG8_STAGE(PG8_SB(1, 1), rB, b3 + hstepB, voffB); PG8_STAGE(PG8_SA(1, 0), rA, a3, voffA);
            PG8_WAIT_V(8); PG8_WAIT_L(0); PG8_BAR; PG8_MMA(1, 0, At, B0); PG8_MMA(1, 1, At, B1); PG8_BAR; PG8_SCHED;
        }
        if (wr == 0) PG8_BAR;
        if constexpr (!Epi::AFTER_DRAIN) E(acc, cur, wr, wc, fr, fq);
        if (!has_next) break;
#pragma unroll
        for (int a = 0; a < 2; ++a)
#pragma unroll
            for (int b = 0; b < 2; ++b)
#pragma unroll
                for (int m = 0; m < 4; ++m)
#pragma unroll
                    for (int n = 0; n < 2; ++n) acc[a][b][m][n] = (f32x4){0.f, 0.f, 0.f, 0.f};
        cur = nxt; cA = nA; cB = nB; ++ui;
        if (wr == 1) PG8_BAR;
    }
    PG8_WAIT_V(0);
    PG8_BAR;
    if constexpr (Epi::AFTER_DRAIN) E.fused(acc, cur, lds, wid);
#undef PG8_SA
#undef PG8_SB
#undef PG8_STAGE
#undef PG8_LDA
#undef PG8_LDB
#undef PG8_MMA
#undef PG8_CAT
#undef PG8_WAIT_V
#undef PG8_WAIT_L
#undef PG8_BAR
#undef PG8_SCHED
}
}

constexpr size_t MiB = (size_t)1 << 20;
constexpr size_t WS_CTL = 0, CTL_ZERO_BYTES = 64 * 1024;
constexpr size_t WS_WIN = 4 * MiB, WS_WOUT = 8 * MiB, WS_WPG = 10 * MiB, WS_WPP = 12 * MiB, WS_WPOOL = 12 * MiB + 512 * 1024;
constexpr size_t WS_WGU = 16 * MiB, WS_WD = 144 * MiB;
constexpr size_t WS_HH = 208 * MiB;
constexpr size_t WS_U = 208 * MiB, WS_Q = 224 * MiB, WS_K = 240 * MiB, WS_VT = 256 * MiB, WS_MIX = 272 * MiB, WS_XN = 304 * MiB;
constexpr size_t WS_PB = 336 * MiB, WS_EB = 344 * MiB, WS_H2 = 376 * MiB  , WS_XE = 408 * MiB  ;
constexpr size_t WS_AFF = 480 * MiB, WS_GATES = 481 * MiB, WS_SLOT = 482 * MiB, WS_ESQ = 483 * MiB, WS_RSTDE = 484 * MiB;
constexpr size_t WS_RMS2 = 484 * MiB + 512 * 1024, WS_RSTD1 = 484 * MiB + 768 * 1024;
constexpr size_t WS_PART = 208 * MiB;
constexpr size_t WS_X2N = 272 * MiB;
constexpr size_t WS_MEGA_END = 485 * MiB;
constexpr int CW_BAR = 1024;

constexpr int RING_BYTES = 131072, LDS_BYTES = 163840, LDSCTL_OFF = LDS_BYTES - 512, MISC_OFF = LDSCTL_OFF + 320;

#define XB_TMO      128
#define XB_XCNT(j)  (256  + 64 * (j))
#define XB_XSUB(j)  (1280 + 64 * (j))
#define XB_XGEN(j)  (2304 + 64 * (j))
#define XB_TOP      3328
#define XB_TOPGEN   3392
#define XCD_BAR_WORDS 3456
#define XB_SPIN_CAP (1u << 18)
__device__ __forceinline__ unsigned xb_ld(unsigned* p)              { return __hip_atomic_load(p, __ATOMIC_RELAXED, __HIP_MEMORY_SCOPE_AGENT); }
__device__ __forceinline__ unsigned xb_add(unsigned* p, unsigned v) { return __hip_atomic_fetch_add(p, v, __ATOMIC_RELAXED, __HIP_MEMORY_SCOPE_AGENT); }
__device__ __forceinline__ unsigned xb_xcc_id() { return (unsigned)__builtin_amdgcn_s_getreg((3 << 11) | 20) & 0xFu; }
#define XB_SPIN(cond, bar) do { unsigned _sp = 0; while (cond) { __builtin_amdgcn_s_sleep(1); \
    if ((++_sp & 255u) == 0u) { if (xb_ld(&(bar)[XB_TMO])) break; if (_sp > XB_SPIN_CAP) { atomicAdd(&(bar)[XB_TMO], 1u); break; } } } } while (0)
__device__ __forceinline__ void xcd_barrier_post(unsigned* bar) { if (threadIdx.x == 0) (void)xb_add(&bar[XB_XCNT(xb_xcc_id())], 1u); }
__device__ __forceinline__ void xcd_barrier_complete(unsigned* bar, unsigned x, unsigned& nloc, unsigned& nx) {
    const unsigned G = gridDim.x * gridDim.y * gridDim.z;
    unsigned sum, cnt, mine, sp = 0u;
    for (;;) {
        sum = 0u; cnt = 0u; mine = 0u;
#pragma unroll
        for (unsigned j = 0; j < 16; ++j) { const unsigned c = xb_ld(&bar[XB_XCNT(j)]); sum += c; cnt += (c > 0u) ? 1u : 0u; mine = (j == x) ? c : mine; }
        if (sum == G) break;
        __builtin_amdgcn_s_sleep(1);
        if ((++sp & 255u) == 0u) { if (xb_ld(&bar[XB_TMO])) break; if (sp > XB_SPIN_CAP) { atomicAdd(&bar[XB_TMO], 1u); break; } }
    }
    nloc = mine > 0u ? mine : 1u; nx = cnt > 0u ? cnt : 1u;
}
__device__ __forceinline__ void xcd_barrier(unsigned* bar, volatile LAS unsigned* st) {
    asm volatile("s_waitcnt vmcnt(0)" ::: "memory");
    __syncthreads();
    if (threadIdx.x == 0) {
        const unsigned x = xb_xcc_id();
        __builtin_amdgcn_s_waitcnt(0);
        unsigned nloc = st[0], nx = st[1];
        if (nloc == 0u) { xcd_barrier_complete(bar, x, nloc, nx); st[0] = nloc; st[1] = nx; }
        const unsigned old = xb_add(&bar[XB_XSUB(x)], 1u);
        const unsigned gen = old / nloc;
        if (old + 1u == (gen + 1u) * nloc) {
            __builtin_amdgcn_fence(__ATOMIC_RELEASE, "agent");
            asm volatile("s_waitcnt vmcnt(0)" ::: "memory");
            const unsigned og = xb_add(&bar[XB_TOP], 1u);
            const unsigned tg = og / nx;
            if (og + 1u == (tg + 1u) * nx) xb_add(&bar[XB_TOPGEN], 1u);
            else XB_SPIN(xb_ld(&bar[XB_TOPGEN]) == tg, bar);
            __builtin_amdgcn_fence(__ATOMIC_ACQUIRE, "agent");
            xb_add(&bar[XB_XGEN(x)], 1u);
            asm volatile("s_waitcnt vmcnt(0)" ::: "memory");
        } else {
            XB_SPIN(xb_ld(&bar[XB_XGEN(x)]) == gen, bar);
            __builtin_amdgcn_fence(__ATOMIC_ACQUIRE, "agent");
            asm volatile("s_waitcnt vmcnt(0)" ::: "memory");
        }
    }
    __syncthreads();
}

struct MArgs { const float* in[19]; float* out; unsigned char* ws; int ph_lo, ph_hi; };
struct Frame {
    LAS unsigned char* lds; int tid, lane, wave, vcu, G;
    float* out; unsigned char* ws; const MArgs* a;
};
#define F_x (F.a->in[0])
#define F_p (F.a->in[1])
#define F_norm_mix (F.a->in[2])
#define F_w_in (F.a->in[3])
#define F_w_pool (F.a->in[4])
#define F_pool_scale (F.a->in[5])
#define F_q_norm (F.a->in[6])
#define F_k_norm (F.a->in[7])
#define F_rpb (F.a->in[8])
#define F_w_out (F.a->in[9])
#define F_norm_ffn (F.a->in[10])
#define F_w_router (F.a->in[11])
#define F_w_gate (F.a->in[12])
#define F_w_up (F.a->in[13])
#define F_w_down (F.a->in[14])
#define F_norm_ple (F.a->in[15])
#define F_w_ple_gate (F.a->in[16])
#define F_w_ple_proj (F.a->in[17])
#define F_norm_ple_post (F.a->in[18])
#define WSP(T, off) ((T*)(F.ws + (off)))

__device__ __forceinline__ void tr_item(const float* W, int K, int N, bf16_t* WT, int kb, int nb, int dst_row0, LAS float* scr, int lane) {
    const int k0 = 64 * kb, n0 = 32 * nb;
#pragma unroll 8
    for (int i = 0; i < 32; ++i) { const int kk = 2 * i + (lane >> 5); scr[kk * 33 + (lane & 31)] = W[(size_t)(k0 + kk) * N + n0 + (lane & 31)]; }
    asm volatile("s_waitcnt lgkmcnt(0)" ::: "memory");
    const int c = lane & 7;
#pragma unroll
    for (int j = 0; j < 4; ++j) { const int n = (lane >> 3) + 8 * j; const LAS float* s = scr + (8 * c) * 33 + n;
        u32x4 o; o.x = pkbf(s[0 * 33], s[1 * 33]); o.y = pkbf(s[2 * 33], s[3 * 33]); o.z = pkbf(s[4 * 33], s[5 * 33]); o.w = pkbf(s[6 * 33], s[7 * 33]);
        *(u32x4*)(WT + (size_t)(dst_row0 + n) * K + k0 + 8 * c) = o; }
    asm volatile("s_waitcnt lgkmcnt(0)" ::: "memory");
}
__device__ __forceinline__ void tr_item8(const float* W, int K, int N, unsigned char* WT, int kb, int nb, int dst_row0, float scale, LAS float* scr, int lane) {
    const int k0 = 128 * kb, n0 = 32 * nb;
    const float* wp = W + (size_t)(k0 + (lane >> 5)) * N + n0 + (lane & 31); LAS float* sp = scr + (lane >> 5) * 33 + (lane & 31);
#pragma unroll
    for (int h = 0; h < 2; ++h) { float t[32];
#pragma unroll
        for (int i = 0; i < 32; ++i) t[i] = wp[(size_t)(2 * (32 * h + i)) * N];
#pragma unroll
        for (int i = 0; i < 32; ++i) sp[(2 * (32 * h + i)) * 33] = t[i] * scale; }
    asm volatile("s_waitcnt lgkmcnt(0)" ::: "memory");
    const int c = lane & 7;
#pragma unroll
    for (int j = 0; j < 4; ++j) { const int n = (lane >> 3) + 8 * j; const LAS float* s = scr + (16 * c) * 33 + n;
        u32x4 o; o.x = pk4_fp8(s[0 * 33], s[1 * 33], s[2 * 33], s[3 * 33]); o.y = pk4_fp8(s[4 * 33], s[5 * 33], s[6 * 33], s[7 * 33]);
        o.z = pk4_fp8(s[8 * 33], s[9 * 33], s[10 * 33], s[11 * 33]); o.w = pk4_fp8(s[12 * 33], s[13 * 33], s[14 * 33], s[15 * 33]);
        *(u32x4*)(WT + (size_t)(dst_row0 + n) * K + k0 + 16 * c) = o; }
    asm volatile("s_waitcnt lgkmcnt(0)" ::: "memory");
}
__device__ __forceinline__ void rms_row_to_bf16(const float* xrow, const float* g, bf16_t* orow, int lane) {
    const f32x4* xr = (const f32x4*)xrow + lane; const f32x4* gr = (const f32x4*)g + lane;
    f32x4 v[4]; float s = 0.f;
#pragma unroll
    for (int j = 0; j < 4; ++j) { v[j] = xr[64 * j]; s += (v[j].x * v[j].x + v[j].y * v[j].y) + (v[j].z * v[j].z + v[j].w * v[j].w); }
    const float rstd = 1.0f / sqrtf(wave_sum(s) * (1.0f / D) + EPS);
    u32x2* o8 = (u32x2*)orow + lane;
#pragma unroll
    for (int j = 0; j < 4; ++j) { const f32x4 gg = gr[64 * j]; u32x2 o; o.x = pkbf(v[j].x * rstd * gg.x, v[j].y * rstd * gg.y); o.y = pkbf(v[j].z * rstd * gg.z, v[j].w * rstd * gg.w); o8[64 * j] = o; }
}
__device__ __forceinline__ void p0_prologue(Frame& F) {
    LAS float* scr = (LAS float*)(F.lds + F.wave * 17408);
    const int gw = F.vcu * 8 + F.wave, NGW = F.G * 8;
    constexpr int I_IN = 16 * 64, I_OUT = 16 * 32, I_PG = 16 * 32, I_PP = 4 * 32, I_E = EXPERT_FP8 ? 512 : 1024;
    constexpr int NSMALL = I_IN + I_OUT + I_PG + I_PP, NITEMS = NSMALL + 3 * 16 * I_E;
    bf16_t* Win_t = WSP(bf16_t, WS_WIN); bf16_t* Wout_t = WSP(bf16_t, WS_WOUT); bf16_t* Wpg_t = WSP(bf16_t, WS_WPG); bf16_t* Wpp_t = WSP(bf16_t, WS_WPP);
    bf16_t* Wgu_t = WSP(bf16_t, WS_WGU); bf16_t* Wd_t = WSP(bf16_t, WS_WD);
    const int nitems = (EXPERT_FP8 && F.G == 256) ? NSMALL : NITEMS;
    for (int it = gw; it < nitems; it += NGW) {
        int r = it;
        if (r < I_IN) { tr_item(F_w_in, 1024, 2048, Win_t, r / 64, r % 64, 32 * (r % 64), scr, F.lane); continue; } r -= I_IN;
        if (r < I_OUT) { tr_item(F_w_out, 1024, 1024, Wout_t, r / 32, r % 32, 32 * (r % 32), scr, F.lane); continue; } r -= I_OUT;
        if (r < I_PG) { tr_item(F_w_ple_gate, 1024, 1024, Wpg_t, r / 32, r % 32, 32 * (r % 32), scr, F.lane); continue; } r -= I_PG;
        if (r < I_PP) { tr_item(F_w_ple_proj, 256, 1024, Wpp_t, r / 32, r % 32, 32 * (r % 32), scr, F.lane); continue; } r -= I_PP;
        const int mat = r / (16 * I_E), e = (r / I_E) % 16, q = r % I_E;
#if EXPERT_FP8
        unsigned char* Wgu8 = WSP(unsigned char, WS_WGU); unsigned char* Wd8 = WSP(unsigned char, WS_WD);
        if (mat < 2) { const int kb = q / 64, nb = q % 64, n0 = 32 * nb;
            tr_item8((mat == 0 ? F_w_gate : F_w_up) + (size_t)e * 1024 * 2048, 1024, 2048, Wgu8, kb, nb, e * 4096 + (n0 >> 7) * 256 + ((n0 >> 5) & 3) * 64 + 32 * mat, mat == 1 ? FP8_WSCALE * FP8_HSCALE : FP8_WSCALE, scr, F.lane);
        } else { const int kb = q / 32, nb = q % 32;
            tr_item8(F_w_down + (size_t)e * 2048 * 1024, 2048, 1024, Wd8, kb, nb, e * 1024 + 32 * nb, FP8_WSCALE, scr, F.lane); }
        continue;
#endif
        if (mat < 2) {
            const int kb = q / 64, nb = q % 64, n0 = 32 * nb;
            tr_item((mat == 0 ? F_w_gate : F_w_up) + (size_t)e * 1024 * 2048, 1024, 2048, Wgu_t, kb, nb, e * 4096 + (n0 >> 7) * 256 + ((n0 >> 5) & 3) * 64 + 32 * mat, scr, F.lane);
        } else {
            const int kb = q / 32, nb = q % 32;
            tr_item(F_w_down + (size_t)e * 2048 * 1024, 2048, 1024, Wd_t, kb, nb, e * 1024 + 32 * nb, scr, F.lane);
        }
    }
    bf16_t* XN = WSP(bf16_t, WS_XN);
    for (int m = gw; m < T; m += NGW) rms_row_to_bf16(F_x + (size_t)m * D, F_norm_mix, XN + (size_t)m * D, F.lane);
    { const int gt = F.vcu * 512 + F.tid, NT_ = F.G * 512; const f32x4* p4 = (const f32x4*)F_p; u32x2* o = WSP(u32x2, WS_PB);
      for (int i = gt; i < T * PD / 4; i += NT_) { const f32x4 v = p4[i]; u32x2 w; w.x = pkbf(v.x, v.y); w.y = pkbf(v.z, v.w); o[i] = w; }
      bf16_t* Wp = WSP(bf16_t, WS_WPOOL);
      for (int i = gt; i < 4 * 128 * 128; i += NT_) { const int gg = i >> 14, n = (i >> 7) & 127, k = i & 127; const float v = F_w_pool[(gg * 128 + k) * 128 + n] * F_pool_scale[gg * 128 + n]; Wp[i] = (bf16_t)(pkbf(v, 0.f) & 0xffffu); }
    }
}

#if EXPERT_FP8
struct CvTile { const float* src; unsigned char* dst; int N, K; bool up; };
__device__ __forceinline__ bool cv_decode(const Frame& F, int tile, int lane, CvTile& t) {
    const int mat = tile >> 14, e = (tile >> 10) & 15, q = tile & 1023; const int i = lane & 15, g = lane >> 4;
    int kb, nb, N, K, drow; const float* W; unsigned char* WT;
    if (mat < 2) { kb = q >> 6; nb = q & 63; N = 2048; K = 1024; W = (mat == 0 ? F_w_gate : F_w_up) + (size_t)e * 1024 * 2048; WT = WSP(unsigned char, WS_WGU);
        const int n0 = 32 * nb; drow = e * 4096 + (n0 >> 7) * 256 + ((n0 >> 5) & 3) * 64 + 32 * mat; }
    else { kb = q >> 5; nb = q & 31; N = 1024; K = 2048 + PAD_WD; W = F_w_down + (size_t)e * 2048 * 1024; WT = WSP(unsigned char, WS_WD); drow = e * 1024 + 32 * nb; }
    t.src = W + (size_t)(64 * kb + 16 * (i >> 2) + (i & 3)) * N + 32 * nb + 8 * g;
    t.dst = WT + (size_t)(drow + i) * K + 64 * kb + 16 * g;
    t.N = N; t.K = K; t.up = (mat == 1); return true;
}
__device__ __forceinline__ void p1_convert_experts(Frame& F, int cw, int ncw) {
    const int lane = F.lane, i = lane & 15, g = lane >> 4;
    bf16x8 s32[2], s256[2];
#pragma unroll
    for (int h = 0; h < 2; ++h)
#pragma unroll
        for (int j = 0; j < 8; ++j) { const bool on = (8 * g + j) == (i + 16 * h); s32[h][j] = on ? (short)0x4200 : (short)0; s256[h][j] = on ? (short)0x4380 : (short)0; }
    f32x4 bA[8], bB[8], bC[8]; CvTile tA, tB, tC;
    const int last = cw + ((3 * 16 * 1024 - 1 - cw) / ncw) * ncw;
#define CV_LOAD(buf, tt, tile) do { const int t_ = (tile) < last ? (tile) : last; (void)cv_decode(F, t_, lane, tt); _Pragma("unroll") for (int m = 0; m < 4; ++m) { const float* p_ = tt.src + (size_t)(4 * m) * tt.N; buf[2 * m] = *(const f32x4*)p_; buf[2 * m + 1] = *(const f32x4*)(p_ + 4); } } while (0)
#define CV_PROC(buf, tt) do { f32x4 d0[4], d1[4]; const bf16x8 sl0 = tt.up ? s256[0] : s32[0], sl1 = tt.up ? s256[1] : s32[1]; \
        _Pragma("unroll") for (int m = 0; m < 4; ++m) { u32x4 aw; aw.x = pkbf(buf[2 * m][0], buf[2 * m][1]); aw.y = pkbf(buf[2 * m][2], buf[2 * m][3]); aw.z = pkbf(buf[2 * m + 1][0], buf[2 * m + 1][1]); aw.w = pkbf(buf[2 * m + 1][2], buf[2 * m + 1][3]); \
            const bf16x8 af = __builtin_bit_cast(bf16x8, aw); const f32x4 z = (f32x4){0.f, 0.f, 0.f, 0.f}; \
            d0[m] = __builtin_amdgcn_mfma_f32_16x16x32_bf16(af, sl0, z, 0, 0, 0); d1[m] = __builtin_amdgcn_mfma_f32_16x16x32_bf16(af, sl1, z, 0, 0, 0); } \
        u32x4 o0, o1; o0.x = pk4_fp8(d0[0][0], d0[0][1], d0[0][2], d0[0][3]); o0.y = pk4_fp8(d0[1][0], d0[1][1], d0[1][2], d0[1][3]); o0.z = pk4_fp8(d0[2][0], d0[2][1], d0[2][2], d0[2][3]); o0.w = pk4_fp8(d0[3][0], d0[3][1], d0[3][2], d0[3][3]); \
        o1.x = pk4_fp8(d1[0][0], d1[0][1], d1[0][2], d1[0][3]); o1.y = pk4_fp8(d1[1][0], d1[1][1], d1[1][2], d1[1][3]); o1.z = pk4_fp8(d1[2][0], d1[2][1], d1[2][2], d1[2][3]); o1.w = pk4_fp8(d1[3][0], d1[3][1], d1[3][2], d1[3][3]); \
        *(u32x4*)tt.dst = o0; *(u32x4*)(tt.dst + (size_t)16 * tt.K) = o1; } while (0)
    int tile = cw;
    CV_LOAD(bA, tA, tile); CV_LOAD(bB, tB, tile + ncw);
    for (; tile <= last; tile += 3 * ncw) {
        CV_LOAD(bC, tC, tile + 2 * ncw); CV_PROC(bA, tA);
        CV_LOAD(bA, tA, tile + 3 * ncw); CV_PROC(bB, tB);
        CV_LOAD(bB, tB, tile + 4 * ncw); CV_PROC(bC, tC);
    }
#undef CV_LOAD
#undef CV_PROC
}
#endif

typedef f32x4 AccT[2][2][4][2];
struct EpiQKV {
    static constexpr bool AFTER_DRAIN = false;
    bf16_t *U, *Q, *Kk, *VT; const float *qn, *kn;
    __device__ __forceinline__ void operator()(const AccT& acc, const pg8::Unit& u, int wr, int wc, int, int) const {
        int ln_ = (int)__builtin_amdgcn_mbcnt_hi(~0u, __builtin_amdgcn_mbcnt_lo(~0u, 0u)); asm volatile("" : "+v"(ln_));
        const int fr = ln_ & 15, fq = ln_ >> 4;
        const int type = u.pn >> 1; const int row0 = u.pm * 256 + wr * 64 + fr;
        if (type == 0) {
#pragma unroll
            for (int ai = 0; ai < 2; ++ai)
#pragma unroll
                for (int m = 0; m < 4; ++m) { const int row = row0 + ai * 128 + m * 16; bf16_t* rp = U + (size_t)row * 512 + (u.pn & 1) * 256 + wc * 64 + 8 * fq;
#pragma unroll
                    for (int bj = 0; bj < 2; ++bj) { const f32x4 v0 = acc[ai][bj][m][0], v1 = acc[ai][bj][m][1]; u32x4 w; w.x = pkbf(v0[0], v0[1]); w.y = pkbf(v0[2], v0[3]); w.z = pkbf(v1[0], v1[1]); w.w = pkbf(v1[2], v1[3]); *(u32x4*)(rp + bj * 32) = w; } asm volatile("" ::: "memory"); }
        } else if (type == 3) {
            const int hh = (u.pn & 1) * 4 + wc; const int t = fr & 3; const bool o1 = (t & 1) != 0, o2 = (t & 2) != 0;
#pragma unroll
            for (int ai = 0; ai < 2; ++ai)
#pragma unroll
                for (int m = 0; m < 4; ++m) { const int row = u.pm * 256 + wr * 64 + ai * 128 + m * 16 + (fr & 12); const int b = row >> 11, s_ = row & 2047;
                    bf16_t* bp = VT + ((size_t)((b * 8 + hh) * 32 + (s_ >> 6)) * 64 + 8 * fq + t) * 64 + (s_ & 63);
#pragma unroll
                    for (int bj = 0; bj < 2; ++bj)
#pragma unroll
                        for (int n = 0; n < 2; ++n) { const f32x4 x = acc[ai][bj][m][n];
                            const float p0 = __builtin_bit_cast(float, __builtin_amdgcn_update_dpp(0, __builtin_bit_cast(int, o1 ? x[0] : x[1]), 0xB1, 0xF, 0xF, false));
                            const float p1 = __builtin_bit_cast(float, __builtin_amdgcn_update_dpp(0, __builtin_bit_cast(int, o1 ? x[2] : x[3]), 0xB1, 0xF, 0xF, false));
                            const float y0 = o1 ? p0 : x[0], y1 = o1 ? x[1] : p0, y2 = o1 ? p1 : x[2], y3 = o1 ? x[3] : p1;
                            const float q0 = __builtin_bit_cast(float, __builtin_amdgcn_update_dpp(0, __builtin_bit_cast(int, o2 ? y0 : y2), 0x4E, 0xF, 0xF, false));
                            const float q1 = __builtin_bit_cast(float, __builtin_amdgcn_update_dpp(0, __builtin_bit_cast(int, o2 ? y1 : y3), 0x4E, 0xF, 0xF, false));
                            const float z0 = o2 ? q0 : y0, z1 = o2 ? q1 : y1, z2 = o2 ? y2 : q0, z3 = o2 ? y3 : q1;
                            u32x2 w; w.x = pkbf(z0, z1); w.y = pkbf(z2, z3);
                            *(u32x2*)(bp + (32 * bj + 4 * n) * 64) = w; }
                    asm volatile("" ::: "memory"); }
        } else {
            const int hh = (u.pn & 1) * 4 + wc; const float* gn = (type == 1) ? qn : kn; const float sc = (type == 1) ? 0.125f * LOG2E : 1.0f; bf16_t* dst = (type == 1) ? Q : Kk;
            f32x4 gv[2][2];
#pragma unroll
            for (int bj = 0; bj < 2; ++bj)
#pragma unroll
                for (int n = 0; n < 2; ++n) gv[bj][n] = *(const f32x4*)(gn + 32 * bj + 8 * fq + 4 * n) * sc;
#pragma unroll
            for (int ai = 0; ai < 2; ++ai)
#pragma unroll
                for (int m = 0; m < 4; ++m) { const int row = row0 + ai * 128 + m * 16; const int b = row >> 11, s = row & 2047;
                    float ss = 0.f;
#pragma unroll
                    for (int bj = 0; bj < 2; ++bj)
#pragma unroll
                        for (int n = 0; n < 2; ++n) { const f32x4 v = acc[ai][bj][m][n]; ss += (v[0] * v[0] + v[1] * v[1]) + (v[2] * v[2] + v[3] * v[3]); }
                    ss += __shfl_xor(ss, 16); ss += __shfl_xor(ss, 32);
                    const float rstd = 1.0f / sqrtf(ss * (1.0f / 64.0f) + EPS);
                    bf16_t* rp = dst + ((size_t)(b * 8 + hh) * 2048 + s) * 64 + 8 * fq;
#pragma unroll
                    for (int bj = 0; bj < 2; ++bj) { const f32x4 v0 = acc[ai][bj][m][0] * gv[bj][0] * rstd, v1 = acc[ai][bj][m][1] * gv[bj][1] * rstd; u32x4 w; w.x = pkbf(v0[0], v0[1]); w.y = pkbf(v0[2], v0[3]); w.z = pkbf(v1[0], v1[1]); w.w = pkbf(v1[2], v1[3]); *(u32x4*)(rp + bj * 32) = w; } asm volatile("" ::: "memory"); }
        }
    }
};
struct EpiE {
    static constexpr bool AFTER_DRAIN = false;
    bf16_t* EB; float* esq;
    __device__ __forceinline__ void operator()(const AccT& acc, const pg8::Unit& u, int wr, int wc, int, int) const {
        int ln_ = (int)__builtin_amdgcn_mbcnt_hi(~0u, __builtin_amdgcn_mbcnt_lo(~0u, 0u)); asm volatile("" : "+v"(ln_));
        const int fr = ln_ & 15, fq = ln_ >> 4;
        const int row0 = u.pm * 256 + wr * 64 + fr;
#pragma unroll
        for (int ai = 0; ai < 2; ++ai)
#pragma unroll
            for (int m = 0; m < 4; ++m) { const int row = row0 + ai * 128 + m * 16; bf16_t* rp = EB + (size_t)row * 1024 + u.pn * 256 + wc * 64 + 8 * fq; float ss = 0.f;
#pragma unroll
                for (int bj = 0; bj < 2; ++bj) { const f32x4 v0 = acc[ai][bj][m][0], v1 = acc[ai][bj][m][1];
                    ss += (v0[0] * v0[0] + v0[1] * v0[1]) + (v0[2] * v0[2] + v0[3] * v0[3]) + (v1[0] * v1[0] + v1[1] * v1[1]) + (v1[2] * v1[2] + v1[3] * v1[3]);
                    u32x4 w; w.x = pkbf(v0[0], v0[1]); w.y = pkbf(v0[2], v0[3]); w.z = pkbf(v1[0], v1[1]); w.w = pkbf(v1[2], v1[3]); *(u32x4*)(rp + bj * 32) = w; }
                ss += __shfl_xor(ss, 16); ss += __shfl_xor(ss, 32);
                if (fq == 0) esq[(size_t)row * 16 + u.pn * 4 + wc] = ss; asm volatile("" ::: "memory"); }
    }
};
struct EpiRes {
    static constexpr bool AFTER_DRAIN = false;
    const float* x; float* out;
    __device__ __forceinline__ void operator()(const AccT& acc, const pg8::Unit& u, int wr, int wc, int, int) const {
        int ln_ = (int)__builtin_amdgcn_mbcnt_hi(~0u, __builtin_amdgcn_mbcnt_lo(~0u, 0u)); asm volatile("" : "+v"(ln_));
        const int fr = ln_ & 15, fq = ln_ >> 4;
        const int row0 = u.pm * 256 + wr * 64 + fr; const int col0 = u.pn * 256 + wc * 64 + 8 * fq;
#pragma unroll
        for (int ai = 0; ai < 2; ++ai)
#pragma unroll
            for (int m = 0; m < 4; ++m) { const size_t off = (size_t)(row0 + ai * 128 + m * 16) * 1024 + col0;
#pragma unroll
                for (int bj = 0; bj < 2; ++bj)
#pragma unroll
                    for (int n = 0; n < 2; ++n) { const f32x4 xv = *(const f32x4*)(x + off + bj * 32 + n * 4); *(f32x4*)(out + off + bj * 32 + n * 4) = xv + acc[ai][bj][m][n]; }
                if (m & 1) asm volatile("" ::: "memory"); }
    }
};
struct EpiX1 {
    static constexpr bool AFTER_DRAIN = true;
    const float* x; const float* gffn; const float* wrt; bf16_t* H2; float* part;
    __device__ __forceinline__ void fused(AccT& acc, const pg8::Unit& u, LAS unsigned char* lds, int wid) const {
        const int tid = threadIdx.x; int ln_ = (int)__builtin_amdgcn_mbcnt_hi(~0u, __builtin_amdgcn_mbcnt_lo(~0u, 0u)); asm volatile("" : "+v"(ln_));
        const int fr = ln_ & 15, fq = ln_ >> 4, wr_ = wid >> 2, wc = wid & 3;
        LAS bf16_t* whi = (LAS bf16_t*)lds; LAS bf16_t* wlo = (LAS bf16_t*)(lds + 8448); LAS float* P = (LAS float*)(lds + 16896);
        constexpr int WP = 264, PR = 68;
#pragma unroll
        for (int k = 0; k < 8; ++k) { const int idx = tid + 512 * k, ct = idx >> 4, e = idx & 15; const float wv = wrt[(size_t)(u.pn * 256 + ct) * 16 + e];
            const unsigned hb = pkbf(wv, 0.f) & 0xffffu; const float hf = __builtin_bit_cast(float, hb << 16);
            whi[e * WP + ct] = (bf16_t)hb; wlo[e * WP + ct] = (bf16_t)(pkbf(wv - hf, 0.f) & 0xffffu); }
        const int row0 = u.pm * 256 + wr_ * 64 + fr, col0 = u.pn * 256 + wc * 64 + 8 * fq;
        f32x4 gv[2][2];
#pragma unroll
        for (int bj = 0; bj < 2; ++bj)
#pragma unroll
            for (int n = 0; n < 2; ++n) gv[bj][n] = *(const f32x4*)(gffn + col0 + bj * 32 + n * 4);
        f32x4 xn[2][2];
#define X1_LOADX(ai, m) do { const float* xp_ = x + (size_t)(row0 + (ai) * 128 + (m) * 16) * 1024 + col0; _Pragma("unroll") for (int bj = 0; bj < 2; ++bj) _Pragma("unroll") for (int n = 0; n < 2; ++n) xn[bj][n] = *(const f32x4*)(xp_ + bj * 32 + n * 4); } while (0)
        X1_LOADX(0, 0);
        asm volatile("s_waitcnt lgkmcnt(0)" ::: "memory"); __syncthreads();
        bf16x8 ahi[2], alo[2];
#pragma unroll
        for (int bj = 0; bj < 2; ++bj) { ahi[bj] = *(const LAS bf16x8*)(whi + fr * WP + wc * 64 + 32 * bj + 8 * fq); alo[bj] = *(const LAS bf16x8*)(wlo + fr * WP + wc * 64 + 32 * bj + 8 * fq); }
#pragma unroll
        for (int ai = 0; ai < 2; ++ai)
#pragma unroll
            for (int m = 0; m < 4; ++m) {
                f32x4 x1[2][2];
#pragma unroll
                for (int bj = 0; bj < 2; ++bj)
#pragma unroll
                    for (int n = 0; n < 2; ++n) x1[bj][n] = acc[ai][bj][m][n] + xn[bj][n];
                asm volatile("" : "+v"(x1[0][0]), "+v"(x1[0][1]), "+v"(x1[1][0]), "+v"(x1[1][1]));
                if (ai * 4 + m < 7) { const int g2 = ai * 4 + m + 1; X1_LOADX(g2 >> 2, g2 & 3); }
                float ss = 0.f; f32x4 pl = (f32x4){0.f, 0.f, 0.f, 0.f};
                bf16_t* rp = H2 + (size_t)(row0 + ai * 128 + m * 16) * 1024 + col0;
#pragma unroll
                for (int bj = 0; bj < 2; ++bj) { f32x4 h0, h1;
                    { const f32x4 v = x1[bj][0]; ss += (v[0] * v[0] + v[1] * v[1]) + (v[2] * v[2] + v[3] * v[3]); h0 = v * gv[bj][0]; }
                    { const f32x4 v = x1[bj][1]; ss += (v[0] * v[0] + v[1] * v[1]) + (v[2] * v[2] + v[3] * v[3]); h1 = v * gv[bj][1]; }
                    u32x4 wh; wh.x = pkbf(h0[0], h0[1]); wh.y = pkbf(h0[2], h0[3]); wh.z = pkbf(h1[0], h1[1]); wh.w = pkbf(h1[2], h1[3]);
                    *(u32x4*)(rp + bj * 32) = wh;
                    u32x4 wl; wl.x = pkbf(h0[0] - bflo(wh.x), h0[1] - bfhi(wh.x)); wl.y = pkbf(h0[2] - bflo(wh.y), h0[3] - bfhi(wh.y)); wl.z = pkbf(h1[0] - bflo(wh.z), h1[1] - bfhi(wh.z)); wl.w = pkbf(h1[2] - bflo(wh.w), h1[3] - bfhi(wh.w));
                    const bf16x8 bh = __builtin_bit_cast(bf16x8, wh), bl = __builtin_bit_cast(bf16x8, wl);
                    pl = __builtin_amdgcn_mfma_f32_16x16x32_bf16(ahi[bj], bh, pl, 0, 0, 0); pl = __builtin_amdgcn_mfma_f32_16x16x32_bf16(ahi[bj], bl, pl, 0, 0, 0); pl = __builtin_amdgcn_mfma_f32_16x16x32_bf16(alo[bj], bh, pl, 0, 0, 0); }
                ss += __shfl_xor(ss, 16); ss += __shfl_xor(ss, 32);
                LAS float* pp = P + (ai * 128 + wr_ * 64 + m * 16 + fr) * PR;
                *(LAS f32x4*)(pp + wc * 16 + 4 * fq) = pl;
                if (fq == 0) pp[64 + wc] = ss;
                __builtin_amdgcn_sched_barrier(0); }
#undef X1_LOADX
        asm volatile("s_waitcnt lgkmcnt(0)" ::: "memory"); __syncthreads();
        if (tid < 256) { const LAS f32x4* p4 = (const LAS f32x4*)(P + tid * PR); float tot[20];
            const f32x4 s4 = p4[16]; tot[0] = (s4[0] + s4[1]) + (s4[2] + s4[3]);
#pragma unroll
            for (int q = 0; q < 4; ++q) { const f32x4 t4 = (p4[q] + p4[4 + q]) + (p4[8 + q] + p4[12 + q]); tot[1 + 4 * q] = t4[0]; tot[2 + 4 * q] = t4[1]; tot[3 + 4 * q] = t4[2]; tot[4 + 4 * q] = t4[3]; }
            tot[17] = 0.f; tot[18] = 0.f; tot[19] = 0.f;
            f32x4* dst = (f32x4*)(part + ((size_t)(u.pm * 256 + tid) * 4 + u.pn) * 20);
#pragma unroll
            for (int k = 0; k < 5; ++k) dst[k] = (f32x4){tot[4 * k], tot[4 * k + 1], tot[4 * k + 2], tot[4 * k + 3]}; }
    }
};
struct EpiGU {
    static constexpr bool AFTER_DRAIN = false;
    bf16_t* HH;
    __device__ __forceinline__ void operator()(const AccT& acc, const pg8::Unit& u, int wr, int wc, int, int) const {
        int ln_ = (int)__builtin_amdgcn_mbcnt_hi(~0u, __builtin_amdgcn_mbcnt_lo(~0u, 0u)); asm volatile("" : "+v"(ln_));
        const int fr = ln_ & 15, fq = ln_ >> 4;
        const int row0 = u.arow + wr * 64 + fr; const int col0 = u.pn * 128 + wc * 32 + 8 * fq;
#pragma unroll
        for (int ai = 0; ai < 2; ++ai)
#pragma unroll
            for (int m = 0; m < 4; ++m) { float h[8];
#pragma unroll
                for (int n = 0; n < 2; ++n)
#pragma unroll
                    for (int i = 0; i < 4; ++i) { const float a = acc[ai][0][m][n][i], b = acc[ai][1][m][n][i]; h[4 * n + i] = a * __builtin_amdgcn_rcpf(1.0f + __builtin_amdgcn_exp2f(-LOG2E * a)) * b; }
#if EXPERT_FP8
#pragma unroll
                for (int q = 0; q < 8; ++q) h[q] = __builtin_amdgcn_fmed3f(h[q], -448.f, 448.f);
                u32x2 w; w.x = pk4_fp8(h[0], h[1], h[2], h[3]); w.y = pk4_fp8(h[4], h[5], h[6], h[7]);
                *(u32x2*)((unsigned char*)HH + (size_t)(row0 + ai * 128 + m * 16) * (2048 + PAD_HH) + col0) = w; __builtin_amdgcn_sched_barrier(0); }
#else
                u32x4 w; w.x = pkbf(h[0], h[1]); w.y = pkbf(h[2], h[3]); w.z = pkbf(h[4], h[5]); w.w = pkbf(h[6], h[7]);
                *(u32x4*)(HH + (size_t)(row0 + ai * 128 + m * 16) * 2048 + col0) = w; }
#endif
    }
};
struct EpiDown {
    static constexpr bool AFTER_DRAIN = false;
    bf16_t* YE; const float* gates;
    __device__ __forceinline__ void operator()(const AccT& acc, const pg8::Unit& u, int wr, int wc, int, int) const {
        int ln_ = (int)__builtin_amdgcn_mbcnt_hi(~0u, __builtin_amdgcn_mbcnt_lo(~0u, 0u)); asm volatile("" : "+v"(ln_));
        const int fr = ln_ & 15, fq = ln_ >> 4;
        const int row0 = u.arow + wr * 64 + fr; const int col0 = u.pn * 256 + wc * 64 + 8 * fq;
#pragma unroll
        for (int ai = 0; ai < 2; ++ai)
#pragma unroll
            for (int m = 0; m < 4; ++m) { const int row = row0 + ai * 128 + m * 16; const float gt = gates[row]; bf16_t* rp = YE + (size_t)row * 1024 + col0;
#pragma unroll
                for (int bj = 0; bj < 2; ++bj) { const f32x4 v0 = acc[ai][bj][m][0] * gt, v1 = acc[ai][bj][m][1] * gt; u32x4 w; w.x = pkbf(v0[0], v0[1]); w.y = pkbf(v0[2], v0[3]); w.z = pkbf(v1[0], v1[1]); w.w = pkbf(v1[2], v1[3]); *(u32x4*)(rp + bj * 32) = w; } __builtin_amdgcn_sched_barrier(0); }
    }
};
struct EpiFinal {
    static constexpr bool AFTER_DRAIN = false;
    float* outw; const bf16_t* X2N; const bf16_t* EB; const float* rstde; const float* rms2; const float* gpost; const float* gple;
    __device__ __forceinline__ void operator()(const AccT& acc, const pg8::Unit& u, int wr, int wc, int, int) const {
        int ln_ = (int)__builtin_amdgcn_mbcnt_hi(~0u, __builtin_amdgcn_mbcnt_lo(~0u, 0u)); asm volatile("" : "+v"(ln_));
        const int fr = ln_ & 15, fq = ln_ >> 4;
        const int row0 = u.pm * 256 + wr * 64 + fr; const int col0 = u.pn * 256 + wc * 64 + 8 * fq;
        f32x4 gp[2][2], gi[2][2];
#pragma unroll
        for (int bj = 0; bj < 2; ++bj)
#pragma unroll
            for (int n = 0; n < 2; ++n) { gp[bj][n] = *(const f32x4*)(gpost + col0 + bj * 32 + n * 4); const f32x4 gg = *(const f32x4*)(gple + col0 + bj * 32 + n * 4);
                gi[bj][n] = (f32x4){1.0f / gg[0], 1.0f / gg[1], 1.0f / gg[2], 1.0f / gg[3]}; }
#pragma unroll
        for (int ai = 0; ai < 2; ++ai)
#pragma unroll
            for (int m = 0; m < 4; ++m) { const int row = row0 + ai * 128 + m * 16; const size_t off = (size_t)row * 1024 + col0; const float re = rstde[row], rm = rms2[row];
#pragma unroll
                for (int bj = 0; bj < 2; ++bj) { const u32x4 ev = *(const u32x4*)(EB + off + bj * 32); const u32x4 xv = *(const u32x4*)(X2N + off + bj * 32);
                    const f32x4 e0 = (f32x4){bflo(ev.x), bfhi(ev.x), bflo(ev.y), bfhi(ev.y)} * gp[bj][0] * re, e1 = (f32x4){bflo(ev.z), bfhi(ev.z), bflo(ev.w), bfhi(ev.w)} * gp[bj][1] * re;
                    const f32x4 x0 = (f32x4){bflo(xv.x), bfhi(xv.x), bflo(xv.y), bfhi(xv.y)} * gi[bj][0] * rm, x1 = (f32x4){bflo(xv.z), bfhi(xv.z), bflo(xv.w), bfhi(xv.w)} * gi[bj][1] * rm;
                    const f32x4 a0 = acc[ai][bj][m][0], a1 = acc[ai][bj][m][1]; f32x4 g0, g1;
#pragma unroll
                    for (int i = 0; i < 4; ++i) { g0[i] = __builtin_amdgcn_rcpf(1.0f + __builtin_amdgcn_exp2f(-LOG2E * a0[i])); g1[i] = __builtin_amdgcn_rcpf(1.0f + __builtin_amdgcn_exp2f(-LOG2E * a1[i])); }
                    *(f32x4*)(outw + off + bj * 32) = x0 + g0 * e0; *(f32x4*)(outw + off + bj * 32 + 4) = x1 + g1 * e1; }
                asm volatile("" ::: "memory"); __builtin_amdgcn_sched_barrier(0); }
    }
};
struct OrderGU {
    int G, vcu;
    __device__ bool next(int i, pg8::Unit& u) const {
        int e, b, nt;
        if (G == 256) { if (i >= 8) return false; const int x = vcu >> 5, cu = vcu & 31; e = 2 * x + (i >> 2); b = cu & 7; nt = 4 * (i & 3) + (cu >> 3); }
        else { const int L = i * G + vcu; if (L >= 2048) return false; e = L >> 7; b = L & 7; nt = (L >> 3) & 15; }
        u.arow = (b * 16 + e) * 256; u.brow = e * 4096 + nt * 256; u.pm = b; u.pn = nt; u.grp = e; return true;
    }
};
struct OrderDown {
    int G, vcu;
    __device__ bool next(int i, pg8::Unit& u) const {
        int e, b, nt;
        if (G == 256) { if (i >= 2) return false; const int x = vcu >> 5, cu = vcu & 31; e = 2 * x + i; b = cu & 7; nt = cu >> 3; }
        else { const int L = i * G + vcu; if (L >= 512) return false; e = L >> 5; b = L & 7; nt = (L >> 3) & 3; }
        u.arow = (b * 16 + e) * 256; u.brow = e * 1024 + nt * 256; u.pm = b; u.pn = nt; u.grp = e; return true;
    }
};

constexpr int UT_OFF = 32768, UT_PITCH = 136, UT_ROWS = 272;
constexpr int AT_KOFF = 0, AT_VOFF = 9 * 8192, AT_B2OFF = 18 * 8192, AT_SCR = AT_B2OFF + 2048;
static_assert(AT_SCR + 2 * 17 * 64 * 4 <= LDSCTL_OFF, "attention LDS map");
__device__ __forceinline__ int at_fk(int row) { return ((row >> 1) & 1) | (((row >> 3) & 3) << 1); }
__device__ __forceinline__ int at_fv(int row) { return (row >> 1) & 7; }
__device__ __forceinline__ void attn_block(Frame& F, int bh, int r0) {
    const int tid = F.tid, lane = F.lane, g = lane >> 4, m = lane & 15, w = F.wave; const int b = bh >> 3, h = bh & 7;
    const int qb = (w == 0) ? 0 : (w <= 2) ? 1 : (w <= 4) ? 2 : 3; const int kp = (w == 0) ? 0 : (w == 5) ? 1 : ((w - 1) & 1); const bool active = w < 6;
    LAS float* b2 = (LAS float*)(F.lds + AT_B2OFF);
    for (int i = tid; i < 15 * 32; i += 512) { const int dc = i & 31; b2[i] = dc < 31 ? F_rpb[(h * 15 + (i >> 5)) * 31 + dc] * LOG2E : 0.f; }
    const int lrow = tid >> 3, lpos = tid & 7;
    const char* ksrc = (const char*)WSP(const bf16_t, WS_K) + ((size_t)bh * 2048 * 64 + (size_t)lrow * 64) * 2 + ((lpos ^ at_fk(lrow)) * 16);
    const char* vsrc = (const char*)WSP(const bf16_t, WS_VT) + ((size_t)bh * 32 * 4096 + (size_t)lrow * 64) * 2 + ((lpos ^ at_fv(lrow)) * 16);
#define AT_DMA(k) do { const int sl_ = (k) % 9; \
        __builtin_amdgcn_global_load_lds((const unsigned*)(ksrc + (size_t)(k) * 8192), (LAS unsigned*)(F.lds + AT_KOFF + sl_ * 8192 + w * 1024), 16, 0, 0); \
        __builtin_amdgcn_global_load_lds((const unsigned*)(vsrc + (size_t)(k) * 8192), (LAS unsigned*)(F.lds + AT_VOFF + sl_ * 8192 + w * 1024), 16, 0, 0); } while (0)
    int rs0 = r0 - 4; rs0 = rs0 < 0 ? 0 : (rs0 > ROWS - 8 ? ROWS - 8 : rs0);
    for (int k = rs0; k < rs0 + 8; ++k) AT_DMA(k);
    const int c = 16 * qb + m; int cs = c - 8; cs = cs < 0 ? 0 : (cs > GW - 16 ? GW - 16 : cs);
    const bf16_t* Qp = WSP(const bf16_t, WS_Q) + ((size_t)(bh * 2048 + 64 * r0 + c) * 64 + 8 * g);
    bf16x8 qn0 = *(const bf16x8*)Qp, qn1 = *(const bf16x8*)(Qp + 32);
    const int rowA = 32 * kp + 8 * (m >> 2) + (m & 3);
    const int kofs0 = rowA * 128 + ((g ^ at_fk(rowA)) * 16), kofs1 = rowA * 128 + (((4 + g) ^ at_fk(rowA)) * 16);
    const int vofs = m * 128 + (((4 * kp + g) ^ at_fv(m)) * 16);
    const int kc0 = 32 * kp + 8 * g;
    bf16_t* mixb = WSP(bf16_t, WS_MIX) + (size_t)(b * 2048) * 1024 + 512 + h * 64 + 4 * g + (size_t)c * 1024;
    LAS float* scr = (LAS float*)(F.lds + AT_SCR) + ((w - 1) >> 1) * (17 * 64) + lane;
    asm volatile("s_waitcnt vmcnt(0) lgkmcnt(0)" ::: "memory"); __syncthreads();
    for (int rr = 0; rr < 8; ++rr) {
        const int r = r0 + rr; int rs = r - 4; rs = rs < 0 ? 0 : (rs > ROWS - 8 ? ROWS - 8 : rs);
        int rsn = r - 3; rsn = rsn < 0 ? 0 : (rsn > ROWS - 8 ? ROWS - 8 : rsn);
        if (rr < 7 && rsn != rs) AT_DMA(rs + 8);
        f32x4 o[4]; float l = 0.f;
#pragma unroll
        for (int dt = 0; dt < 4; ++dt) o[dt] = (f32x4){0.f, 0.f, 0.f, 0.f};
        const bf16x8 q0 = qn0, q1 = qn1;
        if (active && rr < 7) { qn0 = *(const bf16x8*)(Qp + (size_t)(rr + 1) * 4096); qn1 = *(const bf16x8*)(Qp + (size_t)(rr + 1) * 4096 + 32); }
        int sl = rs % 9;
#define AT_STEP(i) do { const LAS unsigned char* kb_ = F.lds + AT_KOFF + sl * 8192; const LAS unsigned char* vb_ = F.lds + AT_VOFF + sl * 8192 + vofs; sl = (sl == 8) ? 0 : sl + 1; \
            const bf16x8 ka0 = *(const LAS bf16x8*)(kb_ + kofs0), ka1 = *(const LAS bf16x8*)(kb_ + kofs1), kb0 = *(const LAS bf16x8*)(kb_ + kofs0 + 512), kb1 = *(const LAS bf16x8*)(kb_ + kofs1 + 512); \
            bf16x8 vf[4]; _Pragma("unroll") for (int dt = 0; dt < 4; ++dt) vf[dt] = *(const LAS bf16x8*)(vb_ + dt * 2048); \
            f32x4 sa = (f32x4){0.f, 0.f, 0.f, 0.f}, sb = (f32x4){0.f, 0.f, 0.f, 0.f}; \
            sa = __builtin_amdgcn_mfma_f32_16x16x32_bf16(ka0, q0, sa, 0, 0, 0); sa = __builtin_amdgcn_mfma_f32_16x16x32_bf16(ka1, q1, sa, 0, 0, 0); \
            sb = __builtin_amdgcn_mfma_f32_16x16x32_bf16(kb0, q0, sb, 0, 0, 0); sb = __builtin_amdgcn_mfma_f32_16x16x32_bf16(kb1, q1, sb, 0, 0, 0); \
            const LAS float* bp = bp0 + (i) * 32; float pa[4], pb[4]; \
            _Pragma("unroll") for (int q = 0; q < 4; ++q) { const float ea = __builtin_amdgcn_exp2f(sa[q] + bp[q]), eb = __builtin_amdgcn_exp2f(sb[q] + bp[4 + q]); pa[q] = va[q] ? ea : 0.f; pb[q] = vb[q] ? eb : 0.f; } \
            l += ((pa[0] + pa[1]) + (pa[2] + pa[3])) + ((pb[0] + pb[1]) + (pb[2] + pb[3])); \
            u32x4 pw; pw.x = pkbf(pa[0], pa[1]); pw.y = pkbf(pa[2], pa[3]); pw.z = pkbf(pb[0], pb[1]); pw.w = pkbf(pb[2], pb[3]); const bf16x8 pf = __builtin_bit_cast(bf16x8, pw); \
            _Pragma("unroll") for (int dt = 0; dt < 4; ++dt) o[dt] = __builtin_amdgcn_mfma_f32_16x16x32_bf16(vf[dt], pf, o[dt], 0, 0, 0); } while (0)
        const LAS float* bp0 = b2 + ((rs - r + 7) * 32 + 15 - c + kc0);
        bool va[4], vb[4];
#pragma unroll
        for (int q = 0; q < 4; ++q) { va[q] = (unsigned)(kc0 + q - cs) < 16u; vb[q] = (unsigned)(kc0 + 4 + q - cs) < 16u; }
        if (active) { AT_STEP(0); AT_STEP(1); AT_STEP(2); AT_STEP(3); }
        asm volatile("s_waitcnt lgkmcnt(0)" ::: "memory"); __builtin_amdgcn_s_barrier(); asm volatile("" ::: "memory");
        if (active) { AT_STEP(4); AT_STEP(5); AT_STEP(6); AT_STEP(7); }
#undef AT_STEP
        l += __shfl_xor(l, 16); l += __shfl_xor(l, 32);
        if (w == 2 || w == 4) {
#pragma unroll
            for (int dt = 0; dt < 4; ++dt)
#pragma unroll
                for (int q = 0; q < 4; ++q) scr[(dt * 4 + q) * 64] = o[dt][q];
            scr[16 * 64] = l;
        }
        asm volatile("s_waitcnt vmcnt(0) lgkmcnt(0)" ::: "memory"); __syncthreads();
        if (w == 1 || w == 3) {
#pragma unroll
            for (int dt = 0; dt < 4; ++dt)
#pragma unroll
                for (int q = 0; q < 4; ++q) o[dt][q] += scr[(dt * 4 + q) * 64];
            l += scr[16 * 64];
        }
        if (w == 0 || w == 1 || w == 3 || w == 5) { const float inv = 1.0f / l; bf16_t* op = mixb + (size_t)(64 * r) * 1024;
#pragma unroll
            for (int dt = 0; dt < 4; ++dt) { u32x2 ww; ww.x = pkbf(o[dt][0] * inv, o[dt][1] * inv); ww.y = pkbf(o[dt][2] * inv, o[dt][3] * inv); *(u32x2*)(op + 16 * dt) = ww; } }
    }
#undef AT_DMA
    asm volatile("s_waitcnt lgkmcnt(0)" ::: "memory"); __syncthreads();
}
__device__ __forceinline__ void pool_unit(Frame& F, int pm, int grp) {
    LAS bf16_t* Ut = (LAS bf16_t*)(F.lds + UT_OFF);
    const int tid = F.tid; const int tok0 = pm * 256, b = tok0 >> 11, t0 = tok0 & 2047;
    {   const bf16_t* Ub = WSP(const bf16_t, WS_U) + (size_t)b * 2048 * 512 + grp * 128;
        for (int i = tid; i < UT_ROWS * 16; i += 512) { const int rr = i >> 4, ch = i & 15; const int t = t0 - 8 + rr;
            u32x4 v = (u32x4){0u, 0u, 0u, 0u}; if (t >= 0 && t < S) v = *(const u32x4*)(Ub + (size_t)t * 512 + ch * 8);
            *(LAS u32x4*)(Ut + rr * UT_PITCH + ch * 8) = v; } }
    __syncthreads();
    {   const int lane = F.lane, g = lane >> 4, m = lane & 15, w = F.wave; const int hw = 1 << grp;
        const bf16_t* Wp = WSP(const bf16_t, WS_WPOOL) + (size_t)grp * 128 * 128;
        f32x4 acc[2][8];
#pragma unroll
        for (int mt = 0; mt < 2; ++mt)
#pragma unroll
            for (int nt = 0; nt < 8; ++nt) acc[mt][nt] = (f32x4){0.f, 0.f, 0.f, 0.f};
        float rc[2];
#pragma unroll
        for (int mt = 0; mt < 2; ++mt) { const int t = t0 + 32 * w + 16 * mt + m; const int lo = (t - hw) < 0 ? 0 : (t - hw), hi = (t + hw - 1) > (S - 1) ? (S - 1) : (t + hw - 1); rc[mt] = 1.0f / (float)(hi - lo + 1); }
        for (int ks = 0; ks < 4; ++ks) { bf16x8 af[2];
#pragma unroll
            for (int mt = 0; mt < 2; ++mt) { const LAS bf16_t* up = Ut + (32 * w + 16 * mt + m + 8) * UT_PITCH + 32 * ks + 8 * g;
                float sm[8];
#pragma unroll
                for (int j = 0; j < 8; ++j) sm[j] = 0.f;
                for (int q = -hw; q < hw; ++q) { const u32x4 v = *(const LAS u32x4*)(up + q * UT_PITCH);
                    sm[0] += bflo(v.x); sm[1] += bfhi(v.x); sm[2] += bflo(v.y); sm[3] += bfhi(v.y); sm[4] += bflo(v.z); sm[5] += bfhi(v.z); sm[6] += bflo(v.w); sm[7] += bfhi(v.w); }
                const u32x4 uc = *(const LAS u32x4*)up; const float r_ = rc[mt];
                u32x4 d; d.x = pkbf(sm[0] * r_ - bflo(uc.x), sm[1] * r_ - bfhi(uc.x)); d.y = pkbf(sm[2] * r_ - bflo(uc.y), sm[3] * r_ - bfhi(uc.y));
                d.z = pkbf(sm[4] * r_ - bflo(uc.z), sm[5] * r_ - bfhi(uc.z)); d.w = pkbf(sm[6] * r_ - bflo(uc.w), sm[7] * r_ - bfhi(uc.w));
                af[mt] = __builtin_bit_cast(bf16x8, d); }
#pragma unroll
            for (int nt = 0; nt < 8; ++nt) { const bf16x8 wf = *(const bf16x8*)(Wp + (size_t)(16 * nt + m) * 128 + 32 * ks + 8 * g);
#pragma unroll
                for (int mt = 0; mt < 2; ++mt) acc[mt][nt] = __builtin_amdgcn_mfma_f32_16x16x32_bf16(wf, af[mt], acc[mt][nt], 0, 0, 0); } }
        bf16_t* mix = WSP(bf16_t, WS_MIX);
#pragma unroll
        for (int mt = 0; mt < 2; ++mt)
#pragma unroll
            for (int nt = 0; nt < 8; ++nt) { u32x2 o; o.x = pkbf(acc[mt][nt][0], acc[mt][nt][1]); o.y = pkbf(acc[mt][nt][2], acc[mt][nt][3]);
                *(u32x2*)(mix + (size_t)(pm * 256 + 32 * w + 16 * mt + m) * 1024 + grp * 128 + 16 * nt + 4 * g) = o; }
    }
    __syncthreads();
}
__device__ __forceinline__ void p2_mixer(Frame& F) {
#ifndef P2_POOL_REPS
#define P2_POOL_REPS 1
#endif
#ifndef P2_ATTN_REPS
#define P2_ATTN_REPS 1
#endif
    for (int u = F.vcu; u < 64 * 4 * P2_POOL_REPS; u += F.G) pool_unit(F, (u & 255) >> 2, u & 3);
    for (int t = F.vcu; t < B * AH * 4 * P2_ATTN_REPS; t += F.G) attn_block(F, (t & 255) >> 2, (t & 3) * 8);
}

__device__ __forceinline__ void p4_router(Frame& F) {
    LAS float* wt = (LAS float*)F.lds;
    for (int i = F.tid; i < D * NE; i += 512) wt[(i & 15) * D + (i >> 4)] = F_w_router[i];
    __syncthreads();
    const int gw = F.vcu * 8 + F.wave, NGW = F.G * 8, lane = F.lane;
    bf16_t* H2 = WSP(bf16_t, WS_H2); float* aff = WSP(float, WS_AFF);
    f32x4 vn[2][4];
#pragma unroll
    for (int rr = 0; rr < 2; ++rr) { const int r_ = (2 * gw + rr) < T ? (2 * gw + rr) : 0; const f32x4* xr = (const f32x4*)(F.out + (size_t)r_ * D) + lane;
#pragma unroll
        for (int j = 0; j < 4; ++j) vn[rr][j] = xr[64 * j]; }
    for (int row = 2 * gw; row < T; row += 2 * NGW) {
        const f32x4* gr = (const f32x4*)F_norm_ffn + lane;
        f32x4 v[2][4]; float ss[2];
#pragma unroll
        for (int rr = 0; rr < 2; ++rr) { float s_ = 0.f;
#pragma unroll
            for (int j = 0; j < 4; ++j) { v[rr][j] = vn[rr][j]; s_ += (v[rr][j].x * v[rr][j].x + v[rr][j].y * v[rr][j].y) + (v[rr][j].z * v[rr][j].z + v[rr][j].w * v[rr][j].w); }
            ss[rr] = s_; }
#pragma unroll
        for (int rr = 0; rr < 2; ++rr) { const int rn = row + 2 * NGW + rr; const int r_ = rn < T ? rn : row + rr; const f32x4* xr = (const f32x4*)(F.out + (size_t)r_ * D) + lane;
#pragma unroll
            for (int j = 0; j < 4; ++j) vn[rr][j] = xr[64 * j]; }
#pragma unroll
        for (int o = 1; o < 64; o <<= 1) { ss[0] += __shfl_xor(ss[0], o); ss[1] += __shfl_xor(ss[1], o); }
#pragma unroll
        for (int rr = 0; rr < 2; ++rr) { const float rstd = 1.0f / sqrtf(ss[rr] * (1.0f / D) + EPS); u32x2* o8 = (u32x2*)(H2 + (size_t)(row + rr) * D) + lane;
#pragma unroll
            for (int j = 0; j < 4; ++j) { v[rr][j] = v[rr][j] * rstd * gr[64 * j]; u32x2 o; o.x = pkbf(v[rr][j].x, v[rr][j].y); o.y = pkbf(v[rr][j].z, v[rr][j].w); o8[64 * j] = o; } }
        float a[32];
#pragma unroll
        for (int e = 0; e < 16; ++e) { float a0 = 0.f, a1 = 0.f;
#pragma unroll
            for (int j = 0; j < 4; ++j) { const f32x4 w4 = *(const LAS f32x4*)(wt + e * D + 256 * j + 4 * lane);
                a0 += (v[0][j].x * w4.x + v[0][j].y * w4.y) + (v[0][j].z * w4.z + v[0][j].w * w4.w); a1 += (v[1][j].x * w4.x + v[1][j].y * w4.y) + (v[1][j].z * w4.z + v[1][j].w * w4.w); }
            a[e] = a0; a[16 + e] = a1; if ((e & 3) == 3) asm volatile("" ::: "memory"); }
#define RS_STEP(n, M) do { const bool up = (lane & (M)) != 0; _Pragma("unroll") for (int j = 0; j < (n) / 2; ++j) { const float snd = up ? a[j] : a[j + (n) / 2]; const float kp_ = up ? a[j + (n) / 2] : a[j]; a[j] = kp_ + __shfl_xor(snd, (M)); } } while (0)
        RS_STEP(32, 32); RS_STEP(16, 16); RS_STEP(8, 8); RS_STEP(4, 4); RS_STEP(2, 2);
#undef RS_STEP
        float lg = a[0] + __shfl_xor(a[0], 1);
        float mx = lg;
#pragma unroll
        for (int o = 2; o < 32; o <<= 1) mx = fmaxf(mx, __shfl_xor(mx, o));
        const float ex = expf(lg - mx); float sum = ex;
#pragma unroll
        for (int o = 2; o < 32; o <<= 1) sum += __shfl_xor(sum, o);
        if ((lane & 1) == 0) { const int k = lane >> 1, rr = k >> 4, e = k & 15; const int rw = row + rr; aff[((size_t)(rw >> 11) * NE + e) * S + (rw & 2047)] = ex / sum; }
    }
}

__device__ __forceinline__ void p4_finish(Frame& F) {
    if (F.wave != 0) return;
    const float* part = WSP(const float, WS_PART); float* aff = WSP(float, WS_AFF); float* rstd1 = WSP(float, WS_RSTD1);
    for (int row = F.vcu * 64 + F.lane; row < T; row += F.G * 64) {
        const f32x4* pr = (const f32x4*)(part + (size_t)row * 80); float tot[20];
#pragma unroll
        for (int k = 0; k < 5; ++k) { const f32x4 a = pr[k], b = pr[5 + k], c = pr[10 + k], d = pr[15 + k]; const f32x4 t = (a + b) + (c + d); tot[4 * k] = t[0]; tot[4 * k + 1] = t[1]; tot[4 * k + 2] = t[2]; tot[4 * k + 3] = t[3]; }
        const float rstd = 1.0f / sqrtf(tot[0] * (1.0f / D) + EPS);
        float mx = -1e30f;
#pragma unroll
        for (int e = 0; e < 16; ++e) { tot[1 + e] *= rstd; mx = fmaxf(mx, tot[1 + e]); }
        float sum = 0.f;
#pragma unroll
        for (int e = 0; e < 16; ++e) { tot[1 + e] = expf(tot[1 + e] - mx); sum += tot[1 + e]; }
        const float inv = 1.0f / sum; const int b = row >> 11, sidx_ = row & 2047;
#pragma unroll
        for (int e = 0; e < 16; ++e) aff[((size_t)b * NE + e) * S + sidx_] = tot[1 + e] * inv;
        rstd1[row] = rstd;
    }
}

__device__ __forceinline__ void p5_topk_gather(Frame& F) {
    LAS int* sidx = (LAS int*)F.lds;
    const int lane = F.lane; const float* aff = WSP(const float, WS_AFF); float* gates = WSP(float, WS_GATES); int* slot_of = WSP(int, WS_SLOT);
    const bf16_t* H2 = WSP(const bf16_t, WS_H2); bf16_t* XE = WSP(bf16_t, WS_XE);
    for (int task = F.vcu; task < B * NE * 2; task += F.G) {
        const int be = task >> 1, half = task & 1, b = be >> 4, e = be & 15;
        if (F.wave == 0) {
            unsigned v[32];
#pragma unroll
            for (int j = 0; j < 32; ++j) v[j] = __builtin_bit_cast(unsigned, aff[(size_t)be * S + 64 * j + lane]);
            unsigned Tt = 0u;
#define WSUM6(c) (__popcll(__ballot(((c) & 1) != 0)) + 2 * __popcll(__ballot(((c) & 2) != 0)) + 4 * __popcll(__ballot(((c) & 4) != 0)) + 8 * __popcll(__ballot(((c) & 8) != 0)) + 16 * __popcll(__ballot(((c) & 16) != 0)) + 32 * __popcll(__ballot(((c) & 32) != 0)))
            for (int bit = 30; bit >= 0; --bit) { const unsigned cand = Tt | (1u << bit); int c = 0;
#pragma unroll
                for (int j = 0; j < 32; ++j) c += (v[j] >= cand) ? 1 : 0;
                if (WSUM6(c) >= CAP) Tt = cand; }
            int ngt;
            { int c = 0;
#pragma unroll
              for (int j = 0; j < 32; ++j) c += (v[j] > Tt) ? 1 : 0;
              ngt = WSUM6(c); }
#undef WSUM6
            const int need = CAP - ngt; int eq_run = 0, sel_run = 0;
            const unsigned long long ltmask = (lane == 0) ? 0ull : (~0ull >> (64 - lane));
#pragma unroll
            for (int j = 0; j < 32; ++j) {
                const bool gt = v[j] > Tt, eq = v[j] == Tt;
                const unsigned long long em = __ballot(eq);
                const int eqb = eq_run + __popcll(em & ltmask);
                const bool sel = gt || (eq && eqb < need);
                eq_run += __popcll(em);
                const unsigned long long sm = __ballot(sel);
                const int slot = sel_run + __popcll(sm & ltmask);
                sel_run += __popcll(sm);
                const int tok = 64 * j + lane;
                if (sel) sidx[slot] = tok;
                if (half == 0) { if (sel) gates[be * CAP + slot] = __builtin_bit_cast(float, v[j]); slot_of[((size_t)b * S + tok) * NE + e] = sel ? slot : -1; }
            }
        }
        __syncthreads();
        for (int i = 0; i < 16; ++i) { const int slot = half * 128 + F.wave * 16 + i; const int tok = sidx[slot];
#if EXPERT_FP8
            const u32x4* src = (const u32x4*)(H2 + ((size_t)b * S + tok) * D) + 2 * lane; u32x4* dst = (u32x4*)((unsigned char*)XE + ((size_t)be * CAP + slot) * D) + lane;
            const u32x4 a0 = src[0], a1 = src[1]; u32x4 o; const float rs = WSP(const float, WS_RSTD1)[(size_t)b * S + tok];
            o.x = pk4_fp8(bflo(a0.x) * rs, bfhi(a0.x) * rs, bflo(a0.y) * rs, bfhi(a0.y) * rs); o.y = pk4_fp8(bflo(a0.z) * rs, bfhi(a0.z) * rs, bflo(a0.w) * rs, bfhi(a0.w) * rs);
            o.z = pk4_fp8(bflo(a1.x) * rs, bfhi(a1.x) * rs, bflo(a1.y) * rs, bfhi(a1.y) * rs); o.w = pk4_fp8(bflo(a1.z) * rs, bfhi(a1.z) * rs, bflo(a1.w) * rs, bfhi(a1.w) * rs); dst[0] = o; }
#else
            const u32x4* src = (const u32x4*)(H2 + ((size_t)b * S + tok) * D) + lane; u32x4* dst = (u32x4*)(XE + ((size_t)be * CAP + slot) * D) + lane;
            const float rs = WSP(const float, WS_RSTD1)[(size_t)b * S + tok]; u32x4 a0 = src[0], a1 = src[64];
#define RS2(w) w = pkbf(bflo(w) * rs, bfhi(w) * rs)
            RS2(a0.x); RS2(a0.y); RS2(a0.z); RS2(a0.w); RS2(a1.x); RS2(a1.y); RS2(a1.z); RS2(a1.w);
#undef RS2
            dst[0] = a0; dst[64] = a1; }
#endif
        __syncthreads();
    }
}

__device__ __forceinline__ void p8_combine(Frame& F, bf16_t* X2N) {
    const int gw = F.vcu * 8 + F.wave, NGW = F.G * 8, lane = F.lane;
    const bf16_t* YE = WSP(const bf16_t, WS_XE); const int* slot_of = WSP(const int, WS_SLOT);
    const float* esq = WSP(const float, WS_ESQ); float* rstde = WSP(float, WS_RSTDE);
    struct RowIn { f32x4 x[4]; u32x2 y[4][4]; float wgt[4]; unsigned rest; int myslot; };
#define P8_SLOT(r_) (((r_) < T && lane < 16) ? slot_of[(size_t)(r_) * NE + lane] : -1)
#define P8_FETCH(in, r_, ms_) do { const int rq_ = (r_) < T ? (r_) : gw; const u32x2* xr_ = (const u32x2*)(H2s + (size_t)rq_ * D) + lane; \
        _Pragma("unroll") for (int j = 0; j < 4; ++j) { const u32x2 h_ = xr_[64 * j]; in.x[j] = (f32x4){bflo(h_.x), bfhi(h_.x), bflo(h_.y), bfhi(h_.y)} * gi[j]; } \
        in.myslot = (ms_); unsigned mk_ = (unsigned)__builtin_amdgcn_readfirstlane((int)(__ballot(in.myslot >= 0) & 0xffffull)); const int b_ = rq_ >> 11; \
        _Pragma("unroll") for (int k = 0; k < 4; ++k) { const bool ok_ = mk_ != 0u; const int e_ = ok_ ? __builtin_ctz(mk_) : 0; if (ok_) mk_ &= mk_ - 1u; \
            int sl_ = __builtin_amdgcn_readlane(in.myslot, e_); sl_ = (ok_ && sl_ >= 0) ? sl_ : 0; in.wgt[k] = ok_ ? 1.0f : 0.0f; \
            const u32x2* yr_ = (const u32x2*)(YE + ((size_t)(b_ * NE + e_) * CAP + sl_) * D) + lane; \
            _Pragma("unroll") for (int j = 0; j < 4; ++j) in.y[k][j] = yr_[64 * j]; } \
        in.rest = mk_; } while (0)
    const bf16_t* H2s = WSP(const bf16_t, WS_H2); f32x4 gi[4];
#pragma unroll
    for (int j = 0; j < 4; ++j) { const f32x4 g_ = ((const f32x4*)F_norm_ffn)[lane + 64 * j]; gi[j] = (f32x4){1.0f / g_[0], 1.0f / g_[1], 1.0f / g_[2], 1.0f / g_[3]}; }
    RowIn cur, nxt;
    int ms1 = P8_SLOT(gw + NGW);
    { const int ms0 = P8_SLOT(gw); P8_FETCH(cur, gw, ms0); }
    for (int row = gw; row < T; row += NGW) {
        const int ms2 = P8_SLOT(row + 2 * NGW);
        P8_FETCH(nxt, row + NGW, ms1);
        const f32x4* gr = (const f32x4*)F_norm_ple + lane; const int b = row >> 11;
        f32x4 v[4];
#pragma unroll
        for (int j = 0; j < 4; ++j) v[j] = cur.x[j];
#pragma unroll
        for (int k = 0; k < 4; ++k)
#pragma unroll
            for (int j = 0; j < 4; ++j) { v[j].x += cur.wgt[k] * bflo(cur.y[k][j].x); v[j].y += cur.wgt[k] * bfhi(cur.y[k][j].x); v[j].z += cur.wgt[k] * bflo(cur.y[k][j].y); v[j].w += cur.wgt[k] * bfhi(cur.y[k][j].y); }
        unsigned mask = cur.rest;
        while (mask != 0u) { const int e = __builtin_ctz(mask); mask &= mask - 1u; const int sl = __builtin_amdgcn_readlane(cur.myslot, e);
            const u32x2* yr = (const u32x2*)(YE + ((size_t)(b * NE + e) * CAP + sl) * D) + lane;
#pragma unroll
            for (int j = 0; j < 4; ++j) { const u32x2 y = yr[64 * j]; v[j].x += bflo(y.x); v[j].y += bfhi(y.x); v[j].z += bflo(y.y); v[j].w += bfhi(y.y); } }
        float s = 0.f;
#pragma unroll
        for (int j = 0; j < 4; ++j) { s += (v[j].x * v[j].x + v[j].y * v[j].y) + (v[j].z * v[j].z + v[j].w * v[j].w); }
        const float rms = sqrtf(wave_sum(s) * (1.0f / D) + EPS), rstd = 1.0f / rms;
        if (lane == 1) WSP(float, WS_RMS2)[row] = rms;
        u32x2* o8 = (u32x2*)(X2N + (size_t)row * D) + lane;
#pragma unroll
        for (int j = 0; j < 4; ++j) { const f32x4 gg = gr[64 * j]; u32x2 o; o.x = pkbf(v[j].x * rstd * gg.x, v[j].y * rstd * gg.y); o.y = pkbf(v[j].z * rstd * gg.z, v[j].w * rstd * gg.w); o8[64 * j] = o; }
        float q = (lane < 16) ? esq[(size_t)row * 16 + lane] : 0.f; q = wave_sum(q);
        if (lane == 0) rstde[row] = 1.0f / sqrtf(q * (1.0f / D) + EPS);
        cur = nxt; ms1 = ms2;
    }
#undef P8_SLOT
#undef P8_FETCH
}

constexpr int N_PHASES = 10;
__global__ void __launch_bounds__(512, 2) mega_fwd(MArgs args) {
    extern __shared__ __attribute__((aligned(16))) unsigned char lds_raw[];
    Frame F;
    F.lds = (LAS unsigned char*)lds_raw; F.tid = threadIdx.x; F.lane = F.tid & 63; F.wave = __builtin_amdgcn_readfirstlane(F.tid >> 6);
    F.G = gridDim.x; { const int bx = blockIdx.x; F.vcu = (F.G % 8 == 0) ? (bx % 8) * (F.G / 8) + bx / 8 : bx; }
    F.out = args.out; F.ws = args.ws; F.a = &args;
    for (int u = F.tid; u < (LDS_BYTES - LDSCTL_OFF) / 4; u += 512) ((LAS unsigned*)(F.lds + LDSCTL_OFF))[u] = 0u;
    __syncthreads();
    const int lo = args.ph_lo, hi = args.ph_hi;
    if (hi - lo > 1) xcd_barrier_post(WSP(unsigned, WS_CTL) + CW_BAR);
#ifndef PH_ENABLE
#define PH_ENABLE 0x3ff
#endif
#define IN(k) (((PH_ENABLE >> (k)) & 1) && lo <= (k) && (k) < hi)
#ifndef DUP_MASK
#define DUP_MASK 0
#endif
#ifndef P1A_REPS
#define P1A_REPS 1
#endif
#ifndef P1B_REPS
#define P1B_REPS 1
#endif
#define GBAR() xcd_barrier(WSP(unsigned, WS_CTL) + CW_BAR, (volatile LAS unsigned*)(F.lds + MISC_OFF) + 8)
#define DUP(k) (((DUP_MASK >> (k)) & 1) ? 2 : 1)
#ifdef TS_PHASE
#ifndef TS_SPAN
#define TS_SPAN 1
#endif
#ifndef TS_GAIN
#define TS_GAIN 1.0
#endif
#define STAMP(i) do { if (blockIdx.x == 0 && F.tid == 0) WSP(unsigned long long, WS_CTL + 32768)[(i)] = __builtin_amdgcn_s_memrealtime(); } while (0)
#else
#define STAMP(i) do {} while (0)
#endif
#define SEAM(k) do { if (IN(k) && IN((k) + 1)) xcd_barrier(WSP(unsigned, WS_CTL) + CW_BAR, (volatile LAS unsigned*)(F.lds + MISC_OFF) + 8); STAMP((k) + 1); } while (0)
    STAMP(0);
    if (IN(0)) { for (int rep = 0; rep < DUP(0); ++rep) { if (rep) GBAR(); p0_prologue(F); } } SEAM(0);
    if (IN(1)) for (int rep = 0; rep < DUP(1); ++rep) { if (rep) GBAR();
#ifndef CONV_SPLIT
#define CONV_SPLIT 2
#endif
        const int bq = (int)blockIdx.x >> 3, bxc = (int)blockIdx.x & 7; const bool split = EXPERT_FP8 && F.G == 256;
#if CONV_SPLIT == 16
        const int q16 = bq & 15, hi16 = bq >> 4; const bool conv = split && q16 >= 9;
        const int gG = split ? 144 : F.G; const int gc = split ? (bxc + 8 * (hi16 * 9 + q16)) : (int)blockIdx.x;
        const int cvw = ((hi16 * 7 + (q16 - 9)) * 8 + bxc) * 8 + F.wave, ncvw = 896;
        const bool e_run = !split || gc >= 80; const int eG = split ? 64 : F.G, ec = split ? gc - 80 : gc;
#else
        const bool conv = split && (bq % CONV_SPLIT) == CONV_SPLIT - 1;
        const int gG = split ? 256 - 256 / CONV_SPLIT : F.G; const int gc = split ? (bxc + 8 * ((bq / CONV_SPLIT) * (CONV_SPLIT - 1) + (bq % CONV_SPLIT))) : (int)blockIdx.x;
        const int cvw = ((bq / CONV_SPLIT) * 8 + bxc) * 8 + F.wave, ncvw = 8 * 256 / CONV_SPLIT;
        const bool e_run = true; const int eG = gG, ec = (split && CONV_SPLIT == 4) ? (gc + 64) % 192 : gc;
#endif
#if EXPERT_FP8
        if (conv) { p1_convert_experts(F, cvw, ncvw); } else
#endif
        {
#ifndef NO_P1A
        { pg8::Gemm g{WSP(const bf16_t, WS_XN), WSP(const bf16_t, WS_WIN), 1024}; pg8::StaticOrder So; So.init(T, 2048, gG, gc, P1A_REPS);
          EpiQKV E{WSP(bf16_t, WS_U), WSP(bf16_t, WS_Q), WSP(bf16_t, WS_K), WSP(bf16_t, WS_VT), F_q_norm, F_k_norm};
          pg8::gemm_phase(F.lds, g, So, E); }
#endif
#ifndef NO_P1B
        if (e_run) { pg8::Gemm g{WSP(const bf16_t, WS_PB), WSP(const bf16_t, WS_WPP), 256}; pg8::StaticOrder So; So.init(T, 1024, eG, ec, P1B_REPS);
          EpiE E{WSP(bf16_t, WS_EB), WSP(float, WS_ESQ)};
          pg8::gemm_phase(F.lds, g, So, E); }
#endif
        }
    } SEAM(1);
    if (IN(2)) { for (int rep = 0; rep < DUP(2); ++rep) { if (rep) GBAR(); p2_mixer(F); } } SEAM(2);
    if (IN(3)) for (int rep = 0; rep < DUP(3); ++rep) { if (rep) GBAR(); pg8::Gemm g{WSP(const bf16_t, WS_MIX), WSP(const bf16_t, WS_WOUT), 1024}; pg8::StaticOrder So; So.init(T, 1024, F.G, (int)blockIdx.x);
        EpiX1 E{F_x, F_norm_ffn, F_w_router, WSP(bf16_t, WS_H2), WSP(float, WS_PART)}; pg8::gemm_phase(F.lds, g, So, E); } SEAM(3);
    if (IN(4)) { for (int rep = 0; rep < DUP(4); ++rep) { if (rep) GBAR(); p4_finish(F); } } SEAM(4);
    if (IN(5)) { for (int rep = 0; rep < DUP(5); ++rep) { if (rep) GBAR(); p5_topk_gather(F); } } SEAM(5);
    if (IN(6)) for (int rep = 0; rep < DUP(6); ++rep) { if (rep) GBAR(); pg8::Gemm g{WSP(const bf16_t, WS_XE), WSP(const bf16_t, WS_WGU), 1024}; OrderGU So{F.G, F.vcu};
        EpiGU E{WSP(bf16_t, WS_HH)};
#if EXPERT_FP8
        pg8::gemm_phase<EpiGU, OrderGU, true, 0x7a7a7a7au, 0x7f7f7f7fu>(F.lds, g, So, E); } SEAM(6);
#else
        pg8::gemm_phase(F.lds, g, So, E); } SEAM(6);
#endif
    if (IN(7)) for (int rep = 0; rep < DUP(7); ++rep) { if (rep) GBAR(); pg8::Gemm g{WSP(const bf16_t, WS_HH), WSP(const bf16_t, WS_WD), 2048, EXPERT_FP8 ? PAD_HH : 0, EXPERT_FP8 ? PAD_WD : 0}; OrderDown So{F.G, F.vcu};
        EpiDown E{WSP(bf16_t, WS_XE), WSP(const float, WS_GATES)};
#if EXPERT_FP8
        pg8::gemm_phase<EpiDown, OrderDown, true, 0x7a7a7a7au, 0x7c7c7c7cu>(F.lds, g, So, E); } SEAM(7);
#else
        pg8::gemm_phase(F.lds, g, So, E); } SEAM(7);
#endif
#ifdef SHADOW_P8
    if (IN(8)) { p8_combine(F, WSP(bf16_t, WS_Q)); GBAR(); }
#endif
    if (IN(8)) { p8_combine(F, WSP(bf16_t, WS_X2N)); } SEAM(8);
#ifdef SHADOW_P9
    if (IN(9)) { pg8::Gemm g{WSP(const bf16_t, WS_X2N), WSP(const bf16_t, WS_WPG), 1024}; pg8::StaticOrder So; So.init(T, 1024, F.G, (int)blockIdx.x);
        EpiFinal E{WSP(float, WS_U), WSP(const bf16_t, WS_X2N), WSP(const bf16_t, WS_EB), WSP(const float, WS_RSTDE), WSP(const float, WS_RMS2), F_norm_ple_post, F_norm_ple}; pg8::gemm_phase(F.lds, g, So, E); GBAR(); }
#endif
    if (IN(9)) { pg8::Gemm g{WSP(const bf16_t, WS_X2N), WSP(const bf16_t, WS_WPG), 1024}; pg8::StaticOrder So; So.init(T, 1024, F.G, (int)blockIdx.x);
        EpiFinal E{F.out, WSP(const bf16_t, WS_X2N), WSP(const bf16_t, WS_EB), WSP(const float, WS_RSTDE), WSP(const float, WS_RMS2), F_norm_ple_post, F_norm_ple}; pg8::gemm_phase(F.lds, g, So, E); }
#ifdef TS_PHASE
    GBAR(); STAMP(10);
    if (blockIdx.x == 0) { __syncthreads(); const unsigned long long* ts = WSP(const unsigned long long, WS_CTL + 32768);
        const unsigned long long t0 = __hip_atomic_load(ts + (TS_PHASE), __ATOMIC_RELAXED, __HIP_MEMORY_SCOPE_AGENT), t1 = __hip_atomic_load(ts + (TS_PHASE) + TS_SPAN, __ATOMIC_RELAXED, __HIP_MEMORY_SCOPE_AGENT);
#ifdef TS_FAKE
        const float us = (float)(TS_FAKE);
#else
        const float us = (float)(t1 - t0) * 0.01f;
#endif
        const float delta = sqrtf(us * 4.1e-4f * (float)(TS_GAIN));
        for (int i = F.tid; i < 65536; i += 512) F.out[i] += delta; }
#endif
#undef IN
#undef SEAM
}
static inline dim3 g1(size_t n) { return dim3((unsigned)((n + 255) / 256)); }

#ifndef MODE
#define MODE 0
#endif

extern "C" void kernel_launch(void* const* d_in, const int* in_sizes, int n_in, void* d_out, int out_size, void* d_ws, size_t ws_size, hipStream_t stream) {
    const float* x = (const float*)d_in[0]; const float* p = (const float*)d_in[1]; const float* norm_mix = (const float*)d_in[2]; const float* w_in = (const float*)d_in[3];
    const float* w_pool = (const float*)d_in[4]; const float* pool_scale = (const float*)d_in[5]; const float* q_norm = (const float*)d_in[6]; const float* k_norm = (const float*)d_in[7];
    const float* rpb = (const float*)d_in[8]; const float* w_out = (const float*)d_in[9]; const float* norm_ffn = (const float*)d_in[10]; const float* w_router = (const float*)d_in[11];
    const float* w_gate = (const float*)d_in[12]; const float* w_up = (const float*)d_in[13]; const float* w_down = (const float*)d_in[14]; const float* norm_ple = (const float*)d_in[15];
    const float* w_ple_gate = (const float*)d_in[16]; const float* w_ple_proj = (const float*)d_in[17]; const float* norm_ple_post = (const float*)d_in[18];
    float* out = (float*)d_out; char* ws = (char*)d_ws;
    (void)in_sizes; (void)n_in; (void)out_size;
    static int grid = 0;
    if (grid == 0) {
        if (ws_size < (size_t)489 * MiB) { fprintf(stderr, "kernel_launch: workspace too small (%zu)\n", ws_size); grid = -1; return; }
        int dev = 0, cus = 0, per_cu = 0;
        if (hipGetDevice(&dev) != hipSuccess || hipDeviceGetAttribute(&cus, hipDeviceAttributeMultiprocessorCount, dev) != hipSuccess) { grid = -1; return; }
        if (hipFuncSetAttribute((const void*)mega_fwd, hipFuncAttributeMaxDynamicSharedMemorySize, LDS_BYTES) != hipSuccess) { fprintf(stderr, "kernel_launch: hipFuncSetAttribute failed\n"); grid = -1; return; }
        if (hipOccupancyMaxActiveBlocksPerMultiprocessor(&per_cu, (const void*)mega_fwd, 512, LDS_BYTES) != hipSuccess || per_cu < 1) { fprintf(stderr, "kernel_launch: occupancy query says %d blocks per CU\n", per_cu); grid = -1; (void)hipGetLastError(); return; }
        if (cus != 256) { fprintf(stderr, "kernel_launch: built for a 256-CU device (one 256x256 unit per workgroup in the fused phases); found %d CUs\n", cus); grid = -1; return; }
        grid = cus;
    }
    if (grid < 0) return;
    (void)hipMemsetAsync((char*)d_ws + WS_CTL, 0, CTL_ZERO_BYTES, stream);
    MArgs a{};
    for (int i = 0; i < 19; ++i) a.in[i] = (const float*)d_in[i];
    a.out = out; a.ws = (unsigned char*)d_ws;
#if MODE == 0
    a.ph_lo = 0; a.ph_hi = N_PHASES;
    hipLaunchKernelGGL(mega_fwd, dim3(grid), dim3(512), LDS_BYTES, stream, a);
#else
    constexpr int KOPT = MODE - 100;
    for (int ph = 0; ph <= KOPT; ++ph) { a.ph_lo = ph; a.ph_hi = ph + 1; hipLaunchKernelGGL(mega_fwd, dim3(grid), dim3(512), LDS_BYTES, stream, a); }
    float* xn = (float*)(ws + 0 * MiB);
    float* z = (float*)(ws + 64 * MiB);
    float* dp = (float*)(ws + 192 * MiB);
    float* ye = (float*)(ws + 288 * MiB);
    float* ga = (float*)(ws + 416 * MiB); float* gb = (float*)(ws + 448 * MiB);
    float* mix = (float*)(ws + 416 * MiB);
    float* aff = (float*)(ws + 485 * MiB); int* idx = (int*)(ws + 486 * MiB); float* gates = (float*)(ws + 487 * MiB); int* slot_of = (int*)(ws + 488 * MiB);
    const unsigned short* mU = (const unsigned short*)(ws + WS_U); const unsigned short* mQ = (const unsigned short*)(ws + WS_Q); const unsigned short* mK = (const unsigned short*)(ws + WS_K); const unsigned short* mVT = (const unsigned short*)(ws + WS_VT);
    if (KOPT < 1) {
        nv::rmsnorm_rows<<<T, 256, 0, stream>>>(x, norm_mix, xn, D);
        nv::gemm_f32<<<dim3(2048 / 64, T / 64, 1), 256, 0, stream>>>(xn, w_in, z, D, D, 2048, 2048, 0, 0, 0);
    }
    if (KOPT < 2) {
        if (KOPT == 1) nv::bf16_to_f32<<<g1((size_t)T * PW), 256, 0, stream>>>(mU, z, PW, 2048, (size_t)T * PW);
        nv::pool_diff<<<g1((size_t)T * PW), 256, 0, stream>>>(z, dp);
        nv::gemm_f32<<<dim3(PG / 64, T / 64, 4), 256, 0, stream>>>(dp, w_pool, mix, PG, PW, PG, D, PG, (size_t)PG * PG, PG);
        nv::scale_cols<<<g1((size_t)T * PW), 256, 0, stream>>>(mix, D, PW, pool_scale, (size_t)T * PW);
        if (KOPT == 1) nv::natten_pre<<<T * AH, 128, 0, stream>>>(mQ, mK, mVT, rpb, mix);
        else nv::natten<<<T * AH, 128, 0, stream>>>(z, q_norm, k_norm, rpb, mix);
    }
    if (KOPT < 3) {
        if (KOPT == 2) nv::bf16_to_f32<<<g1((size_t)T * D), 256, 0, stream>>>((const unsigned short*)(ws + WS_MIX), mix, D, D, (size_t)T * D);
        nv::gemm_f32<<<dim3(D / 64, T / 64, 1), 256, 0, stream>>>(mix, w_out, xn, D, D, D, D, 0, 0, 0);
        nv::add_to<<<g1((size_t)T * D), 256, 0, stream>>>(out, x, xn, (size_t)T * D);
    }
    if (KOPT < 4) {
        nv::rmsnorm_rows<<<T, 256, 0, stream>>>(out, norm_ffn, xn, D);
        nv::router<<<T, 256, 0, stream>>>(xn, w_router, aff);
    } else { aff = (float*)(ws + WS_AFF); }
    if (KOPT < 5) {
        if (KOPT == 4) nv::bf16_to_f32<<<g1((size_t)T * D), 256, 0, stream>>>((const unsigned short*)(ws + WS_H2), xn, D, D, (size_t)T * D);
        nv::topk<<<B * NE, 1024, 0, stream>>>(aff, idx, gates, slot_of);
        nv::gather_rows<<<B * NE * CAP, 256, 0, stream>>>(xn, idx, z);
    } else { gates = (float*)(ws + WS_GATES); slot_of = (int*)(ws + WS_SLOT); }
    if (KOPT < 7) {
        float* xe = z;
        if (KOPT >= 5) nv::bf16_to_f32<<<g1((size_t)B * NE * CAP * D), 256, 0, stream>>>((const unsigned short*)(ws + WS_XE), xe, D, D, (size_t)B * NE * CAP * D);
        for (int b = 0; b < B; ++b) {
            const float* xeb = xe + (size_t)b * NE * CAP * D;
            nv::gemm_f32<<<dim3(DE / 64, CAP / 64, NE), 256, 0, stream>>>(xeb, w_gate, ga, D, D, DE, DE, (size_t)CAP * D, (size_t)D * DE, (size_t)CAP * DE);
            nv::gemm_f32<<<dim3(DE / 64, CAP / 64, NE), 256, 0, stream>>>(xeb, w_up, gb, D, D, DE, DE, (size_t)CAP * D, (size_t)D * DE, (size_t)CAP * DE);
            nv::silu_mul<<<g1((size_t)NE * CAP * DE), 256, 0, stream>>>(ga, gb, (size_t)NE * CAP * DE);
            nv::gemm_f32<<<dim3(D / 64, CAP / 64, NE), 256, 0, stream>>>(ga, w_down, ye + (size_t)b * NE * CAP * D, DE, DE, D, D, (size_t)CAP * DE, (size_t)DE * D, (size_t)CAP * D);
        }
    }
    if (KOPT < 8) {
        if (KOPT == 7) nv::combine_bf16<<<T, 256, 0, stream>>>(out, (const unsigned short*)(ws + WS_XE), slot_of);
        else nv::combine<<<T, 256, 0, stream>>>(out, ye, gates, slot_of);
    }
    if (KOPT < 9) {
        nv::rmsnorm_rows<<<T, 256, 0, stream>>>(out, norm_ple, xn, D);
        nv::gemm_f32<<<dim3(D / 64, T / 64, 1), 256, 0, stream>>>(xn, w_ple_gate, mix, D, D, D, D, 0, 0, 0);
        float* eraw = ye;
        nv::gemm_f32<<<dim3(D / 64, T / 64, 1), 256, 0, stream>>>(p, w_ple_proj, eraw, PD, PD, D, D, 0, 0, 0);
        nv::rmsnorm_rows<<<T, 256, 0, stream>>>(eraw, norm_ple_post, xn, D);
        nv::ple_final<<<g1((size_t)T * D), 256, 0, stream>>>(out, mix, xn, (size_t)T * D);
    }
#endif
}
```
